# Optimizing an MI355X kernel written in HIP

```python
import jax, jax.numpy as jnp
from jax import lax
import numpy as np

D_MODEL = 1024
BATCH = 4
SEQ = 4096
DEPTH = 2
DEC_BATCH = 8
DEC_SEQ = 16
PAST_LEN = 1024

CHUNK = 64
D_A = 512
G_A = 4
A_CHUNK = 128
D_B = 512
H_B = 8
DH_B = D_B // H_B
CONV_W = 4
LRU_C = 8.0
H_C = 8
D_NOPE = 64
D_ROPE = 32
D_V = 64
Q_LORA = 256
KV_LORA = 128
D_C = H_C * D_V
ROPE_BASE = 10000.0
Q_BLOCK = 128
N_MEM = 256
H_M = 4
DH_M = 64
D_M = H_M * DH_M
N_BRANCH = 4
ALPHA = (2.0 * DEPTH) ** 0.25
BETA = (8.0 * DEPTH) ** -0.25
EPS = 1e-6
SPLITS = (D_A, D_A, D_A, D_B, D_B, Q_LORA, KV_LORA, D_ROPE, D_C, D_M, N_BRANCH * D_MODEL)
D_IN = 3 * D_A + 2 * D_B + Q_LORA + KV_LORA + D_ROPE + D_C + D_M + N_BRANCH * D_MODEL
D_BR = D_A + D_B + D_C + D_M

kernel_name = 'hybrid_gmlp_rglru_mla_stream_step'


def layer_norm(x, g, b):
    xf = x.astype(jnp.float32)
    mu = jnp.mean(xf, -1, keepdims=True)
    var = jnp.mean(jnp.square(xf - mu), -1, keepdims=True)
    return ((xf - mu) * lax.rsqrt(var + EPS) * g + b).astype(x.dtype)


def rms_norm(x, g):
    xf = x.astype(jnp.float32)
    return (xf * lax.rsqrt(jnp.mean(jnp.square(xf), -1, keepdims=True) + EPS) * g).astype(x.dtype)


def split_cols(z):
    parts, start = [], 0
    for n in SPLITS:
        parts.append(z[..., start:start + n])
        start += n
    return parts


def rope(x, pos):
    half = D_ROPE // 2
    freq = ROPE_BASE ** (-jnp.arange(half, dtype=jnp.float32) / half)
    ang = pos.astype(jnp.float32)[:, None] * freq[None, :]
    ang = ang.reshape((1, pos.shape[0]) + (1,) * (x.ndim - 3) + (half,))
    cos, sin = jnp.cos(ang), jnp.sin(ang)
    xf = x.astype(jnp.float32)
    x1, x2 = xf[..., :half], xf[..., half:]
    return jnp.concatenate([x1 * cos - x2 * sin, x1 * sin + x2 * cos], -1).astype(x.dtype)


def gmlp_branch(u, v, ln_g, ln_b, w_s, b_s):
    B, T, _ = v.shape
    u = jax.nn.gelu(u)
    v = layer_norm(jax.nn.gelu(v), ln_g, ln_b)
    L = min(T, A_CHUNK)
    vc = v.reshape(B, T // L, L, G_A, D_A // G_A)
    w = jnp.tril(w_s[:, :L, :L])
    s = jnp.einsum('gpq,bnqgc->bnpgc', w, vc) + jnp.transpose(b_s[:, :L])[None, None, :, :, None]
    return u * s.reshape(B, T, D_A), v


def _lin_combine(left, right):
    a_l, b_l = left
    a_r, b_r = right
    return a_l * a_r, a_r * b_l + b_r


def rglru_branch(xb, conv0, h0, conv_w, conv_b, w_r, b_r, w_i, b_i, lam):
    B, T, _ = xb.shape
    xp = jnp.concatenate([conv0.astype(xb.dtype), xb], axis=1)
    xc = conv_b
    for k in range(CONV_W):
        xc = xc + xp[:, k:k + T] * conv_w[k]
    xh = xc.reshape(B, T, H_B, DH_B)
    r = jax.nn.sigmoid((jnp.einsum('bthi,hij->bthj', xh, w_r).reshape(B, T, D_B) + b_r).astype(jnp.float32))
    i = jax.nn.sigmoid((jnp.einsum('bthi,hij->bthj', xh, w_i).reshape(B, T, D_B) + b_i).astype(jnp.float32))
    log_a = -LRU_C * r * jax.nn.softplus(-lam.astype(jnp.float32))
    a = jnp.exp(log_a)
    bval = jnp.sqrt(-jnp.expm1(2.0 * log_a)) * (i * xc.astype(jnp.float32))
    acc_a, acc_b = lax.associative_scan(_lin_combine, (a, bval), axis=1)
    h = acc_a * h0.astype(jnp.float32)[:, None, :] + acc_b
    return h.astype(xb.dtype), xp[:, -(CONV_W - 1):], h[:, -1].astype(xb.dtype)


def _mla_block(q_nope, q_rope, k_nope, k_rope, v, q_pos, k_pos):
    scale = (D_NOPE + D_ROPE) ** -0.5
    s = (jnp.einsum('bqhd,bkhd->bhqk', q_nope, k_nope)
         + jnp.einsum('bqhd,bkd->bhqk', q_rope, k_rope)).astype(jnp.float32) * scale
    mask = (k_pos[None, :] // CHUNK) <= (q_pos[:, None] // CHUNK)
    s = jnp.where(mask[None, None], s, -1e30)
    p = jax.nn.softmax(s, axis=-1).astype(v.dtype)
    return jnp.einsum('bhqk,bkhd->bqhd', p, v)


def chunk_causal_mla(q_nope, q_rope, k_nope, k_rope, v, q_pos, k_pos):
    B, T = q_nope.shape[:2]
    if T <= Q_BLOCK:
        return _mla_block(q_nope, q_rope, k_nope, k_rope, v, q_pos, k_pos)
    nb = T // Q_BLOCK
    qn = jnp.swapaxes(q_nope.reshape(B, nb, Q_BLOCK, H_C, D_NOPE), 0, 1)
    qr = jnp.swapaxes(q_rope.reshape(B, nb, Q_BLOCK, H_C, D_ROPE), 0, 1)
    qp = q_pos.reshape(nb, Q_BLOCK)
    out = lax.map(lambda a: _mla_block(a[0], a[1], k_nope, k_rope, v, a[2], k_pos), (qn, qr, qp))
    return jnp.swapaxes(out, 0, 1).reshape(B, T, H_C, D_V)


def mla_branch(c_q, c_kv, kr_raw, q_norm, w_uq, kv_norm, w_ukv, q_pos, past_ckv, past_kr):
    B, T, _ = c_q.shape
    q = (rms_norm(c_q, q_norm) @ w_uq).reshape(B, T, H_C, D_NOPE + D_ROPE)
    q_nope, q_rope = q[..., :D_NOPE], rope(q[..., D_NOPE:], q_pos)
    ckv_new = rms_norm(c_kv, kv_norm)
    kr_new = rope(kr_raw, q_pos)
    if past_ckv is None:
        ckv_all, kr_all, k_pos = ckv_new, kr_new, q_pos
    else:
        ckv_all = jnp.concatenate([past_ckv, ckv_new], axis=1)
        kr_all = jnp.concatenate([past_kr, kr_new], axis=1)
        k_pos = jnp.arange(ckv_all.shape[1])
    Tk = ckv_all.shape[1]
    kv = (ckv_all @ w_ukv).reshape(B, Tk, H_C, D_NOPE + D_V)
    o = chunk_causal_mla(q_nope, q_rope, kv[..., :D_NOPE], kr_all, kv[..., D_NOPE:], q_pos, k_pos)
    return o.reshape(B, T, D_C), ckv_new, kr_new


def mem_attend(q, mem_k, mem_v):
    s = jnp.einsum('bqhd,bkhd->bhqk', q, mem_k).astype(jnp.float32) * (DH_M ** -0.5)
    p = jax.nn.softmax(s, axis=-1).astype(mem_v.dtype)
    return jnp.einsum('bhqk,bkhd->bqhd', p, mem_v)


def trunk_layer(x, pos, mem_k, mem_v, past_ckv, past_kr, conv0, h0,
                w_in, gmlp_ln_g, gmlp_ln_b, gmlp_ws, gmlp_bs,
                lru_conv_w, lru_conv_b, lru_w_r, lru_b_r, lru_w_i, lru_b_i, lru_lambda,
                mla_q_norm, mla_w_uq, mla_kv_norm, mla_w_ukv, w_br, w_out, ln_g, ln_b):
    B, T, _ = x.shape
    (a_u, a_v, a_g, b_x, b_g, c_q, c_kv, c_kr, c_g, m_q, gate_logits) = split_cols(x @ w_in)
    oa, v_rows = gmlp_branch(a_u, a_v, gmlp_ln_g, gmlp_ln_b, gmlp_ws, gmlp_bs)
    oa = oa * jax.nn.silu(a_g)
    ob, conv_new, h_new = rglru_branch(b_x, conv0, h0, lru_conv_w, lru_conv_b,
                                       lru_w_r, lru_b_r, lru_w_i, lru_b_i, lru_lambda)
    ob = ob * jax.nn.silu(b_g)
    oc, ckv_new, kr_new = mla_branch(c_q, c_kv, c_kr, mla_q_norm, mla_w_uq, mla_kv_norm, mla_w_ukv,
                                     pos, past_ckv, past_kr)
    oc = oc * jax.nn.silu(c_g)
    om = mem_attend(m_q.reshape(B, T, H_M, DH_M), mem_k, mem_v).reshape(B, T, D_M)
    g = jax.nn.sigmoid(gate_logits.astype(jnp.float32)).astype(x.dtype).reshape(B, T, N_BRANCH, D_MODEL)
    ya = oa @ w_br[:D_A]
    yb = ob @ w_br[D_A:D_A + D_B]
    yc = oc @ w_br[D_A + D_B:D_A + D_B + D_C]
    ym = om @ w_br[D_A + D_B + D_C:]
    merged = g[:, :, 0] * ya + g[:, :, 1] * yb + g[:, :, 2] * yc + g[:, :, 3] * ym
    y = merged @ w_out
    x_new = layer_norm(ALPHA * x + y, ln_g, ln_b)
    return x_new, v_rows, conv_new, h_new, ckv_new, kr_new


def setup_inputs(seed: int = 0) -> dict:
    key = jax.random.key(seed)
    ks = iter(jax.random.split(key, 48))
    def nrm(shape, scale):
        return jax.random.normal(next(ks), shape, jnp.float32) * scale
    a0 = jax.random.uniform(next(ks), (DEPTH, D_B), jnp.float32, minval=0.9, maxval=0.999)
    p0 = a0 ** (1.0 / LRU_C)
    lru_lambda = jnp.log(p0) - jnp.log1p(-p0)
    w_br = jnp.concatenate([nrm((DEPTH, D_A, D_MODEL), BETA * D_A ** -0.5),
                            nrm((DEPTH, D_B, D_MODEL), BETA * D_B ** -0.5),
                            nrm((DEPTH, D_C, D_MODEL), BETA * D_C ** -0.5),
                            nrm((DEPTH, D_M, D_MODEL), BETA * D_M ** -0.5)], axis=1)
    return {
        'x_prompt': nrm((BATCH, SEQ, D_MODEL), 1.0),
        'x_sample': nrm((DEC_BATCH, DEC_SEQ, D_MODEL), 1.0),
        'mem_prompt': nrm((BATCH, N_MEM, D_MODEL), 1.0),
        'cache_mla_ckv': nrm((DEPTH, DEC_BATCH, PAST_LEN, KV_LORA), 1.0),
        'cache_mla_krope': nrm((DEPTH, DEC_BATCH, PAST_LEN, D_ROPE), 1.0),
        'cache_mem_k': nrm((DEPTH, DEC_BATCH, N_MEM, H_M, DH_M), 1.0),
        'cache_mem_v': nrm((DEPTH, DEC_BATCH, N_MEM, H_M, DH_M), 1.0),
        'state_lru_h': nrm((DEPTH, DEC_BATCH, D_B), 0.5),
        'state_lru_conv': nrm((DEPTH, DEC_BATCH, CONV_W - 1, D_B), 1.0),
        'w_in': nrm((DEPTH, D_MODEL, D_IN), D_MODEL ** -0.5),
        'gmlp_ln_g': 1.0 + nrm((DEPTH, D_A), 0.02),
        'gmlp_ln_b': nrm((DEPTH, D_A), 0.02),
        'gmlp_ws': nrm((DEPTH, G_A, A_CHUNK, A_CHUNK), 0.5 * A_CHUNK ** -0.5),
        'gmlp_bs': 1.0 + nrm((DEPTH, G_A, A_CHUNK), 0.1),
        'lru_conv_w': nrm((DEPTH, CONV_W, D_B), CONV_W ** -0.5),
        'lru_conv_b': nrm((DEPTH, D_B), 0.02),
        'lru_w_r': nrm((DEPTH, H_B, DH_B, DH_B), DH_B ** -0.5),
        'lru_b_r': nrm((DEPTH, D_B), 0.02),
        'lru_w_i': nrm((DEPTH, H_B, DH_B, DH_B), DH_B ** -0.5),
        'lru_b_i': nrm((DEPTH, D_B), 0.02),
        'lru_lambda': lru_lambda,
        'mla_q_norm': 1.0 + nrm((DEPTH, Q_LORA), 0.02),
        'mla_w_uq': nrm((DEPTH, Q_LORA, H_C * (D_NOPE + D_ROPE)), Q_LORA ** -0.5),
        'mla_kv_norm': 1.0 + nrm((DEPTH, KV_LORA), 0.02),
        'mla_w_ukv': nrm((DEPTH, KV_LORA, H_C * (D_NOPE + D_V)), KV_LORA ** -0.5),
        'mem_w_k': nrm((DEPTH, D_MODEL, D_M), D_MODEL ** -0.5),
        'mem_w_v': nrm((DEPTH, D_MODEL, D_M), D_MODEL ** -0.5),
        'w_br': w_br,
        'w_out': nrm((DEPTH, D_MODEL, D_MODEL), BETA * D_MODEL ** -0.5),
        'ln_g': 1.0 + nrm((DEPTH, D_MODEL), 0.02),
        'ln_b': nrm((DEPTH, D_MODEL), 0.02),
    }


def reference(x_prompt, x_sample, mem_prompt, cache_mla_ckv, cache_mla_krope, cache_mem_k, cache_mem_v,
              state_lru_h, state_lru_conv, w_in, gmlp_ln_g, gmlp_ln_b, gmlp_ws, gmlp_bs,
              lru_conv_w, lru_conv_b, lru_w_r, lru_b_r, lru_w_i, lru_b_i, lru_lambda,
              mla_q_norm, mla_w_uq, mla_kv_norm, mla_w_ukv, mem_w_k, mem_w_v, w_br, w_out, ln_g, ln_b):
    Bp, Tp, _ = x_prompt.shape
    Bs, Ts, _ = x_sample.shape
    pos_p = jnp.arange(Tp)
    pos_s = PAST_LEN + jnp.arange(Ts)
    xp, xs = x_prompt, x_sample
    p_ckv, p_kr, p_mk, p_mv, p_h, p_conv = [], [], [], [], [], []
    s_ckv, s_kr, s_h, s_conv, s_v = [], [], [], [], []
    for l in range(DEPTH):
        lw = (w_in[l], gmlp_ln_g[l], gmlp_ln_b[l], gmlp_ws[l], gmlp_bs[l],
              lru_conv_w[l], lru_conv_b[l], lru_w_r[l], lru_b_r[l], lru_w_i[l], lru_b_i[l], lru_lambda[l],
              mla_q_norm[l], mla_w_uq[l], mla_kv_norm[l], mla_w_ukv[l], w_br[l], w_out[l], ln_g[l], ln_b[l])
        mk = (mem_prompt @ mem_w_k[l]).reshape(Bp, N_MEM, H_M, DH_M)
        mv = (mem_prompt @ mem_w_v[l]).reshape(Bp, N_MEM, H_M, DH_M)
        conv0 = jnp.zeros((Bp, CONV_W - 1, D_B), xp.dtype)
        h0 = jnp.zeros((Bp, D_B), xp.dtype)
        xp, _, conv_n, h_n, ckv_n, kr_n = trunk_layer(xp, pos_p, mk, mv, None, None, conv0, h0, *lw)
        p_ckv.append(ckv_n); p_kr.append(kr_n); p_mk.append(mk); p_mv.append(mv)
        p_h.append(h_n); p_conv.append(conv_n)
        xs, v_n, conv_n, h_n, ckv_n, kr_n = trunk_layer(
            xs, pos_s, cache_mem_k[l], cache_mem_v[l], cache_mla_ckv[l], cache_mla_krope[l],
            state_lru_conv[l], state_lru_h[l], *lw)
        s_ckv.append(ckv_n); s_kr.append(kr_n); s_h.append(h_n); s_conv.append(conv_n); s_v.append(v_n)
    return (xp, xs,
            jnp.stack(p_ckv), jnp.stack(p_kr), jnp.stack(p_mk), jnp.stack(p_mv), jnp.stack(p_h), jnp.stack(p_conv),
            jnp.stack(s_ckv), jnp.stack(s_kr), jnp.stack(s_h), jnp.stack(s_conv), jnp.stack(s_v))
```

```cpp
#include <hip/hip_runtime.h>
#include <hip/hip_cooperative_groups.h>
#include <cstdio>
namespace cg = cooperative_groups;

#define LAS __attribute__((address_space(3)))
#define DI __device__ __forceinline__
typedef unsigned short bf16_t;
typedef short bf16x8 __attribute__((ext_vector_type(8)));
typedef short s16x4 __attribute__((ext_vector_type(4)));
typedef float f32x2 __attribute__((ext_vector_type(2)));
typedef float f32x4 __attribute__((ext_vector_type(4)));
typedef float f32x16 __attribute__((ext_vector_type(16)));
typedef unsigned u32x2 __attribute__((ext_vector_type(2)));
typedef unsigned u32x4 __attribute__((ext_vector_type(4)));
typedef __bf16 bf16v2 __attribute__((ext_vector_type(2)));

constexpr int TP = 16384, NROW = 16512, MROWS = 16640;
constexpr int ZW = 3840;
constexpr int C_AU = 0, C_AV = 512, C_AG = 1024, C_BX = 1536, C_BG = 2048, C_CQ = 2560, C_CKV = 2816, C_CKR = 2944, C_CG = 2976, C_MQ = 3488;
constexpr int KVROWS = 24832, SKEYS = 1040;
constexpr float LN_EPS = 1e-6f;
constexpr float ALPHA_RES = 1.41421356237f;

constexpr size_t SZ_WIN = (size_t)7936 * 1024 * 2, SZ_WUQ = 768 * 256 * 2, SZ_WUK = 512 * 256 * 2, SZ_WBR = (size_t)1024 * 1792 * 2, SZ_WOUT = 1024 * 1024 * 2,
                 SZ_MEMW = 512 * 1024 * 2, SZ_WRI = 8 * 128 * 64 * 2, SZ_GWS = 4 * 128 * 128 * 2;
constexpr size_t OFF_WIN = 0;
constexpr size_t OFF_WUQ = OFF_WIN + 2 * SZ_WIN;
constexpr size_t OFF_WUK = OFF_WUQ + 2 * SZ_WUQ;
constexpr size_t OFF_WUV = OFF_WUK + 2 * SZ_WUK;
constexpr size_t OFF_WBR = OFF_WUV + 2 * SZ_WUK;
constexpr size_t OFF_WOUT = OFF_WBR + 2 * SZ_WBR;
constexpr size_t OFF_MEMW = OFF_WOUT + 2 * SZ_WOUT;
constexpr size_t OFF_WRI = OFF_MEMW + 2 * SZ_MEMW;
constexpr size_t OFF_GWS = OFF_WRI + 2 * SZ_WRI;
constexpr size_t OFF_XB = OFF_GWS + 2 * SZ_GWS;
constexpr size_t OFF_MEMB = OFF_XB + (size_t)MROWS * 1024 * 2;
constexpr size_t OFF_MK = OFF_MEMB + (size_t)1024 * 1024 * 2;
constexpr size_t OFF_MVT = OFF_MK + 1024 * 256 * 2;
constexpr size_t OFF_MKS = OFF_MVT + 256 * 1024 * 2;
constexpr size_t OFF_MVTS = OFF_MKS + (size_t)2 * 2048 * 256 * 2;
constexpr size_t OFF_Z = OFF_MVTS + (size_t)2 * 2048 * 256 * 2;
constexpr size_t OFF_VT = OFF_Z + (size_t)MROWS * ZW * 2;
constexpr size_t OFF_MERGED = OFF_VT;
constexpr size_t OFF_STATS = OFF_VT + (size_t)MROWS * 1024 * 2;
constexpr size_t OFF_AGG = OFF_STATS + (size_t)2 * MROWS * 2 * 4;
constexpr size_t WS_NEED = OFF_AGG + (size_t)1024 * 128 * 4;
static_assert(WS_NEED <= (size_t)256 * 1024 * 1024, "workspace over 256 MiB");
constexpr size_t DO_Q = 0;
constexpr size_t DO_CKV = DO_Q + (size_t)MROWS * 768 * 2;
constexpr size_t DO_KR = DO_CKV + (size_t)KVROWS * 256 * 2;
constexpr size_t DO_KN = DO_KR + (size_t)KVROWS * 32 * 2;
constexpr size_t DO_END = DO_KN + (size_t)KVROWS * 512 * 2;
constexpr size_t DO_GSCR = 0;
static_assert(DO_END <= (size_t)NROW * 4096, "scratch in d_out too large");
static_assert((size_t)256 * 16 * 512 * 16 <= (size_t)NROW * 4096, "gscr too large");
constexpr size_t O_YS = 16777216, O_PCKV = 16908288, O_PKR = 21102592, O_PMK = 22151168, O_PMV = 22675456, O_PH = 23199744, O_PCONV = 23203840,
                 O_SCKV = 23216128, O_SKR = 23248896, O_SH = 23257088, O_SCONV = 23265280, O_SGV = 23289856;

struct Params {
    const float* in[31];
    float* out;
    unsigned char* ws;
};
typedef const __attribute__((address_space(4))) Params* KP;

DI float bf2f(unsigned short b) { return __uint_as_float(((unsigned)b) << 16); }
DI float bflo(unsigned w) { return __uint_as_float(w << 16); }
DI float bfhi(unsigned w) { return __uint_as_float(w & 0xffff0000u); }
DI unsigned cvt_pk(float lo, float hi) { f32x2 v = {lo, hi}; return __builtin_bit_cast(unsigned, __builtin_convertvector(v, bf16v2)); }
DI unsigned short f2bf(float x) { return (unsigned short)(cvt_pk(x, x) & 0xffffu); }
DI u32x4 pack8(f32x4 a, f32x4 b) { u32x4 w; w.x = cvt_pk(a[0], a[1]); w.y = cvt_pk(a[2], a[3]); w.z = cvt_pk(b[0], b[1]); w.w = cvt_pk(b[2], b[3]); return w; }
DI void unpack8(u32x4 w, float* f) { f[0] = bflo(w.x); f[1] = bfhi(w.x); f[2] = bflo(w.y); f[3] = bfhi(w.y); f[4] = bflo(w.z); f[5] = bfhi(w.z); f[6] = bflo(w.w); f[7] = bfhi(w.w); }
DI float fsigmoid(float x) { return __builtin_amdgcn_rcpf(1.f + __expf(-x)); }
DI float fsilu(float x) { return x * fsigmoid(x); }
DI float fgelu(float x) { return x * fsigmoid(1.5957691216f * (x + 0.044715f * x * x * x)); }
DI float wave_sum(float v) {
#pragma unroll
    for (int o = 32; o >= 1; o >>= 1) v += __shfl_xor(v, o);
    return v;
}
DI int crow(int reg, int h) { return (reg & 3) + 8 * (reg >> 2) + 4 * h; }
#define MFMA32(a, b, c) __builtin_amdgcn_mfma_f32_32x32x16_bf16((a), (b), (c), 0, 0, 0)

constexpr int HTB = 128 * 64 * 2;
DI int lds_byte(int r, int c) { const int st = (r >> 4) * 2 + (c >> 5), rr = r & 15, cc = c & 31, ob = rr * 64 + cc * 2; return st * 1024 + (ob ^ (((ob >> 9) & 1) << 5)); }
DI void stage_rc(int b, int& R, int& C) { const int st = b / 1024, sb = b % 1024, swz = sb ^ (((sb >> 9) & 1) << 5); R = (st >> 1) * 16 + swz / 64; C = (st & 1) * 32 + (swz % 64) / 2; }
DI int perm32(int rho) { const int n = rho >> 4, i = rho & 15; return 8 * (i >> 2) + 4 * n + (i & 3); }

enum { K_Z = 0, K_MEMKV = 1, K_PLAIN = 2, K_QP = 3, K_EG = 4, K_EY = 5, K_F = 6 };
struct GU {
    const char* A; const char* B;
    int lda, ldb;
    int nt;
    int kind, pm, pn, aux;
    bf16_t* C; int ldc;
};

DI bool next_unit(KP p, int gph, int l, int i, GU& u, int wg, int G) {
    unsigned char* ws = p->ws; unsigned char* dob = (unsigned char*)p->out;
    u.aux = 0; u.C = nullptr; u.ldc = 0;
    if (gph == 0) {
        int L = i * G + wg;
        if (L < 975) { u.pn = L / 65; u.pm = L % 65; u.A = (const char*)(ws + OFF_XB) + (size_t)u.pm * 256 * 2048; u.B = (const char*)(ws + OFF_WIN + l * SZ_WIN) + (size_t)u.pn * 256 * 2048;
            u.lda = 2048; u.ldb = 2048; u.nt = 16; u.kind = K_Z; return true; }
        L -= 975;
        if (L < 8) { u.pm = L & 3; u.pn = L >> 2; u.A = (const char*)(ws + OFF_MEMB) + (size_t)u.pm * 256 * 2048; u.B = (const char*)(ws + OFF_MEMW + l * SZ_MEMW) + (size_t)u.pn * 256 * 2048;
            u.lda = 2048; u.ldb = 2048; u.nt = 16; u.kind = K_MEMKV; return true; }
        if (L < 12) { u.pm = 0; u.pn = L - 8; u.A = (const char*)(ws + OFF_MEMW + l * SZ_MEMW) + (size_t)256 * 2048; u.B = (const char*)(ws + OFF_MEMB) + (size_t)u.pn * 256 * 2048;
            u.lda = 2048; u.ldb = 2048; u.nt = 16; u.kind = K_PLAIN; u.C = (bf16_t*)(ws + OFF_MVT); u.ldc = 1024; return true; }
        return false;
    } else if (gph == 1) {
        int L = i * G + wg;
        if (L < 195) { u.pm = L % 65; u.pn = L / 65; u.A = (const char*)(ws + OFF_Z) + (size_t)u.pm * 256 * (ZW * 2) + C_CQ * 2; u.lda = ZW * 2;
            u.B = (const char*)(ws + OFF_WUQ + l * SZ_WUQ) + (size_t)u.pn * 256 * 512; u.ldb = 512; u.nt = 4; u.kind = K_QP; return true; }
        L -= 195;
        if (L < 194) { u.pm = L % 97; u.pn = L / 97; u.A = (const char*)(dob + DO_CKV) + (size_t)u.pm * 256 * 512; u.lda = 512;
            u.B = (const char*)(ws + OFF_WUK + l * SZ_WUK) + (size_t)u.pn * 256 * 512; u.ldb = 512; u.nt = 4; u.kind = K_PLAIN; u.C = (bf16_t*)(dob + DO_KN); u.ldc = 512; return true; }
        L -= 194;
        if (L < 194) { u.pm = L / 97; u.pn = L % 97; u.A = (const char*)(ws + OFF_WUV + l * SZ_WUK) + (size_t)u.pm * 256 * 512; u.lda = 512;
            u.B = (const char*)(dob + DO_CKV) + (size_t)u.pn * 256 * 512; u.ldb = 512; u.nt = 4; u.kind = K_PLAIN; u.C = (bf16_t*)(ws + OFF_VT); u.ldc = KVROWS; return true; }
        return false;
    } else if (gph == 2) {
        const int rr = i >> 3, sub = i & 7, tt = wg + G * rr;
        if (tt >= 260) return false;
        u.pm = tt % 65; u.pn = tt / 65; const int ib = sub >> 1; u.aux = ib;
        if ((sub & 1) == 0) { u.A = (const char*)(ws + OFF_XB) + (size_t)u.pm * 256 * 2048; u.lda = 2048;
            u.B = (const char*)(ws + OFF_WIN + l * SZ_WIN) + (size_t)(3840 + ib * 1024 + u.pn * 256) * 2048; u.ldb = 2048; u.nt = 16; u.kind = K_EG; }
        else { const int zc = ib == 0 ? C_AU : ib == 1 ? C_BG : ib == 2 ? C_CG : C_MQ;
            u.A = (const char*)(ws + OFF_Z) + (size_t)u.pm * 256 * (ZW * 2) + zc * 2; u.lda = ZW * 2;
            u.B = (const char*)(ws + OFF_WBR + l * SZ_WBR) + (size_t)u.pn * 256 * 3584 + ib * 512 * 2; u.ldb = 3584; u.nt = ib < 3 ? 8 : 4; u.kind = K_EY; }
        return true;
    } else {
        const int L = i * G + wg;
        if (L >= 260) return false;
        u.pm = L % 65; u.pn = L / 65; u.A = (const char*)(ws + OFF_MERGED) + (size_t)u.pm * 256 * 2048; u.lda = 2048;
        u.B = (const char*)(ws + OFF_WOUT + l * SZ_WOUT) + (size_t)u.pn * 256 * 2048; u.ldb = 2048; u.nt = 16; u.kind = K_F; return true;
    }
}

DI void rope_pair(float& a, float& b, float pos, int jj) {
    const float freq = exp2f(-(float)jj * 0.83048202372f);
    const float ang = pos * freq;
    const float rev = __builtin_amdgcn_fractf(ang * 0.15915494309f);
    const float sn = __builtin_amdgcn_sinf(rev), cs = __builtin_amdgcn_cosf(rev);
    const float x1 = a, x2 = b;
    a = x1 * cs - x2 * sn; b = x1 * sn + x2 * cs;
}

DI void gemm_epilogue(KP p, int l, const f32x4 (&acc)[2][2][4][2], const GU& u, int tid_in, int wg) {
    unsigned char* ws = p->ws;
    int tid = tid_in; asm volatile("" : "+v"(tid));
    const int wid = tid >> 6, lane = tid & 63, wr = wid >> 2, wc = wid & 3, fr = lane & 15, fq = lane >> 4;
#pragma unroll
    for (int ai = 0; ai < 2; ++ai)
#pragma unroll
        for (int m = 0; m < 4; ++m) {
            const int row = u.pm * 256 + ai * 128 + wr * 64 + m * 16 + fr;
            float s1 = 0.f, s2 = 0.f;
#pragma unroll
            for (int bj = 0; bj < 2; ++bj) {
                const int col = u.pn * 256 + bj * 128 + wc * 32 + 8 * fq;
                f32x4 v0 = acc[ai][bj][m][0], v1 = acc[ai][bj][m][1];
                const int vec = (ai * 4 + m) * 2 + bj;
                if (u.kind == K_Z) {
                    int act = 0;
                    if (col < C_AG) act = 1; else if (col < C_BX) act = 2; else if (col < C_BG) act = 0; else if (col < C_CQ) act = 2; else if (col < C_CG) act = 0; else if (col < C_MQ) act = 2;
                    if (act == 1) {
#pragma unroll
                        for (int j = 0; j < 4; ++j) { v0[j] = fgelu(v0[j]); v1[j] = fgelu(v1[j]); }
                    } else if (act == 2) {
#pragma unroll
                        for (int j = 0; j < 4; ++j) { v0[j] = fsilu(v0[j]); v1[j] = fsilu(v1[j]); }
                    }
                    *(u32x4*)((bf16_t*)(ws + OFF_Z) + (size_t)row * ZW + col) = pack8(v0, v1);
                } else if (u.kind == K_MEMKV) {
                    float* o = p->out + (col < 256 ? O_PMK : O_PMV) + (size_t)l * 262144 + (size_t)row * 256 + (col & 255);
                    *(f32x4*)o = v0; *(f32x4*)(o + 4) = v1;
                    if (col < 256) *(u32x4*)((bf16_t*)(ws + OFF_MK) + (size_t)row * 256 + col) = pack8(v0, v1);
                } else if (u.kind == K_PLAIN) {
                    *(u32x4*)(u.C + (size_t)row * u.ldc + col) = pack8(v0, v1);
                } else if (u.kind == K_QP) {
                    const int d = col % 96;
                    if (d >= 64) {
                        const float pos = row < TP ? (float)(row & 4095) : (float)(1024 + ((row - TP) & 15));
                        const int j0 = (d - 64) >> 1;
                        float t0 = v0[0], t1 = v0[1], t2 = v0[2], t3 = v0[3], t4 = v1[0], t5 = v1[1], t6 = v1[2], t7 = v1[3];
                        rope_pair(t0, t1, pos, j0); rope_pair(t2, t3, pos, j0 + 1); rope_pair(t4, t5, pos, j0 + 2); rope_pair(t6, t7, pos, j0 + 3);
                        v0 = (f32x4){t0, t1, t2, t3}; v1 = (f32x4){t4, t5, t6, t7};
                    }
                    *(u32x4*)((bf16_t*)((unsigned char*)p->out + DO_Q) + (size_t)row * 768 + col) = pack8(v0, v1);
                } else if (u.kind == K_EG) {
#pragma unroll
                    for (int j = 0; j < 4; ++j) { v0[j] = fsigmoid(v0[j]); v1[j] = fsigmoid(v1[j]); }
                    *((u32x4*)((unsigned char*)p->out + DO_GSCR) + ((size_t)wg * 16 + vec) * 512 + tid) = pack8(v0, v1);
                } else if (u.kind == K_EY) {
                    const u32x4 gw = *((const u32x4*)((unsigned char*)p->out + DO_GSCR) + ((size_t)wg * 16 + vec) * 512 + tid);
                    float g[8]; unpack8(gw, g);
                    u32x4* mp = (u32x4*)((bf16_t*)(ws + OFF_MERGED) + (size_t)row * 1024 + col);
                    float mo[8] = {0.f, 0.f, 0.f, 0.f, 0.f, 0.f, 0.f, 0.f};
                    if (u.aux > 0) { const u32x4 mw = *mp; unpack8(mw, mo); }
#pragma unroll
                    for (int j = 0; j < 4; ++j) { v0[j] = mo[j] + g[j] * v0[j]; v1[j] = mo[4 + j] + g[4 + j] * v1[j]; }
                    *mp = pack8(v0, v1);
                } else {
                    float x[8];
                    if (l == 0) { const float* xs = row < TP ? p->in[0] + (size_t)row * 1024 + col : p->in[1] + (size_t)((row < NROW ? row : TP) - TP) * 1024 + col;
                        const f32x4 a = *(const f32x4*)xs, b = *(const f32x4*)(xs + 4);
#pragma unroll
                        for (int j = 0; j < 4; ++j) { x[j] = a[j]; x[4 + j] = b[j]; } }
                    else { const u32x4 xw = *(const u32x4*)((const bf16_t*)(ws + OFF_XB) + (size_t)row * 1024 + col); unpack8(xw, x); }
#pragma unroll
                    for (int j = 0; j < 4; ++j) { v0[j] = ALPHA_RES * x[j] + v0[j]; v1[j] = ALPHA_RES * x[4 + j] + v1[j]; s1 += v0[j] + v1[j]; s2 += v0[j] * v0[j] + v1[j] * v1[j]; }
                    if (row < NROW) { float* o = p->out + (size_t)row * 1024 + col; *(f32x4*)o = v0; *(f32x4*)(o + 4) = v1; }
                }
            }
            if (u.kind == K_F) {
                s1 += __shfl_xor(s1, 16); s1 += __shfl_xor(s1, 32); s2 += __shfl_xor(s2, 16); s2 += __shfl_xor(s2, 32);
                if (fq == 0) { float* st = (float*)(ws + OFF_STATS) + ((size_t)l * MROWS + row) * 2;
                    __hip_atomic_fetch_add(st, s1, __ATOMIC_RELAXED, __HIP_MEMORY_SCOPE_AGENT); __hip_atomic_fetch_add(st + 1, s2, __ATOMIC_RELAXED, __HIP_MEMORY_SCOPE_AGENT); }
            }
        }
}

DI void gemm_stream(KP p, int gph, int l, LAS unsigned char* lds, int tid, int wg, int G) {
    const int wid = __builtin_amdgcn_readfirstlane(tid >> 6), lane = tid & 63, wr = wid >> 2, wc = wid & 3, fr = lane & 15, fq = lane >> 4;
    const unsigned ldsw = (unsigned)wid * 1024u;
    const int aoff = lds_byte(wr * 64 + fr, fq * 8), boff = lds_byte(wc * 32 + fr, fq * 8);
#define PG8_SA(b, h) (((b) * 2 + (h)) * HTB)
#define PG8_SB(b, h) ((4 + (b) * 2 + (h)) * HTB)
#define PG8_STAGE(bufoff, gbase, voff) do { const char* _g = (const char*)(gbase); asm volatile("" : "+s"(_g)); _Pragma("unroll") for (int _i = 0; _i < 2; ++_i) \
        __builtin_amdgcn_global_load_lds((const unsigned*)(_g + (voff)[_i]), (LAS unsigned*)(lds + (bufoff) + ldsw + _i * 8192), 16, 0, 0); } while (0)
#define PG8_LDA(dst, b, h) do { _Pragma("unroll") for (int m = 0; m < 4; ++m) _Pragma("unroll") for (int k = 0; k < 2; ++k) dst[m][k] = *(const LAS bf16x8*)(lds + PG8_SA(b, h) + aoff + m * 2048 + k * 1024); } while (0)
#define PG8_LDB(dst, b, h) do { _Pragma("unroll") for (int n = 0; n < 2; ++n) _Pragma("unroll") for (int k = 0; k < 2; ++k) dst[n][k] = *(const LAS bf16x8*)(lds + PG8_SB(b, h) + boff + n * 2048 + k * 1024); } while (0)
#define PG8_MMA(ai, bj, At, Bt) do { __builtin_amdgcn_s_setprio(1); _Pragma("unroll") for (int m = 0; m < 4; ++m) _Pragma("unroll") for (int n = 0; n < 2; ++n) _Pragma("unroll") for (int k = 0; k < 2; ++k) \
        acc[ai][bj][m][n] = __builtin_amdgcn_mfma_f32_16x16x32_bf16(Bt[n][k], At[m][k], acc[ai][bj][m][n], 0, 0, 0); __builtin_amdgcn_s_setprio(0); } while (0)
#define PG8_WAIT_V(n) asm volatile("s_waitcnt vmcnt(" #n ")" ::: "memory")
#define PG8_WAIT_L(n) asm volatile("s_waitcnt lgkmcnt(" #n ")" ::: "memory")
#define PG8_BAR __builtin_amdgcn_s_barrier()
#define PG8_SCHED __builtin_amdgcn_sched_barrier(0)
#define PG8_VOFF(vA, vB, U) do { _Pragma("unroll") for (int _i = 0; _i < 2; ++_i) { int _R, _C; stage_rc(tid * 16 + _i * 8192, _R, _C); const int _Rb = (_R & ~31) + perm32(_R & 31); \
        vA[_i] = (unsigned)(_R * (U).lda + _C * 2); vB[_i] = (unsigned)(_Rb * (U).ldb + _C * 2); } } while (0)
    GU cur, nxt; int ui = 0;
    if (!next_unit(p, gph, l, 0, cur, wg, G)) return;
    f32x4 acc[2][2][4][2];
#pragma unroll
    for (int a = 0; a < 2; ++a)
#pragma unroll
        for (int b = 0; b < 2; ++b)
#pragma unroll
            for (int m = 0; m < 4; ++m)
#pragma unroll
                for (int n = 0; n < 2; ++n) acc[a][b][m][n] = (f32x4){0.f, 0.f, 0.f, 0.f};
    bf16x8 At[4][2], B0[2][2], B1[2][2];
    unsigned cvA[2], cvB[2];
    PG8_VOFF(cvA, cvB, cur);
    const char* cA = cur.A; const char* cB = cur.B;
    size_t chA = (size_t)128 * cur.lda, chB = (size_t)128 * cur.ldb;
    const size_t kstep = 128;
    PG8_STAGE(PG8_SB(0, 0), cB, cvB); PG8_STAGE(PG8_SA(0, 0), cA, cvA); PG8_STAGE(PG8_SB(0, 1), cB + chB, cvB); PG8_STAGE(PG8_SA(0, 1), cA + chA, cvA);
    if (wr == 1) PG8_BAR;
    PG8_WAIT_V(4); PG8_BAR;
    PG8_STAGE(PG8_SB(1, 0), cB + kstep, cvB); PG8_STAGE(PG8_SA(1, 0), cA + kstep, cvA); PG8_STAGE(PG8_SB(1, 1), cB + chB + kstep, cvB);
    PG8_WAIT_V(6); PG8_BAR;
    for (;;) {
        const bool has_next = next_unit(p, gph, l, ui + 1, nxt, wg, G);
        if (!has_next) nxt = cur;
        const char* nA = nxt.A; const char* nB = nxt.B;
        const size_t nhA = (size_t)128 * nxt.lda, nhB = (size_t)128 * nxt.ldb;
        const int nt = cur.nt;
        for (int t = 0; t < nt; t += 2) {
            const bool last = (t == nt - 2);
            const char* a1 = cA + (size_t)(t + 1) * kstep;
            const char* a2 = last ? nA : cA + (size_t)(t + 2) * kstep; const char* b2 = last ? nB : cB + (size_t)(t + 2) * kstep;
            const char* a3 = a2 + kstep; const char* b3 = b2 + kstep;
            unsigned vA2[2], vB2[2];
            if (last) { PG8_VOFF(vA2, vB2, nxt); }
            else {
#pragma unroll
                for (int _i = 0; _i < 2; ++_i) { vA2[_i] = cvA[_i]; vB2[_i] = cvB[_i]; } }
            const size_t hA2 = last ? nhA : chA, hB2 = last ? nhB : chB;
            PG8_LDB(B0, 0, 0); PG8_SCHED; PG8_LDA(At, 0, 0); PG8_STAGE(PG8_SA(1, 1), a1 + chA, cvA);
            PG8_WAIT_L(8); PG8_BAR; PG8_WAIT_L(0); PG8_MMA(0, 0, At, B0); PG8_BAR; PG8_SCHED;
            PG8_LDB(B1, 0, 1); PG8_STAGE(PG8_SB(0, 0), b2, vB2);
            PG8_BAR; PG8_WAIT_L(0); PG8_MMA(0, 1, At, B1); PG8_BAR;
            PG8_LDA(At, 0, 1); PG8_STAGE(PG8_SA(0, 0), a2, vA2);
            PG8_BAR; PG8_WAIT_L(0); PG8_MMA(1, 0, At, B0); PG8_BAR; PG8_SCHED;
            PG8_STAGE(PG8_SB(0, 1), b2 + hB2, vB2);
            PG8_WAIT_V(6); PG8_BAR; PG8_MMA(1, 1, At, B1); PG8_BAR;
            PG8_LDB(B0, 1, 0); PG8_SCHED; PG8_LDA(At, 1, 0); PG8_STAGE(PG8_SA(0, 1), a2 + hA2, vA2);
            PG8_WAIT_L(8); PG8_BAR; PG8_WAIT_L(0); PG8_MMA(0, 0, At, B0); PG8_BAR; PG8_SCHED;
            PG8_LDB(B1, 1, 1); PG8_STAGE(PG8_SB(1, 0), b3, vB2);
            PG8_BAR; PG8_WAIT_L(0); PG8_MMA(0, 1, At, B1); PG8_BAR;
            PG8_LDA(At, 1, 1); PG8_STAGE(PG8_SA(1, 0), a3, vA2);
            PG8_BAR; PG8_WAIT_L(0); PG8_MMA(1, 0, At, B0); PG8_BAR; PG8_SCHED;
            PG8_STAGE(PG8_SB(1, 1), b3 + hB2, vB2);
            PG8_WAIT_V(6); PG8_BAR; PG8_MMA(1, 1, At, B1); PG8_BAR;
        }
        gemm_epilogue(p, l, acc, cur, tid, wg);
        if (!has_next) break;
#pragma unroll
        for (int a = 0; a < 2; ++a)
#pragma unroll
            for (int b = 0; b < 2; ++b)
#pragma unroll
                for (int m = 0; m < 4; ++m)
#pragma unroll
                    for (int n = 0; n < 2; ++n) acc[a][b][m][n] = (f32x4){0.f, 0.f, 0.f, 0.f};
        cur = nxt; cA = nA; cB = nB; chA = nhA; chB = nhB;
        PG8_VOFF(cvA, cvB, cur);
        ++ui;
    }
    PG8_WAIT_V(0);
    if (wr == 0) PG8_BAR;
    PG8_BAR;
}

struct TJob { const float* src; int lds_, Ks; bf16_t* dst; int ldd, nN, nK, map; };
DI int tmap(int kind, int n) {
    if (kind == 0) return n;
    if (kind == 1) return n < 3744 ? n : (n < 3840 ? -1 : n - 96);
    if (kind == 2) { const int h = n / 96, d = n % 96; if (d < 64) return n; const int jj = (d - 64) >> 1, e = (d - 64) & 1; return h * 96 + 64 + jj + 16 * e; }
    if (kind == 3) { const int h = n >> 6, d = n & 63; return h * 128 + d; }
    const int h = n >> 6, d = n & 63; return h * 128 + 64 + d;
}
DI bool tjob(KP p, int j, TJob& t) {
    unsigned char* ws = p->ws;
    if (j < 18) { const int l = j / 9, k = j % 9;
        switch (k) {
        case 0: t = {p->in[9] + (size_t)l * 1024 * 7840, 7840, 1024, (bf16_t*)(ws + OFF_WIN + l * SZ_WIN), 1024, 124, 16, 1}; break;
        case 1: t = {p->in[22] + (size_t)l * 256 * 768, 768, 256, (bf16_t*)(ws + OFF_WUQ + l * SZ_WUQ), 256, 12, 4, 2}; break;
        case 2: t = {p->in[24] + (size_t)l * 128 * 1024, 1024, 128, (bf16_t*)(ws + OFF_WUK + l * SZ_WUK), 256, 8, 4, 3}; break;
        case 3: t = {p->in[24] + (size_t)l * 128 * 1024, 1024, 128, (bf16_t*)(ws + OFF_WUV + l * SZ_WUK), 256, 8, 4, 4}; break;
        case 4: t = {p->in[27] + (size_t)l * 1792 * 1024, 1024, 1792, (bf16_t*)(ws + OFF_WBR + l * SZ_WBR), 1792, 16, 28, 0}; break;
        case 5: t = {p->in[28] + (size_t)l * 1024 * 1024, 1024, 1024, (bf16_t*)(ws + OFF_WOUT + l * SZ_WOUT), 1024, 16, 16, 0}; break;
        case 6: t = {p->in[25] + (size_t)l * 1024 * 256, 256, 1024, (bf16_t*)(ws + OFF_MEMW + l * SZ_MEMW), 1024, 4, 16, 0}; break;
        case 7: t = {p->in[26] + (size_t)l * 1024 * 256, 256, 1024, (bf16_t*)(ws + OFF_MEMW + l * SZ_MEMW) + 256 * 1024, 1024, 4, 16, 0}; break;
        default: t = {p->in[6] + (size_t)l * 8 * 65536, 256, 256, (bf16_t*)(ws + OFF_MVTS) + (size_t)l * 8 * 65536, 256, 4, 4, 0}; break;
        }
        return true; }
    j -= 18;
    if (j < 14) { const int l = j / 7, b = j % 7 + 1; t = {p->in[6] + (size_t)(l * 8 + b) * 65536, 256, 256, (bf16_t*)(ws + OFF_MVTS) + (size_t)(l * 8 + b) * 65536, 256, 4, 4, 0}; return true; }
    j -= 14;
    if (j < 32) { const int l = j / 16, r = j % 16, hb = r >> 1, gi = r & 1;
        t = {p->in[gi ? 18 : 16] + (size_t)(l * 8 + hb) * 4096, 64, 64, (bf16_t*)(ws + OFF_WRI + l * SZ_WRI) + hb * 8192 + gi * 4096, 64, 1, 1, 0}; return true; }
    return false;
}

DI void prep_phase(KP p, LAS unsigned char* lds, int tid) {
    const int G = gridDim.x, wg = blockIdx.x;
    unsigned char* ws = p->ws;
    {
        bf16_t* XB = (bf16_t*)(ws + OFF_XB);
        const size_t nvec = (size_t)MROWS * 1024 / 8;
        for (size_t v = (size_t)wg * 512 + tid; v < nvec; v += (size_t)G * 512) {
            const size_t e = v * 8; const int row = (int)(e >> 10);
            u32x4 o = {0u, 0u, 0u, 0u};
            if (row < NROW) { const float* src = row < TP ? p->in[0] + e : p->in[1] + (e - (size_t)TP * 1024); o = pack8(*(const f32x4*)src, *(const f32x4*)(src + 4)); }
            *(u32x4*)(XB + e) = o;
        }
    }
    {
        bf16_t* MB = (bf16_t*)(ws + OFF_MEMB);
        for (size_t v = (size_t)wg * 512 + tid; v < (size_t)1024 * 1024 / 8; v += (size_t)G * 512) { const float* s = p->in[2] + v * 8; *(u32x4*)(MB + v * 8) = pack8(*(const f32x4*)s, *(const f32x4*)(s + 4)); }
        bf16_t* MKS = (bf16_t*)(ws + OFF_MKS);
        for (size_t v = (size_t)wg * 512 + tid; v < (size_t)2 * 2048 * 256 / 8; v += (size_t)G * 512) { const float* s = p->in[5] + v * 8; *(u32x4*)(MKS + v * 8) = pack8(*(const f32x4*)s, *(const f32x4*)(s + 4)); }
        bf16_t* GW = (bf16_t*)(ws + OFF_GWS);
        for (size_t v = (size_t)wg * 512 + tid; v < (size_t)2 * 4 * 128 * 128 / 8; v += (size_t)G * 512) {
            const size_t e = v * 8; const int q0 = (int)(e & 127), pr = (int)((e >> 7) & 127); const float* s = p->in[12] + e;
            f32x4 a = *(const f32x4*)s, b = *(const f32x4*)(s + 4);
#pragma unroll
            for (int j = 0; j < 4; ++j) { if (q0 + j > pr) a[j] = 0.f; if (q0 + 4 + j > pr) b[j] = 0.f; }
            *(u32x4*)(GW + e) = pack8(a, b); }
        float* st = (float*)(ws + OFF_STATS);
        for (size_t v = (size_t)wg * 512 + tid; v < (size_t)2 * MROWS * 2; v += (size_t)G * 512) st[v] = 0.f;
    }
    LAS float* tile = (LAS float*)lds;
    int base = 0;
    for (int j = 0;; ++j) {
        TJob t; if (!tjob(p, j, t)) break;
        const int ntile = t.nN * t.nK;
        int first = wg - (base % G); if (first < 0) first += G;
        for (int tt = first; tt < ntile; tt += G) {
            const int tn = tt / t.nK, tk = tt % t.nK, n0 = tn * 64, k0 = tk * 64;
            __syncthreads();
            for (int e = tid; e < 4096; e += 512) { const int kk = e >> 6, nn = e & 63; const int sc = tmap(t.map, n0 + nn); const int k = k0 + kk;
                tile[kk * 65 + nn] = (sc >= 0 && k < t.Ks) ? t.src[(size_t)k * t.lds_ + sc] : 0.f; }
            __syncthreads();
            for (int e = tid; e < 2048; e += 512) { const int nn = e >> 5, k2 = (e & 31) * 2;
                *(unsigned*)(t.dst + (size_t)(n0 + nn) * t.ldd + k0 + k2) = cvt_pk(tile[k2 * 65 + nn], tile[(k2 + 1) * 65 + nn]); }
        }
        base += ntile;
    }
    __syncthreads();
}

DI void rows_phase(KP p, int l, int tid) {
    const int G = gridDim.x, lane = tid & 63, gw = blockIdx.x * 8 + (tid >> 6), nw = G * 8;
    unsigned char* ws = p->ws; unsigned char* dob = (unsigned char*)p->out;
    bf16_t* Z = (bf16_t*)(ws + OFF_Z); bf16_t* CKV = (bf16_t*)(dob + DO_CKV); bf16_t* KR = (bf16_t*)(dob + DO_KR);
    for (int it = gw; it < NROW + 8192 + 36 + 128; it += nw) {
        if (it < NROW) {
            const int row = it; const bool smp = row >= TP; const int srow = row - TP;
            bf16_t* zr = Z + (size_t)row * ZW;
            {
                const u32x4 raw = *(const u32x4*)(zr + C_AV + lane * 8); float x[8]; unpack8(raw, x);
                float s = 0.f;
#pragma unroll
                for (int j = 0; j < 8; ++j) s += x[j];
                const float mean = wave_sum(s) * (1.f / 512.f);
                float q = 0.f;
#pragma unroll
                for (int j = 0; j < 8; ++j) { x[j] -= mean; q += x[j] * x[j]; }
                const float rstd = rsqrtf(wave_sum(q) * (1.f / 512.f) + LN_EPS);
                const float* gg = p->in[10] + l * 512 + lane * 8; const float* bb = p->in[11] + l * 512 + lane * 8;
                f32x4 y0, y1;
#pragma unroll
                for (int j = 0; j < 4; ++j) { y0[j] = x[j] * rstd * gg[j] + bb[j]; y1[j] = x[4 + j] * rstd * gg[4 + j] + bb[4 + j]; }
                *(u32x4*)(zr + C_AV + lane * 8) = pack8(y0, y1);
                if (smp) { float* o = p->out + O_SGV + (size_t)l * 65536 + (size_t)srow * 512 + lane * 8; *(f32x4*)o = y0; *(f32x4*)(o + 4) = y1; }
            }
            {
                const u32x2 raw = *(const u32x2*)(zr + C_CQ + lane * 4);
                float x[4] = {bflo(raw.x), bfhi(raw.x), bflo(raw.y), bfhi(raw.y)};
                const float ss = wave_sum(x[0] * x[0] + x[1] * x[1] + x[2] * x[2] + x[3] * x[3]);
                const float r = rsqrtf(ss * (1.f / 256.f) + LN_EPS);
                const float* gq = p->in[21] + l * 256 + lane * 4;
                u32x2 o; o.x = cvt_pk(x[0] * r * gq[0], x[1] * r * gq[1]); o.y = cvt_pk(x[2] * r * gq[2], x[3] * r * gq[3]);
                *(u32x2*)(zr + C_CQ + lane * 4) = o;
            }
            const int kvrow = smp ? TP + (srow >> 4) * SKEYS + 1024 + (srow & 15) : row;
            {
                const unsigned raw = *(const unsigned*)(zr + C_CKV + lane * 2);
                const float x0 = bflo(raw), x1 = bfhi(raw);
                const float ss = wave_sum(x0 * x0 + x1 * x1);
                const float r = rsqrtf(ss * (1.f / 128.f) + LN_EPS);
                const float* gk = p->in[23] + l * 128 + lane * 2;
                const float y0 = x0 * r * gk[0], y1 = x1 * r * gk[1];
                float* o = smp ? p->out + O_SCKV + (size_t)l * 16384 + (size_t)srow * 128 + lane * 2 : p->out + O_PCKV + (size_t)l * 2097152 + (size_t)row * 128 + lane * 2;
                *(f32x2*)o = (f32x2){y0, y1};
                *(unsigned*)(CKV + (size_t)kvrow * 256 + lane * 2) = cvt_pk(y0, y1);
                *(unsigned*)(CKV + (size_t)kvrow * 256 + 128 + lane * 2) = 0u;
            }
            if (lane < 16) {
                float a = bf2f(zr[C_CKR + lane]), b = bf2f(zr[C_CKR + 16 + lane]);
                const float pos = smp ? (float)(1024 + (srow & 15)) : (float)(row & 4095);
                rope_pair(a, b, pos, lane);
                float* o = smp ? p->out + O_SKR + (size_t)l * 4096 + (size_t)srow * 32 : p->out + O_PKR + (size_t)l * 524288 + (size_t)row * 32;
                o[lane] = a; o[lane + 16] = b;
                *(unsigned*)(KR + (size_t)kvrow * 32 + lane * 2) = cvt_pk(a, b);
            }
        } else if (it < NROW + 8192) {
            const int idx = it - NROW, b = idx >> 10, j = idx & 1023; const int dst = TP + b * SKEYS + j;
            const float* s = p->in[3] + ((size_t)(l * 8 + b) * 1024 + j) * 128 + lane * 2;
            *(unsigned*)(CKV + (size_t)dst * 256 + lane * 2) = cvt_pk(s[0], s[1]);
            *(unsigned*)(CKV + (size_t)dst * 256 + 128 + lane * 2) = 0u;
            if (lane < 16) { const float* r = p->in[4] + ((size_t)(l * 8 + b) * 1024 + j) * 32; *(unsigned*)(KR + (size_t)dst * 32 + lane * 2) = cvt_pk(r[lane], r[lane + 16]); }
        } else if (it >= NROW + 8192 + 36) {
            const int dst = 24704 + (it - (NROW + 8192 + 36));
            *(u32x2*)(CKV + (size_t)dst * 256 + lane * 4) = (u32x2){0u, 0u};
        } else {
            const int idx = it - NROW - 8192; int src; float* o;
            if (idx < 12) { const int b = idx / 3, k = idx % 3; src = b * 4096 + 4093 + k; o = p->out + O_PCONV + (size_t)l * 6144 + (size_t)(b * 3 + k) * 512; }
            else { const int i2 = idx - 12, b = i2 / 3, k = i2 % 3; src = TP + b * 16 + 13 + k; o = p->out + O_SCONV + (size_t)l * 12288 + (size_t)(b * 3 + k) * 512; }
            const u32x4 raw = *(const u32x4*)(Z + (size_t)src * ZW + C_BX + lane * 8); float x[8]; unpack8(raw, x);
            *(f32x4*)(o + lane * 8) = (f32x4){x[0], x[1], x[2], x[3]}; *(f32x4*)(o + lane * 8 + 4) = (f32x4){x[4], x[5], x[6], x[7]};
        }
    }
}

DI void ln_phase(KP p, int l, int tid) {
    const int G = gridDim.x, lane = tid & 63, gw = blockIdx.x * 8 + (tid >> 6), nw = G * 8;
    unsigned char* ws = p->ws;
    const float* st = (const float*)(ws + OFF_STATS) + (size_t)l * MROWS * 2;
    bf16_t* XB = (bf16_t*)(ws + OFF_XB);
    const float* g = p->in[29] + l * 1024; const float* b = p->in[30] + l * 1024;
    for (int row = gw; row < NROW; row += nw) {
        const float mean = st[row * 2] * (1.f / 1024.f); const float var = st[row * 2 + 1] * (1.f / 1024.f) - mean * mean;
        const float rstd = rsqrtf(fmaxf(var, 0.f) + LN_EPS);
        float* vr = p->out + (size_t)row * 1024;
#pragma unroll
        for (int c = 0; c < 2; ++c) {
            const int col = c * 512 + lane * 8;
            f32x4 a = *(const f32x4*)(vr + col), bq = *(const f32x4*)(vr + col + 4);
            const f32x4 g0 = *(const f32x4*)(g + col), g1 = *(const f32x4*)(g + col + 4), b0 = *(const f32x4*)(b + col), b1 = *(const f32x4*)(b + col + 4);
#pragma unroll
            for (int j = 0; j < 4; ++j) { a[j] = (a[j] - mean) * rstd * g0[j] + b0[j]; bq[j] = (bq[j] - mean) * rstd * g1[j] + b1[j]; }
            if (l == 0) *(u32x4*)(XB + (size_t)row * 1024 + col) = pack8(a, bq);
            else { *(f32x4*)(vr + col) = a; *(f32x4*)(vr + col + 4) = bq; }
        }
    }
}

DI void gmlp_tile(KP p, int l, int b, int n, int g, LAS unsigned char* lds, int tid) {
    const int w = tid >> 6, lane = tid & 63, r = lane & 31, h = lane >> 5;
    bf16_t* Z = (bf16_t*)(p->ws + OFF_Z);
    const bf16_t* GW = (const bf16_t*)(p->ws + OFF_GWS) + (size_t)(l * 4 + g) * 16384;
    LAS bf16_t* Wl = (LAS bf16_t*)lds; LAS bf16_t* Vl = (LAS bf16_t*)(lds + 128 * 136 * 2);
    const int r0 = b * 4096 + n * 128;
    __syncthreads();
    for (int c = tid; c < 2048; c += 512) { const int rr = c >> 4, ch = c & 15;
        *(LAS u32x4*)(Wl + rr * 136 + ch * 8) = *(const u32x4*)(GW + rr * 128 + ch * 8);
        *(LAS u32x4*)(Vl + rr * 136 + ch * 8) = *(const u32x4*)(Z + (size_t)(r0 + rr) * ZW + C_AV + g * 128 + ch * 8); }
    __syncthreads();
    const int pb = w >> 1, cb0 = (w & 1) * 2;
    f32x16 acc0, acc1;
#pragma unroll
    for (int i = 0; i < 16; ++i) { acc0[i] = 0.f; acc1[i] = 0.f; }
    for (int s = 0; s < 2 * (pb + 1); ++s) {
        const bf16x8 a = *(const LAS bf16x8*)(Wl + (32 * pb + r) * 136 + 16 * s + 8 * h);
        bf16x8 b0, b1;
#pragma unroll
        for (int j = 0; j < 8; ++j) { b0[j] = (short)Vl[(16 * s + 8 * h + j) * 136 + 32 * cb0 + r]; b1[j] = (short)Vl[(16 * s + 8 * h + j) * 136 + 32 * (cb0 + 1) + r]; }
        acc0 = MFMA32(a, b0, acc0); acc1 = MFMA32(a, b1, acc1);
    }
    const float* bs = p->in[13] + (size_t)(l * 4 + g) * 128;
#pragma unroll
    for (int i = 0; i < 16; ++i) {
        const int pr = 32 * pb + crow(i, h); const float bias = bs[pr];
        bf16_t* zr = Z + (size_t)(r0 + pr) * ZW;
#pragma unroll
        for (int cb = 0; cb < 2; ++cb) {
            const int c = g * 128 + 32 * (cb0 + cb) + r;
            const float s = (cb ? acc1[i] : acc0[i]) + bias;
            zr[C_AU + c] = f2bf(bf2f(zr[C_AU + c]) * s * bf2f(zr[C_AG + c]));
        }
    }
}
DI void gmlp_sample(KP p, int l, int b, int g, int tid) {
    const int c = tid & 127, p0 = (tid >> 7) * 4;
    bf16_t* Z = (bf16_t*)(p->ws + OFF_Z);
    const float* wsrc = p->in[12] + (size_t)(l * 4 + g) * 16384; const float* bs = p->in[13] + (size_t)(l * 4 + g) * 128;
    const int r0 = TP + b * 16;
    float v[16];
#pragma unroll
    for (int q = 0; q < 16; ++q) v[q] = bf2f(Z[(size_t)(r0 + q) * ZW + C_AV + g * 128 + c]);
#pragma unroll
    for (int k = 0; k < 4; ++k) { const int pr = p0 + k; float s = bs[pr];
#pragma unroll
        for (int q = 0; q < 16; ++q) if (q <= pr) s += wsrc[pr * 128 + q] * v[q];
        bf16_t* zr = Z + (size_t)(r0 + pr) * ZW; const int cc = g * 128 + c;
        zr[C_AU + cc] = f2bf(bf2f(zr[C_AU + cc]) * s * bf2f(zr[C_AG + cc])); }
}

DI void lru_tile(KP p, int l, int bg, int hb, int seg, bool apply, LAS unsigned char* lds, int tid) {
    const int w = tid >> 6, lane = tid & 63, r = lane & 31, h = lane >> 5;
    bf16_t* Z = (bf16_t*)(p->ws + OFF_Z);
    const bool smp = bg >= 4; const int sb = bg - 4;
    const int row0 = smp ? TP + sb * 16 : bg * 4096 + seg * 128; const int ntok = smp ? 16 : 128;
    LAS float* XC = (LAS float*)lds; LAS bf16_t* XCB = (LAS bf16_t*)(lds + 32768); LAS float* GATE = (LAS float*)(lds + 51200); LAS float* AGL = (LAS float*)(lds + 116736);
    const int c = tid & 63, sub = tid >> 6, ch = hb * 64 + c;
    __syncthreads();
    {
        const float cb = p->in[15][l * 512 + ch];
        float cw[4];
#pragma unroll
        for (int k = 0; k < 4; ++k) cw[k] = p->in[14][(size_t)(l * 4 + k) * 512 + ch];
        for (int t = sub; t < 128; t += 8) {
            float a = 0.f;
            if (t < ntok) { a = cb;
#pragma unroll
                for (int k = 0; k < 4; ++k) { const int tt = t + k - 3; float x;
                    if (!smp) { const int gt = seg * 128 + tt; x = gt >= 0 ? bf2f(Z[(size_t)(bg * 4096 + gt) * ZW + C_BX + ch]) : 0.f; }
                    else x = tt >= 0 ? bf2f(Z[(size_t)(row0 + tt) * ZW + C_BX + ch]) : p->in[8][((size_t)(l * 8 + sb) * 3 + (tt + 3)) * 512 + ch];
                    a += x * cw[k]; } }
            XC[t * 64 + c] = a; XCB[t * 72 + c] = f2bf(a);
        }
    }
    __syncthreads();
    {
        const int tb = w >> 1, nb0 = (w & 1) * 2;
        const bf16_t* WT = (const bf16_t*)(p->ws + OFF_WRI + l * SZ_WRI) + hb * 8192;
        f32x16 a0, a1;
#pragma unroll
        for (int i = 0; i < 16; ++i) { a0[i] = 0.f; a1[i] = 0.f; }
#pragma unroll
        for (int s = 0; s < 4; ++s) {
            const bf16x8 a = *(const LAS bf16x8*)(XCB + (32 * tb + r) * 72 + 16 * s + 8 * h);
            const bf16x8 b0 = *(const bf16x8*)(WT + (32 * nb0 + r) * 64 + 16 * s + 8 * h), b1 = *(const bf16x8*)(WT + (32 * (nb0 + 1) + r) * 64 + 16 * s + 8 * h);
            a0 = MFMA32(a, b0, a0); a1 = MFMA32(a, b1, a1);
        }
        const int n0 = 32 * nb0 + r, n1 = n0 + 32;
        const float bias0 = n0 < 64 ? p->in[17][l * 512 + hb * 64 + n0] : p->in[19][l * 512 + hb * 64 + n0 - 64];
        const float bias1 = n1 < 64 ? p->in[17][l * 512 + hb * 64 + n1] : p->in[19][l * 512 + hb * 64 + n1 - 64];
#pragma unroll
        for (int i = 0; i < 16; ++i) { const int t = 32 * tb + crow(i, h); GATE[t * 128 + n0] = fsigmoid(a0[i] + bias0); GATE[t * 128 + n1] = fsigmoid(a1[i] + bias1); }
    }
    __syncthreads();
    float av[16], bv[16];
    {
        const float lam = p->in[20][l * 512 + ch];
        const float sp = log1pf(__expf(-lam));
        float P = 1.f, S = 0.f;
#pragma unroll
        for (int k = 0; k < 16; ++k) { const int t = sub * 16 + k;
            float a = 1.f, bb = 0.f;
            if (t < ntok) { const float rg = GATE[t * 128 + c], ig = GATE[t * 128 + 64 + c], x = XC[t * 64 + c];
                const float la = -8.f * rg * sp; a = __expf(la); bb = sqrtf(fmaxf(-expm1f(2.f * la), 0.f)) * (ig * x); }
            av[k] = a; bv[k] = bb; S = a * S + bb; P *= a; }
        AGL[sub * 64 + c] = P; AGL[512 + sub * 64 + c] = S;
    }
    __syncthreads();
    float* AGG = (float*)(p->ws + OFF_AGG);
    if (!apply) {
        if (sub == 0 && !smp) { float A = 1.f, B = 0.f;
#pragma unroll
            for (int s2 = 0; s2 < 8; ++s2) { const float P = AGL[s2 * 64 + c], S = AGL[512 + s2 * 64 + c]; B = P * B + S; A *= P; }
            float* o = AGG + (size_t)((bg * 8 + hb) * 32 + seg) * 128; o[c] = A; o[64 + c] = B; }
    } else {
        float hcar;
        if (smp) hcar = p->in[7][(size_t)(l * 8 + sb) * 512 + ch];
        else { hcar = 0.f; for (int s2 = 0; s2 < seg; ++s2) { const float* o = AGG + (size_t)((bg * 8 + hb) * 32 + s2) * 128; hcar = o[c] * hcar + o[64 + c]; } }
        for (int s2 = 0; s2 < sub; ++s2) hcar = AGL[s2 * 64 + c] * hcar + AGL[512 + s2 * 64 + c];
#pragma unroll
        for (int k = 0; k < 16; ++k) { const int t = sub * 16 + k;
            hcar = av[k] * hcar + bv[k];
            if (t < ntok) { bf16_t* zp = Z + (size_t)(row0 + t) * ZW + C_BG + ch; *zp = f2bf(hcar * bf2f(*zp));
                if (smp) { if (t == 15) p->out[O_SH + (size_t)(l * 8 + sb) * 512 + ch] = hcar; }
                else if (seg == 31 && t == 127) p->out[O_PH + (size_t)(l * 4 + bg) * 512 + ch] = hcar; } }
    }
}

struct AttnItem {
    const bf16_t* Q; int ldq, qcol, qrow0, nq;
    const bf16_t* Kn; int ldkn, kncol; const bf16_t* Kr; int krow0;
    const bf16_t* VT; int ldvt, vtrow0, vcol0;
    int nkeys, ntmax, tbase, causal;
    float scale;
    bf16_t* O; int ldo, ocol, gate;
};
template <bool ROPE>
DI void attn_item(const AttnItem& it, LAS unsigned char* lds, int tid) {
    constexpr int NK = ROPE ? 6 : 4;
    const int w = tid >> 6, lane = tid & 63, r = lane & 31, h = lane >> 5;
    LAS bf16_t* Kl = (LAS bf16_t*)lds; LAS bf16_t* VTl = (LAS bf16_t*)(lds + 64 * 104 * 2);
    const int qi = 32 * w + r; const bool qvalid = qi < it.nq; const int qrow = it.qrow0 + (qvalid ? qi : 0);
    const int mytiles = (32 * w >= it.nq) ? 0 : (it.causal ? it.tbase + (w >> 1) + 1 : it.ntmax);
    bf16x8 qf[NK];
#pragma unroll
    for (int ks = 0; ks < NK; ++ks) qf[ks] = *(const bf16x8*)(it.Q + (size_t)qrow * it.ldq + it.qcol + 16 * ks + 8 * h);
    f32x16 o0, o1;
#pragma unroll
    for (int i = 0; i < 16; ++i) { o0[i] = 0.f; o1[i] = 0.f; }
    float mrun = -1e30f, lsum = 0.f;
    const float sc = it.scale;
    const int lk = tid >> 3, lc = tid & 7, rk = tid >> 2, rc = tid & 3;
    u32x4 kreg, rreg = {0u, 0u, 0u, 0u}, vreg;
    kreg = *(const u32x4*)(it.Kn + (size_t)(it.krow0 + lk) * it.ldkn + it.kncol + lc * 8);
    if (ROPE && tid < 256) rreg = *(const u32x4*)(it.Kr + (size_t)(it.krow0 + rk) * 32 + rc * 8);
    vreg = *(const u32x4*)(it.VT + (size_t)(it.vtrow0 + lk) * it.ldvt + it.vcol0 + lc * 8);
    for (int kt = 0; kt < it.ntmax; ++kt) {
        __syncthreads();
        *(LAS u32x4*)(Kl + lk * 104 + lc * 8) = kreg;
        if (ROPE && tid < 256) *(LAS u32x4*)(Kl + rk * 104 + 64 + rc * 8) = rreg;
        *(LAS u32x4*)(VTl + lk * 72 + lc * 8) = vreg;
        __syncthreads();
        if (kt + 1 < it.ntmax) {
            const int k0 = (kt + 1) * 64;
            kreg = *(const u32x4*)(it.Kn + (size_t)(it.krow0 + k0 + lk) * it.ldkn + it.kncol + lc * 8);
            if (ROPE && tid < 256) rreg = *(const u32x4*)(it.Kr + (size_t)(it.krow0 + k0 + rk) * 32 + rc * 8);
            vreg = *(const u32x4*)(it.VT + (size_t)(it.vtrow0 + lk) * it.ldvt + it.vcol0 + k0 + lc * 8);
        }
        if (kt < mytiles) {
            f32x16 s0, s1;
#pragma unroll
            for (int i = 0; i < 16; ++i) { s0[i] = 0.f; s1[i] = 0.f; }
#pragma unroll
            for (int ks = 0; ks < NK; ++ks) {
                const bf16x8 ka0 = *(const LAS bf16x8*)(Kl + r * 104 + 16 * ks + 8 * h), ka1 = *(const LAS bf16x8*)(Kl + (32 + r) * 104 + 16 * ks + 8 * h);
                s0 = MFMA32(ka0, qf[ks], s0); s1 = MFMA32(ka1, qf[ks], s1);
            }
            if ((kt + 1) * 64 > it.nkeys) {
#pragma unroll
                for (int i = 0; i < 16; ++i) { const int key = kt * 64 + crow(i, h); if (key >= it.nkeys) s0[i] = -1e30f; if (key + 32 >= it.nkeys) s1[i] = -1e30f; }
            }
            float mx = s0[0];
#pragma unroll
            for (int i = 1; i < 16; ++i) mx = fmaxf(mx, s0[i]);
#pragma unroll
            for (int i = 0; i < 16; ++i) mx = fmaxf(mx, s1[i]);
            mx = fmaxf(mx, __shfl_xor(mx, 32));
            const float mnew = fmaxf(mrun, mx);
            const float alpha = __builtin_amdgcn_exp2f((mrun - mnew) * sc);
            mrun = mnew;
            const float mc = mnew * sc;
            float ps = 0.f;
#pragma unroll
            for (int i = 0; i < 16; ++i) { s0[i] = __builtin_amdgcn_exp2f(s0[i] * sc - mc); s1[i] = __builtin_amdgcn_exp2f(s1[i] * sc - mc); ps += s0[i] + s1[i]; }
            lsum = lsum * alpha + ps;
#pragma unroll
            for (int i = 0; i < 16; ++i) { o0[i] *= alpha; o1[i] *= alpha; }
#pragma unroll
            for (int kk = 0; kk < 4; ++kk) {
                const int s8 = (kk & 1) * 8;
                u32x4 pw;
                if (kk < 2) { pw.x = cvt_pk(s0[s8], s0[s8 + 1]); pw.y = cvt_pk(s0[s8 + 2], s0[s8 + 3]); pw.z = cvt_pk(s0[s8 + 4], s0[s8 + 5]); pw.w = cvt_pk(s0[s8 + 6], s0[s8 + 7]); }
                else { pw.x = cvt_pk(s1[s8], s1[s8 + 1]); pw.y = cvt_pk(s1[s8 + 2], s1[s8 + 3]); pw.z = cvt_pk(s1[s8 + 4], s1[s8 + 5]); pw.w = cvt_pk(s1[s8 + 6], s1[s8 + 7]); }
                const bf16x8 pf = __builtin_bit_cast(bf16x8, pw);
                const s16x4 a0l = *(const LAS s16x4*)(VTl + r * 72 + 16 * kk + 4 * h), a0h = *(const LAS s16x4*)(VTl + r * 72 + 16 * kk + 8 + 4 * h);
                const s16x4 a1l = *(const LAS s16x4*)(VTl + (32 + r) * 72 + 16 * kk + 4 * h), a1h = *(const LAS s16x4*)(VTl + (32 + r) * 72 + 16 * kk + 8 + 4 * h);
                const bf16x8 va0 = __builtin_shufflevector(a0l, a0h, 0, 1, 2, 3, 4, 5, 6, 7), va1 = __builtin_shufflevector(a1l, a1h, 0, 1, 2, 3, 4, 5, 6, 7);
                o0 = MFMA32(va0, pf, o0); o1 = MFMA32(va1, pf, o1);
            }
        }
    }
    const float ltot = lsum + __shfl_xor(lsum, 32);
    if (qvalid && mytiles > 0) {
        const float inv = 1.f / ltot;
        bf16_t* orow = it.O + (size_t)qrow * it.ldo + it.ocol;
#pragma unroll
        for (int db = 0; db < 2; ++db)
#pragma unroll
            for (int g4 = 0; g4 < 4; ++g4) {
                const int dv0 = 32 * db + 8 * g4 + 4 * h;
                float v[4];
#pragma unroll
                for (int j = 0; j < 4; ++j) v[j] = (db ? o1[4 * g4 + j] : o0[4 * g4 + j]) * inv;
                u32x2* dst = (u32x2*)(orow + dv0);
                if (it.gate) { const u32x2 gw = *dst; v[0] *= bflo(gw.x); v[1] *= bfhi(gw.x); v[2] *= bflo(gw.y); v[3] *= bfhi(gw.y); }
                u32x2 ow; ow.x = cvt_pk(v[0], v[1]); ow.y = cvt_pk(v[2], v[3]);
                *dst = ow;
            }
    }
}

__global__ void __launch_bounds__(512, 2) mega(Params pk) {
    extern __shared__ __attribute__((aligned(16))) unsigned char shm[];
    LAS unsigned char* lds = (LAS unsigned char*)shm;
    cg::grid_group grid = cg::this_grid();
    { KP p = (KP)__builtin_amdgcn_kernarg_segment_ptr(); int tid0 = threadIdx.x; asm volatile("" : "+v"(tid0)); prep_phase(p, lds, tid0); }
    grid.sync();
    for (int step = 0; step < 14; ++step) {
        const int l = step / 7, ph = step % 7;
        KP p = (KP)__builtin_amdgcn_kernarg_segment_ptr(); asm volatile("" : "+s"(p));
        int tid = threadIdx.x; asm volatile("" : "+v"(tid));
        int wg = blockIdx.x, G = gridDim.x; asm volatile("" : "+s"(wg), "+s"(G));
        unsigned char* ws = p->ws; unsigned char* dob = (unsigned char*)p->out;
        const int gph = ph == 0 ? 0 : ph == 2 ? 1 : ph == 4 ? 2 : ph == 5 ? 3 : -1;
        if (gph >= 0) gemm_stream(p, gph, l, lds, tid, wg, G);
        if (ph == 1) rows_phase(p, l, tid);
        else if (ph == 2) {
            __syncthreads();
            for (int t = wg; t < 512 + 32; t += G) {
                if (t < 512) gmlp_tile(p, l, t >> 7, (t >> 2) & 31, t & 3, lds, tid);
                else { const int s = t - 512; gmlp_sample(p, l, s >> 2, s & 3, tid); }
            }
            for (int t = wg; t < 256 + 32; t += G) {
                AttnItem it;
                it.Q = (const bf16_t*)(ws + OFF_Z); it.ldq = ZW; it.Kr = nullptr; it.scale = 0.125f * 1.44269504089f;
                it.O = (bf16_t*)(ws + OFF_Z); it.ldo = ZW; it.gate = 0; it.nkeys = 256; it.ntmax = 4; it.tbase = 0; it.causal = 0; it.krow0 = 0; it.vcol0 = 0;
                if (t < 256) { const int b = t >> 6, hh = (t >> 4) & 3, qb = t & 15;
                    it.qcol = C_MQ + hh * 64; it.qrow0 = b * 4096 + qb * 256; it.nq = 256;
                    it.Kn = (const bf16_t*)(ws + OFF_MK) + (size_t)b * 256 * 256; it.ldkn = 256; it.kncol = hh * 64;
                    it.VT = (const bf16_t*)(ws + OFF_MVT); it.ldvt = 1024; it.vtrow0 = hh * 64; it.vcol0 = b * 256; }
                else { const int s = t - 256, b = s >> 2, hh = s & 3;
                    it.qcol = C_MQ + hh * 64; it.qrow0 = TP + b * 16; it.nq = 16;
                    it.Kn = (const bf16_t*)(ws + OFF_MKS) + (size_t)(l * 8 + b) * 65536; it.ldkn = 256; it.kncol = hh * 64;
                    it.VT = (const bf16_t*)(ws + OFF_MVTS) + (size_t)(l * 8 + b) * 65536; it.ldvt = 256; it.vtrow0 = hh * 64; }
                it.ocol = it.qcol;
                attn_item<false>(it, lds, tid);
            }
            for (int t = wg; t < 1024; t += G) lru_tile(p, l, t >> 8, (t >> 5) & 7, t & 31, false, lds, tid);
        } else if (ph == 3) {
            for (int t = wg; t < 256 + 64; t += G) {
                AttnItem it;
                it.Q = (const bf16_t*)(dob + DO_Q); it.ldq = 768; it.Kn = (const bf16_t*)(dob + DO_KN); it.ldkn = 512; it.Kr = (const bf16_t*)(dob + DO_KR);
                it.VT = (const bf16_t*)(ws + OFF_VT); it.ldvt = KVROWS; it.scale = 0.10206207262f * 1.44269504089f;
                it.O = (bf16_t*)(ws + OFF_Z); it.ldo = ZW; it.gate = 1;
                if (t < 256) { const int b = t >> 6, hh = (t >> 3) & 7, x = t & 7;
                    it.qcol = hh * 96; it.kncol = hh * 64; it.krow0 = b * 4096; it.vtrow0 = hh * 64; it.vcol0 = b * 4096; it.ocol = C_CG + hh * 64; it.nq = 256; it.nkeys = 4096; it.causal = 1;
#pragma unroll 1
                    for (int half = 0; half < 2; ++half) { const int qb = half ? 15 - x : x;
                        it.qrow0 = b * 4096 + qb * 256; it.tbase = 4 * qb; it.ntmax = 4 * qb + 4;
                        attn_item<true>(it, lds, tid); } }
                else { const int s = t - 256, b = s >> 3, hh = s & 7;
                    it.qcol = hh * 96; it.kncol = hh * 64; it.krow0 = TP + b * SKEYS; it.vtrow0 = hh * 64; it.vcol0 = TP + b * SKEYS; it.ocol = C_CG + hh * 64;
                    it.qrow0 = TP + b * 16; it.nq = 16; it.nkeys = SKEYS; it.causal = 0; it.tbase = 0; it.ntmax = 17;
                    attn_item<true>(it, lds, tid); }
            }
            for (int t = wg; t < 1024 + 64; t += G) {
                if (t < 1024) lru_tile(p, l, t >> 8, (t >> 5) & 7, t & 31, true, lds, tid);
                else { const int s = t - 1024; lru_tile(p, l, 4 + (s >> 3), s & 7, 0, true, lds, tid); }
            }
        } else if (ph == 6) ln_phase(p, l, tid);
        if (step < 13) grid.sync();
    }
}

extern "C" void kernel_launch(void* const* d_in, const int* in_sizes, int n_in, void* d_out, int out_size, void* d_ws, size_t ws_size, hipStream_t stream) {
    constexpr size_t kDynLds = 131072;
    static int grid_blocks = 0;
    if (!grid_blocks) {
        int dev = 0, cus = 0, per_cu = 0;
        (void)hipGetDevice(&dev);
        (void)hipDeviceGetAttribute(&cus, hipDeviceAttributeMultiprocessorCount, dev);
        (void)hipFuncSetAttribute((const void*)mega, hipFuncAttributeMaxDynamicSharedMemorySize, (int)kDynLds);
        (void)hipOccupancyMaxActiveBlocksPerMultiprocessor(&per_cu, mega, 512, kDynLds);
        if (per_cu > 1) per_cu = 1;
        grid_blocks = cus * per_cu;
        if (grid_blocks > 256) grid_blocks = 256;
    }
    if (ws_size < WS_NEED) { fprintf(stderr, "workspace too small: %zu < %zu\n", ws_size, (size_t)WS_NEED); return; }
    Params p{};
    for (int i = 0; i < 31; ++i) p.in[i] = (const float*)d_in[i];
    p.out = (float*)d_out; p.ws = (unsigned char*)d_ws;
    void* args[] = {&p};
    hipError_t e = hipLaunchCooperativeKernel((void*)mega, dim3(grid_blocks), dim3(512), args, kDynLds, stream);
    if (e != hipSuccess) fprintf(stderr, "cooperative launch failed: %s (grid %d)\n", hipGetErrorString(e), grid_blocks);
}
```

```cpp
#include <hip/hip_runtime.h>
#include <hip/hip_cooperative_groups.h>
#include <cstdio>
namespace cg = cooperative_groups;

#define LAS __attribute__((address_space(3)))
#define DI __device__ __forceinline__
typedef unsigned short bf16_t;
typedef short bf16x8 __attribute__((ext_vector_type(8)));
typedef short s16x4 __attribute__((ext_vector_type(4)));
typedef float f32x2 __attribute__((ext_vector_type(2)));
typedef float f32x4 __attribute__((ext_vector_type(4)));
typedef float f32x16 __attribute__((ext_vector_type(16)));
typedef unsigned u32x2 __attribute__((ext_vector_type(2)));
typedef unsigned u32x4 __attribute__((ext_vector_type(4)));
typedef __bf16 bf16v2 __attribute__((ext_vector_type(2)));

#ifndef PROBE
#define PROBE 0
#endif
constexpr int TP = 16384, NROW = 16512, MROWS = 16640;
constexpr int ZW = 3840;
constexpr int C_AU = 0, C_AV = 512, C_AG = 1024, C_BX = 1536, C_BG = 2048, C_CQ = 2560, C_CKV = 2816, C_CKR = 2944, C_CG = 2976, C_MQ = 3488;
constexpr int KVROWS = 24832, SKEYS = 1040;
constexpr float LN_EPS = 1e-6f;
constexpr float ALPHA_RES = 1.41421356237f;

constexpr size_t SZ_WIN = (size_t)7936 * 1024 * 2, SZ_WUQ = 768 * 256 * 2, SZ_WUK = 512 * 256 * 2, SZ_WBR = (size_t)1024 * 1792 * 2, SZ_WOUT = 1024 * 1024 * 2,
                 SZ_MEMW = 512 * 1024 * 2, SZ_WRI = 8 * 128 * 64 * 2, SZ_GWS = 4 * 128 * 128 * 2;
constexpr size_t OFF_WIN = 0;
constexpr size_t OFF_WUQ = OFF_WIN + 2 * SZ_WIN;
constexpr size_t OFF_WUK = OFF_WUQ + 2 * SZ_WUQ;
constexpr size_t OFF_WUV = OFF_WUK + 2 * SZ_WUK;
constexpr size_t OFF_WBR = OFF_WUV + 2 * SZ_WUK;
constexpr size_t OFF_WOUT = OFF_WBR + 2 * SZ_WBR;
constexpr size_t OFF_MEMW = OFF_WOUT + 2 * SZ_WOUT;
constexpr size_t OFF_WRI = OFF_MEMW + 2 * SZ_MEMW;
constexpr size_t OFF_GWS = OFF_WRI + 2 * SZ_WRI;
constexpr size_t OFF_XB = OFF_GWS + 2 * SZ_GWS;
constexpr size_t OFF_MEMB = OFF_XB + (size_t)MROWS * 1024 * 2;
constexpr size_t OFF_MK = OFF_MEMB + (size_t)1024 * 1024 * 2;
constexpr size_t OFF_MVT = OFF_MK + 1024 * 256 * 2;
constexpr size_t OFF_MKS = OFF_MVT + 256 * 1024 * 2;
constexpr size_t OFF_MVTS = OFF_MKS + (size_t)2 * 2048 * 256 * 2;
constexpr size_t OFF_Z = OFF_MVTS + (size_t)2 * 2048 * 256 * 2;
constexpr size_t OFF_VT = OFF_Z + (size_t)MROWS * ZW * 2;
constexpr size_t OFF_MERGED = OFF_VT;
constexpr size_t OFF_STATS = OFF_VT + (size_t)MROWS * 1024 * 2;
constexpr size_t OFF_AGG = OFF_STATS + (size_t)2 * MROWS * 2 * 4;
constexpr size_t OFF_BAR = OFF_AGG + (size_t)1024 * 128 * 4;
constexpr size_t WS_NEED = OFF_BAR + 16384;
static_assert(WS_NEED <= (size_t)256 * 1024 * 1024, "workspace over 256 MiB");
constexpr size_t DO_Q = 0;
constexpr size_t DO_CKV = DO_Q + (size_t)MROWS * 768 * 2;
constexpr size_t DO_KR = DO_CKV + (size_t)KVROWS * 256 * 2;
constexpr size_t DO_KN = DO_KR + (size_t)KVROWS * 32 * 2;
constexpr size_t DO_END = DO_KN + (size_t)KVROWS * 512 * 2;
constexpr size_t DO_GSCR = 0;
static_assert(DO_END <= (size_t)NROW * 4096, "scratch in d_out too large");
static_assert((size_t)256 * 16 * 512 * 16 <= (size_t)NROW * 4096, "gscr too large");
constexpr size_t O_YS = 16777216, O_PCKV = 16908288, O_PKR = 21102592, O_PMK = 22151168, O_PMV = 22675456, O_PH = 23199744, O_PCONV = 23203840,
                 O_SCKV = 23216128, O_SKR = 23248896, O_SH = 23257088, O_SCONV = 23265280, O_SGV = 23289856;

struct Params {
    const float* in[31];
    float* out;
    unsigned char* ws;
};
typedef const __attribute__((address_space(4))) Params* KP;

DI float bf2f(unsigned short b) { return __uint_as_float(((unsigned)b) << 16); }
DI float bflo(unsigned w) { return __uint_as_float(w << 16); }
DI float bfhi(unsigned w) { return __uint_as_float(w & 0xffff0000u); }
DI unsigned cvt_pk(float lo, float hi) { f32x2 v = {lo, hi}; return __builtin_bit_cast(unsigned, __builtin_convertvector(v, bf16v2)); }
DI unsigned short f2bf(float x) { return (unsigned short)(cvt_pk(x, x) & 0xffffu); }
DI u32x4 pack8(f32x4 a, f32x4 b) { u32x4 w; w.x = cvt_pk(a[0], a[1]); w.y = cvt_pk(a[2], a[3]); w.z = cvt_pk(b[0], b[1]); w.w = cvt_pk(b[2], b[3]); return w; }
DI void unpack8(u32x4 w, float* f) { f[0] = bflo(w.x); f[1] = bfhi(w.x); f[2] = bflo(w.y); f[3] = bfhi(w.y); f[4] = bflo(w.z); f[5] = bfhi(w.z); f[6] = bflo(w.w); f[7] = bfhi(w.w); }
DI float fsigmoid(float x) { return __builtin_amdgcn_rcpf(1.f + __expf(-x)); }
DI float fsilu(float x) { return x * fsigmoid(x); }
DI float fgelu(float x) { return x * fsigmoid(1.5957691216f * (x + 0.044715f * x * x * x)); }
DI float wave_sum(float v) {
#pragma unroll
    for (int o = 32; o >= 1; o >>= 1) v += __shfl_xor(v, o);
    return v;
}
DI int crow(int reg, int h) { return (reg & 3) + 8 * (reg >> 2) + 4 * h; }
#define MFMA32(a, b, c) __builtin_amdgcn_mfma_f32_32x32x16_bf16((a), (b), (c), 0, 0, 0)

constexpr int HTB = 128 * 64 * 2;
DI int lds_byte(int r, int c) { const int st = (r >> 4) * 2 + (c >> 5), rr = r & 15, cc = c & 31, ob = rr * 64 + cc * 2; return st * 1024 + (ob ^ (((ob >> 9) & 1) << 5)); }
DI void stage_rc(int b, int& R, int& C) { const int st = b / 1024, sb = b % 1024, swz = sb ^ (((sb >> 9) & 1) << 5); R = (st >> 1) * 16 + swz / 64; C = (st & 1) * 32 + (swz % 64) / 2; }
DI int perm32(int rho) { const int n = rho >> 4, i = rho & 15; return 8 * (i >> 2) + 4 * n + (i & 3); }

enum { K_Z = 0, K_MEMKV = 1, K_PLAIN = 2, K_QP = 3, K_EG = 4, K_EY = 5, K_F = 6 };
struct GU {
    const char* A; const char* B;
    int lda, ldb;
    int nt;
    int kind, pm, pn, aux;
    bf16_t* C; int ldc;
};

DI bool next_unit(KP p, int gph, int l, int i, GU& u, int wg, int G) {
    unsigned char* ws = p->ws; unsigned char* dob = (unsigned char*)p->out;
    u.aux = 0; u.C = nullptr; u.ldc = 0;
    if (gph == 0) {
        int L = i * G + wg;
        if (L < 975) { u.pn = L / 65; u.pm = L % 65; u.A = (const char*)(ws + OFF_XB) + (size_t)u.pm * 256 * 2048; u.B = (const char*)(ws + OFF_WIN + l * SZ_WIN) + (size_t)u.pn * 256 * 2048;
            u.lda = 2048; u.ldb = 2048; u.nt = 16; u.kind = K_Z; return true; }
        L -= 975;
        if (L < 8) { u.pm = L & 3; u.pn = L >> 2; u.A = (const char*)(ws + OFF_MEMB) + (size_t)u.pm * 256 * 2048; u.B = (const char*)(ws + OFF_MEMW + l * SZ_MEMW) + (size_t)u.pn * 256 * 2048;
            u.lda = 2048; u.ldb = 2048; u.nt = 16; u.kind = K_MEMKV; return true; }
        if (L < 12) { u.pm = 0; u.pn = L - 8; u.A = (const char*)(ws + OFF_MEMW + l * SZ_MEMW) + (size_t)256 * 2048; u.B = (const char*)(ws + OFF_MEMB) + (size_t)u.pn * 256 * 2048;
            u.lda = 2048; u.ldb = 2048; u.nt = 16; u.kind = K_PLAIN; u.C = (bf16_t*)(ws + OFF_MVT); u.ldc = 1024; return true; }
        return false;
    } else if (gph == 1) {
        int L = i * G + wg;
        if (L < 195) { u.pm = L % 65; u.pn = L / 65; u.A = (const char*)(ws + OFF_Z) + (size_t)u.pm * 256 * (ZW * 2) + C_CQ * 2; u.lda = ZW * 2;
            u.B = (const char*)(ws + OFF_WUQ + l * SZ_WUQ) + (size_t)u.pn * 256 * 512; u.ldb = 512; u.nt = 4; u.kind = K_QP; return true; }
        L -= 195;
        if (L < 194) { u.pm = L % 97; u.pn = L / 97; u.A = (const char*)(dob + DO_CKV) + (size_t)u.pm * 256 * 512; u.lda = 512;
            u.B = (const char*)(ws + OFF_WUK + l * SZ_WUK) + (size_t)u.pn * 256 * 512; u.ldb = 512; u.nt = 4; u.kind = K_PLAIN; u.C = (bf16_t*)(dob + DO_KN); u.ldc = 512; return true; }
        L -= 194;
        if (L < 194) { u.pm = L / 97; u.pn = L % 97; u.A = (const char*)(ws + OFF_WUV + l * SZ_WUK) + (size_t)u.pm * 256 * 512; u.lda = 512;
            u.B = (const char*)(dob + DO_CKV) + (size_t)u.pn * 256 * 512; u.ldb = 512; u.nt = 4; u.kind = K_PLAIN; u.C = (bf16_t*)(ws + OFF_VT); u.ldc = KVROWS; return true; }
        return false;
    } else if (gph == 2) {
        const int rr = i >> 3, sub = i & 7, tt = wg + G * rr;
        if (tt >= 260) return false;
        u.pm = tt % 65; u.pn = tt / 65; const int ib = sub >> 1; u.aux = ib;
        if ((sub & 1) == 0) { u.A = (const char*)(ws + OFF_XB) + (size_t)u.pm * 256 * 2048; u.lda = 2048;
            u.B = (const char*)(ws + OFF_WIN + l * SZ_WIN) + (size_t)(3840 + ib * 1024 + u.pn * 256) * 2048; u.ldb = 2048; u.nt = 16; u.kind = K_EG; }
        else { const int zc = ib == 0 ? C_AU : ib == 1 ? C_BG : ib == 2 ? C_CG : C_MQ;
            u.A = (const char*)(ws + OFF_Z) + (size_t)u.pm * 256 * (ZW * 2) + zc * 2; u.lda = ZW * 2;
            u.B = (const char*)(ws + OFF_WBR + l * SZ_WBR) + (size_t)u.pn * 256 * 3584 + ib * 512 * 2; u.ldb = 3584; u.nt = ib < 3 ? 8 : 4; u.kind = K_EY; }
        return true;
    } else {
        const int L = i * G + wg;
        if (L >= 260) return false;
        u.pm = L % 65; u.pn = L / 65; u.A = (const char*)(ws + OFF_MERGED) + (size_t)u.pm * 256 * 2048; u.lda = 2048;
        u.B = (const char*)(ws + OFF_WOUT + l * SZ_WOUT) + (size_t)u.pn * 256 * 2048; u.ldb = 2048; u.nt = 16; u.kind = K_F; return true;
    }
}

DI void rope_pair(float& a, float& b, float pos, int jj) {
    const float freq = exp2f(-(float)jj * 0.83048202372f);
    const float ang = pos * freq;
    const float rev = __builtin_amdgcn_fractf(ang * 0.15915494309f);
    const float sn = __builtin_amdgcn_sinf(rev), cs = __builtin_amdgcn_cosf(rev);
    const float x1 = a, x2 = b;
    a = x1 * cs - x2 * sn; b = x1 * sn + x2 * cs;
}

DI void gemm_epilogue(KP p, int l, const f32x4 (&acc)[2][2][4][2], const GU& u, int tid_in, int wg, bool dumpst) {
    unsigned char* ws = p->ws;
    int tid = tid_in; asm volatile("" : "+v"(tid));
    const int wid = tid >> 6, lane = tid & 63, wr = wid >> 2, wc = wid & 3, fr = lane & 15, fq = lane >> 4;
#pragma unroll
    for (int ai = 0; ai < 2; ++ai)
#pragma unroll
        for (int m = 0; m < 4; ++m) {
            const int row = u.pm * 256 + ai * 128 + wr * 64 + m * 16 + fr;
            float s1 = 0.f, s2 = 0.f;
#pragma unroll
            for (int bj = 0; bj < 2; ++bj) {
                const int col = u.pn * 256 + bj * 128 + wc * 32 + 8 * fq;
                f32x4 v0 = acc[ai][bj][m][0], v1 = acc[ai][bj][m][1];
                const int vec = (ai * 4 + m) * 2 + bj;
                if (u.kind == K_Z) {
                    int act = 0;
                    if (col < C_AG) act = 1; else if (col < C_BX) act = 2; else if (col < C_BG) act = 0; else if (col < C_CQ) act = 2; else if (col < C_CG) act = 0; else if (col < C_MQ) act = 2;
                    if (act == 1) {
#pragma unroll
                        for (int j = 0; j < 4; ++j) { v0[j] = fgelu(v0[j]); v1[j] = fgelu(v1[j]); }
                    } else if (act == 2) {
#pragma unroll
                        for (int j = 0; j < 4; ++j) { v0[j] = fsilu(v0[j]); v1[j] = fsilu(v1[j]); }
                    }
                    *(u32x4*)((bf16_t*)(ws + OFF_Z) + (size_t)row * ZW + col) = pack8(v0, v1);
                } else if (u.kind == K_MEMKV) {
                    float* o = p->out + (col < 256 ? O_PMK : O_PMV) + (size_t)l * 262144 + (size_t)row * 256 + (col & 255);
                    *(f32x4*)o = v0; *(f32x4*)(o + 4) = v1;
                    if (col < 256) *(u32x4*)((bf16_t*)(ws + OFF_MK) + (size_t)row * 256 + col) = pack8(v0, v1);
                } else if (u.kind == K_PLAIN) {
                    *(u32x4*)(u.C + (size_t)row * u.ldc + col) = pack8(v0, v1);
                } else if (u.kind == K_QP) {
                    const int d = col % 96;
                    if (d >= 64) {
                        const float pos = row < TP ? (float)(row & 4095) : (float)(1024 + ((row - TP) & 15));
                        const int j0 = (d - 64) >> 1;
                        float t0 = v0[0], t1 = v0[1], t2 = v0[2], t3 = v0[3], t4 = v1[0], t5 = v1[1], t6 = v1[2], t7 = v1[3];
                        rope_pair(t0, t1, pos, j0); rope_pair(t2, t3, pos, j0 + 1); rope_pair(t4, t5, pos, j0 + 2); rope_pair(t6, t7, pos, j0 + 3);
                        v0 = (f32x4){t0, t1, t2, t3}; v1 = (f32x4){t4, t5, t6, t7};
                    }
                    *(u32x4*)((bf16_t*)((unsigned char*)p->out + DO_Q) + (size_t)row * 768 + col) = pack8(v0, v1);
                } else if (u.kind == K_EG) {
#pragma unroll
                    for (int j = 0; j < 4; ++j) { v0[j] = fsigmoid(v0[j]); v1[j] = fsigmoid(v1[j]); }
                    *((u32x4*)((unsigned char*)p->out + DO_GSCR) + ((size_t)wg * 16 + vec) * 512 + tid) = pack8(v0, v1);
                } else if (u.kind == K_EY) {
                    const u32x4 gw = *((const u32x4*)((unsigned char*)p->out + DO_GSCR) + ((size_t)wg * 16 + vec) * 512 + tid);
                    float g[8]; unpack8(gw, g);
                    u32x4* mp = (u32x4*)((bf16_t*)(ws + OFF_MERGED) + (size_t)row * 1024 + col);
                    float mo[8] = {0.f, 0.f, 0.f, 0.f, 0.f, 0.f, 0.f, 0.f};
                    if (u.aux > 0) { const u32x4 mw = *mp; unpack8(mw, mo); }
#pragma unroll
                    for (int j = 0; j < 4; ++j) { v0[j] = mo[j] + g[j] * v0[j]; v1[j] = mo[4 + j] + g[4 + j] * v1[j]; }
                    *mp = pack8(v0, v1);
                } else {
                    float x[8];
                    if (l == 0) { const float* xs = row < TP ? p->in[0] + (size_t)row * 1024 + col : p->in[1] + (size_t)((row < NROW ? row : TP) - TP) * 1024 + col;
                        const f32x4 a = *(const f32x4*)xs, b = *(const f32x4*)(xs + 4);
#pragma unroll
                        for (int j = 0; j < 4; ++j) { x[j] = a[j]; x[4 + j] = b[j]; } }
                    else { const u32x4 xw = *(const u32x4*)((const bf16_t*)(ws + OFF_XB) + (size_t)row * 1024 + col); unpack8(xw, x); }
#pragma unroll
                    for (int j = 0; j < 4; ++j) { v0[j] = ALPHA_RES * x[j] + v0[j]; v1[j] = ALPHA_RES * x[4 + j] + v1[j]; s1 += v0[j] + v1[j]; s2 += v0[j] * v0[j] + v1[j] * v1[j]; }
                    if (row < NROW) { float* o = p->out + (size_t)row * 1024 + col; *(f32x4*)o = v0; *(f32x4*)(o + 4) = v1; }
                }
            }
            if (u.kind == K_F) {
                s1 += __shfl_xor(s1, 16); s1 += __shfl_xor(s1, 32); s2 += __shfl_xor(s2, 16); s2 += __shfl_xor(s2, 32);
                if (fq == 0) { float* st = dumpst ? (float*)(ws + WS_NEED) + (row & 1023) * 2 : (float*)(ws + OFF_STATS) + ((size_t)l * MROWS + row) * 2;
                    __hip_atomic_fetch_add(st, s1, __ATOMIC_RELAXED, __HIP_MEMORY_SCOPE_AGENT); __hip_atomic_fetch_add(st + 1, s2, __ATOMIC_RELAXED, __HIP_MEMORY_SCOPE_AGENT); }
            }
        }
}

DI void gemm_stream(KP p, int gph, int l, LAS unsigned char* lds, int tid, int wg, int G, bool dumpst = false) {
    const int wid = __builtin_amdgcn_readfirstlane(tid >> 6), lane = tid & 63, wr = wid >> 2, wc = wid & 3, fr = lane & 15, fq = lane >> 4;
    const unsigned ldsw = (unsigned)wid * 1024u;
    const int aoff = lds_byte(wr * 64 + fr, fq * 8), boff = lds_byte(wc * 32 + fr, fq * 8);
#define PG8_SA(b, h) (((b) * 2 + (h)) * HTB)
#define PG8_SB(b, h) ((4 + (b) * 2 + (h)) * HTB)
#define PG8_STAGE(bufoff, gbase, voff) do { const char* _g = (const char*)(gbase); asm volatile("" : "+s"(_g)); _Pragma("unroll") for (int _i = 0; _i < 2; ++_i) \
        __builtin_amdgcn_global_load_lds((const unsigned*)(_g + (voff)[_i]), (LAS unsigned*)(lds + (bufoff) + ldsw + _i * 8192), 16, 0, 0); } while (0)
#define PG8_LDA(dst, b, h) do { _Pragma("unroll") for (int m = 0; m < 4; ++m) _Pragma("unroll") for (int k = 0; k < 2; ++k) dst[m][k] = *(const LAS bf16x8*)(lds + PG8_SA(b, h) + aoff + m * 2048 + k * 1024); } while (0)
#define PG8_LDB(dst, b, h) do { _Pragma("unroll") for (int n = 0; n < 2; ++n) _Pragma("unroll") for (int k = 0; k < 2; ++k) dst[n][k] = *(const LAS bf16x8*)(lds + PG8_SB(b, h) + boff + n * 2048 + k * 1024); } while (0)
#define PG8_MMA(ai, bj, At, Bt) do { __builtin_amdgcn_s_setprio(1); _Pragma("unroll") for (int m = 0; m < 4; ++m) _Pragma("unroll") for (int n = 0; n < 2; ++n) _Pragma("unroll") for (int k = 0; k < 2; ++k) \
        acc[ai][bj][m][n] = __builtin_amdgcn_mfma_f32_16x16x32_bf16(Bt[n][k], At[m][k], acc[ai][bj][m][n], 0, 0, 0); __builtin_amdgcn_s_setprio(0); } while (0)
#define PG8_WAIT_V(n) asm volatile("s_waitcnt vmcnt(" #n ")" ::: "memory")
#define PG8_WAIT_L(n) asm volatile("s_waitcnt lgkmcnt(" #n ")" ::: "memory")
#define PG8_BAR __builtin_amdgcn_s_barrier()
#define PG8_SCHED __builtin_amdgcn_sched_barrier(0)
#define PG8_VOFF(vA, vB, U) do { _Pragma("unroll") for (int _i = 0; _i < 2; ++_i) { int _R, _C; stage_rc(tid * 16 + _i * 8192, _R, _C); const int _Rb = (_R & ~31) + perm32(_R & 31); \
        vA[_i] = (unsigned)(_R * (U).lda + _C * 2); vB[_i] = (unsigned)(_Rb * (U).ldb + _C * 2); } } while (0)
    GU cur, nxt; int ui = 0;
    if (!next_unit(p, gph, l, 0, cur, wg, G)) return;
    f32x4 acc[2][2][4][2];
#pragma unroll
    for (int a = 0; a < 2; ++a)
#pragma unroll
        for (int b = 0; b < 2; ++b)
#pragma unroll
            for (int m = 0; m < 4; ++m)
#pragma unroll
                for (int n = 0; n < 2; ++n) acc[a][b][m][n] = (f32x4){0.f, 0.f, 0.f, 0.f};
    bf16x8 At[4][2], B0[2][2], B1[2][2];
    unsigned cvA[2], cvB[2];
    PG8_VOFF(cvA, cvB, cur);
    const char* cA = cur.A; const char* cB = cur.B;
    size_t chA = (size_t)128 * cur.lda, chB = (size_t)128 * cur.ldb;
    const size_t kstep = 128;
    PG8_STAGE(PG8_SB(0, 0), cB, cvB); PG8_STAGE(PG8_SA(0, 0), cA, cvA); PG8_STAGE(PG8_SB(0, 1), cB + chB, cvB); PG8_STAGE(PG8_SA(0, 1), cA + chA, cvA);
    if (wr == 1) PG8_BAR;
    PG8_WAIT_V(4); PG8_BAR;
    PG8_STAGE(PG8_SB(1, 0), cB + kstep, cvB); PG8_STAGE(PG8_SA(1, 0), cA + kstep, cvA); PG8_STAGE(PG8_SB(1, 1), cB + chB + kstep, cvB);
    PG8_WAIT_V(6); PG8_BAR;
    for (;;) {
        const bool has_next = next_unit(p, gph, l, ui + 1, nxt, wg, G);
        if (!has_next) nxt = cur;
        const char* nA = nxt.A; const char* nB = nxt.B;
        const size_t nhA = (size_t)128 * nxt.lda, nhB = (size_t)128 * nxt.ldb;
        const int nt = cur.nt;
        for (int t = 0; t < nt; t += 2) {
            const bool last = (t == nt - 2);
            const char* a1 = cA + (size_t)(t + 1) * kstep;
            const char* a2 = last ? nA : cA + (size_t)(t + 2) * kstep; const char* b2 = last ? nB : cB + (size_t)(t + 2) * kstep;
            const char* a3 = a2 + kstep; const char* b3 = b2 + kstep;
            unsigned vA2[2], vB2[2];
            if (last) { PG8_VOFF(vA2, vB2, nxt); }
            else {
#pragma unroll
                for (int _i = 0; _i < 2; ++_i) { vA2[_i] = cvA[_i]; vB2[_i] = cvB[_i]; } }
            const size_t hA2 = last ? nhA : chA, hB2 = last ? nhB : chB;
            PG8_LDB(B0, 0, 0); PG8_SCHED; PG8_LDA(At, 0, 0); PG8_STAGE(PG8_SA(1, 1), a1 + chA, cvA);
            PG8_WAIT_L(8); PG8_BAR; PG8_WAIT_L(0); PG8_MMA(0, 0, At, B0); PG8_BAR; PG8_SCHED;
            PG8_LDB(B1, 0, 1); PG8_STAGE(PG8_SB(0, 0), b2, vB2);
            PG8_BAR; PG8_WAIT_L(0); PG8_MMA(0, 1, At, B1); PG8_BAR;
            PG8_LDA(At, 0, 1); PG8_STAGE(PG8_SA(0, 0), a2, vA2);
            PG8_BAR; PG8_WAIT_L(0); PG8_MMA(1, 0, At, B0); PG8_BAR; PG8_SCHED;
            PG8_STAGE(PG8_SB(0, 1), b2 + hB2, vB2);
            PG8_WAIT_V(6); PG8_BAR; PG8_MMA(1, 1, At, B1); PG8_BAR;
            PG8_LDB(B0, 1, 0); PG8_SCHED; PG8_LDA(At, 1, 0); PG8_STAGE(PG8_SA(0, 1), a2 + hA2, vA2);
            PG8_WAIT_L(8); PG8_BAR; PG8_WAIT_L(0); PG8_MMA(0, 0, At, B0); PG8_BAR; PG8_SCHED;
            PG8_LDB(B1, 1, 1); PG8_STAGE(PG8_SB(1, 0), b3, vB2);
            PG8_BAR; PG8_WAIT_L(0); PG8_MMA(0, 1, At, B1); PG8_BAR;
            PG8_LDA(At, 1, 1); PG8_STAGE(PG8_SA(1, 0), a3, vA2);
            PG8_BAR; PG8_WAIT_L(0); PG8_MMA(1, 0, At, B0); PG8_BAR; PG8_SCHED;
            PG8_STAGE(PG8_SB(1, 1), b3 + hB2, vB2);
            PG8_WAIT_V(6); PG8_BAR; PG8_MMA(1, 1, At, B1); PG8_BAR;
        }
        gemm_epilogue(p, l, acc, cur, tid, wg, dumpst);
        if (!has_next) break;
#pragma unroll
        for (int a = 0; a < 2; ++a)
#pragma unroll
            for (int b = 0; b < 2; ++b)
#pragma unroll
                for (int m = 0; m < 4; ++m)
#pragma unroll
                    for (int n = 0; n < 2; ++n) acc[a][b][m][n] = (f32x4){0.f, 0.f, 0.f, 0.f};
        cur = nxt; cA = nA; cB = nB; chA = nhA; chB = nhB;
        PG8_VOFF(cvA, cvB, cur);
        ++ui;
    }
    PG8_WAIT_V(0);
    if (wr == 0) PG8_BAR;
    PG8_BAR;
}

struct TJob { const float* src; int lds_, Ks; bf16_t* dst; int ldd, nN, nK, map; };
DI int tmap(int kind, int n) {
    if (kind == 0) return n;
    if (kind == 1) return n < 3744 ? n : (n < 3840 ? -1 : n - 96);
    if (kind == 2) { const int h = n / 96, d = n % 96; if (d < 64) return n; const int jj = (d - 64) >> 1, e = (d - 64) & 1; return h * 96 + 64 + jj + 16 * e; }
    if (kind == 3) { const int h = n >> 6, d = n & 63; return h * 128 + d; }
    const int h = n >> 6, d = n & 63; return h * 128 + 64 + d;
}
DI bool tjob(KP p, int j, TJob& t) {
    unsigned char* ws = p->ws;
    if (j < 18) { const int l = j / 9, k = j % 9;
        switch (k) {
        case 0: t = {p->in[9] + (size_t)l * 1024 * 7840, 7840, 1024, (bf16_t*)(ws + OFF_WIN + l * SZ_WIN), 1024, 124, 16, 1}; break;
        case 1: t = {p->in[22] + (size_t)l * 256 * 768, 768, 256, (bf16_t*)(ws + OFF_WUQ + l * SZ_WUQ), 256, 12, 4, 2}; break;
        case 2: t = {p->in[24] + (size_t)l * 128 * 1024, 1024, 128, (bf16_t*)(ws + OFF_WUK + l * SZ_WUK), 256, 8, 4, 3}; break;
        case 3: t = {p->in[24] + (size_t)l * 128 * 1024, 1024, 128, (bf16_t*)(ws + OFF_WUV + l * SZ_WUK), 256, 8, 4, 4}; break;
        case 4: t = {p->in[27] + (size_t)l * 1792 * 1024, 1024, 1792, (bf16_t*)(ws + OFF_WBR + l * SZ_WBR), 1792, 16, 28, 0}; break;
        case 5: t = {p->in[28] + (size_t)l * 1024 * 1024, 1024, 1024, (bf16_t*)(ws + OFF_WOUT + l * SZ_WOUT), 1024, 16, 16, 0}; break;
        case 6: t = {p->in[25] + (size_t)l * 1024 * 256, 256, 1024, (bf16_t*)(ws + OFF_MEMW + l * SZ_MEMW), 1024, 4, 16, 0}; break;
        case 7: t = {p->in[26] + (size_t)l * 1024 * 256, 256, 1024, (bf16_t*)(ws + OFF_MEMW + l * SZ_MEMW) + 256 * 1024, 1024, 4, 16, 0}; break;
        default: t = {p->in[6] + (size_t)l * 8 * 65536, 256, 256, (bf16_t*)(ws + OFF_MVTS) + (size_t)l * 8 * 65536, 256, 4, 4, 0}; break;
        }
        return true; }
    j -= 18;
    if (j < 14) { const int l = j / 7, b = j % 7 + 1; t = {p->in[6] + (size_t)(l * 8 + b) * 65536, 256, 256, (bf16_t*)(ws + OFF_MVTS) + (size_t)(l * 8 + b) * 65536, 256, 4, 4, 0}; return true; }
    j -= 14;
    if (j < 32) { const int l = j / 16, r = j % 16, hb = r >> 1, gi = r & 1;
        t = {p->in[gi ? 18 : 16] + (size_t)(l * 8 + hb) * 4096, 64, 64, (bf16_t*)(ws + OFF_WRI + l * SZ_WRI) + hb * 8192 + gi * 4096, 64, 1, 1, 0}; return true; }
    return false;
}

DI void prep_phase(KP p, LAS unsigned char* lds, int tid) {
    const int G = gridDim.x, wg = blockIdx.x;
    unsigned char* ws = p->ws;
    {
        bf16_t* XB = (bf16_t*)(ws + OFF_XB);
        const size_t nvec = (size_t)MROWS * 1024 / 8;
        for (size_t v = (size_t)wg * 512 + tid; v < nvec; v += (size_t)G * 512) {
            const size_t e = v * 8; const int row = (int)(e >> 10);
            u32x4 o = {0u, 0u, 0u, 0u};
            if (row < NROW) { const float* src = row < TP ? p->in[0] + e : p->in[1] + (e - (size_t)TP * 1024); o = pack8(*(const f32x4*)src, *(const f32x4*)(src + 4)); }
            *(u32x4*)(XB + e) = o;
        }
    }
    {
        bf16_t* MB = (bf16_t*)(ws + OFF_MEMB);
        for (size_t v = (size_t)wg * 512 + tid; v < (size_t)1024 * 1024 / 8; v += (size_t)G * 512) { const float* s = p->in[2] + v * 8; *(u32x4*)(MB + v * 8) = pack8(*(const f32x4*)s, *(const f32x4*)(s + 4)); }
        bf16_t* MKS = (bf16_t*)(ws + OFF_MKS);
        for (size_t v = (size_t)wg * 512 + tid; v < (size_t)2 * 2048 * 256 / 8; v += (size_t)G * 512) { const float* s = p->in[5] + v * 8; *(u32x4*)(MKS + v * 8) = pack8(*(const f32x4*)s, *(const f32x4*)(s + 4)); }
        bf16_t* GW = (bf16_t*)(ws + OFF_GWS);
        for (size_t v = (size_t)wg * 512 + tid; v < (size_t)2 * 4 * 128 * 128 / 8; v += (size_t)G * 512) {
            const size_t e = v * 8; const int q0 = (int)(e & 127), pr = (int)((e >> 7) & 127); const float* s = p->in[12] + e;
            f32x4 a = *(const f32x4*)s, b = *(const f32x4*)(s + 4);
#pragma unroll
            for (int j = 0; j < 4; ++j) { if (q0 + j > pr) a[j] = 0.f; if (q0 + 4 + j > pr) b[j] = 0.f; }
            *(u32x4*)(GW + e) = pack8(a, b); }
        float* st = (float*)(ws + OFF_STATS);
        for (size_t v = (size_t)wg * 512 + tid; v < (size_t)2 * MROWS * 2; v += (size_t)G * 512) st[v] = 0.f;
    }
    LAS float* tile = (LAS float*)lds;
    int base = 0;
    for (int j = 0;; ++j) {
        TJob t; if (!tjob(p, j, t)) break;
        const int ntile = t.nN * t.nK;
        int first = wg - (base % G); if (first < 0) first += G;
        for (int tt = first; tt < ntile; tt += G) {
            const int tn = tt / t.nK, tk = tt % t.nK, n0 = tn * 64, k0 = tk * 64;
            __syncthreads();
            for (int e = tid; e < 4096; e += 512) { const int kk = e >> 6, nn = e & 63; const int sc = tmap(t.map, n0 + nn); const int k = k0 + kk;
                tile[kk * 65 + nn] = (sc >= 0 && k < t.Ks) ? t.src[(size_t)k * t.lds_ + sc] : 0.f; }
            __syncthreads();
            for (int e = tid; e < 2048; e += 512) { const int nn = e >> 5, k2 = (e & 31) * 2;
                *(unsigned*)(t.dst + (size_t)(n0 + nn) * t.ldd + k0 + k2) = cvt_pk(tile[k2 * 65 + nn], tile[(k2 + 1) * 65 + nn]); }
        }
        base += ntile;
    }
    __syncthreads();
}

DI void rows_phase(KP p, int l, int tid) {
    const int G = gridDim.x, lane = tid & 63, gw = blockIdx.x * 8 + (tid >> 6), nw = G * 8;
    unsigned char* ws = p->ws; unsigned char* dob = (unsigned char*)p->out;
    bf16_t* Z = (bf16_t*)(ws + OFF_Z); bf16_t* CKV = (bf16_t*)(dob + DO_CKV); bf16_t* KR = (bf16_t*)(dob + DO_KR);
    for (int it = gw; it < NROW + 8192 + 36 + 128; it += nw) {
        if (it < NROW) {
            const int row = it; const bool smp = row >= TP; const int srow = row - TP;
            bf16_t* zr = Z + (size_t)row * ZW;
            const u32x4 raw_av = *(const u32x4*)(zr + C_AV + lane * 8);
            const u32x2 raw_cq = *(const u32x2*)(zr + C_CQ + lane * 4);
            const unsigned raw_kv = *(const unsigned*)(zr + C_CKV + lane * 2);
            const unsigned short raw_ka = zr[C_CKR + (lane & 15)], raw_kb = zr[C_CKR + 16 + (lane & 15)];
            const f32x4 g0 = *(const f32x4*)(p->in[10] + l * 512 + lane * 8), g1 = *(const f32x4*)(p->in[10] + l * 512 + lane * 8 + 4);
            const f32x4 b0 = *(const f32x4*)(p->in[11] + l * 512 + lane * 8), b1 = *(const f32x4*)(p->in[11] + l * 512 + lane * 8 + 4);
            const f32x4 gq = *(const f32x4*)(p->in[21] + l * 256 + lane * 4);
            const f32x2 gk = *(const f32x2*)(p->in[23] + l * 128 + lane * 2);
            float x[8]; unpack8(raw_av, x);
            float xq[4] = {bflo(raw_cq.x), bfhi(raw_cq.x), bflo(raw_cq.y), bfhi(raw_cq.y)};
            const float k0 = bflo(raw_kv), k1 = bfhi(raw_kv);
            float s = 0.f;
#pragma unroll
            for (int j = 0; j < 8; ++j) s += x[j];
            float ssq = xq[0] * xq[0] + xq[1] * xq[1] + xq[2] * xq[2] + xq[3] * xq[3];
            float ssk = k0 * k0 + k1 * k1;
#pragma unroll
            for (int o = 32; o >= 1; o >>= 1) { s += __shfl_xor(s, o); ssq += __shfl_xor(ssq, o); ssk += __shfl_xor(ssk, o); }
            const float mean = s * (1.f / 512.f);
            float q = 0.f;
#pragma unroll
            for (int j = 0; j < 8; ++j) { x[j] -= mean; q += x[j] * x[j]; }
            const float rstd = rsqrtf(wave_sum(q) * (1.f / 512.f) + LN_EPS);
            {
                f32x4 y0, y1;
#pragma unroll
                for (int j = 0; j < 4; ++j) { y0[j] = x[j] * rstd * g0[j] + b0[j]; y1[j] = x[4 + j] * rstd * g1[j] + b1[j]; }
                *(u32x4*)(zr + C_AV + lane * 8) = pack8(y0, y1);
                if (smp) { float* o = p->out + O_SGV + (size_t)l * 65536 + (size_t)srow * 512 + lane * 8; *(f32x4*)o = y0; *(f32x4*)(o + 4) = y1; }
            }
            {
                const float r = rsqrtf(ssq * (1.f / 256.f) + LN_EPS);
                u32x2 o; o.x = cvt_pk(xq[0] * r * gq[0], xq[1] * r * gq[1]); o.y = cvt_pk(xq[2] * r * gq[2], xq[3] * r * gq[3]);
                *(u32x2*)(zr + C_CQ + lane * 4) = o;
            }
            const int kvrow = smp ? TP + (srow >> 4) * SKEYS + 1024 + (srow & 15) : row;
            {
                const float r = rsqrtf(ssk * (1.f / 128.f) + LN_EPS);
                const float y0 = k0 * r * gk[0], y1 = k1 * r * gk[1];
                float* o = smp ? p->out + O_SCKV + (size_t)l * 16384 + (size_t)srow * 128 + lane * 2 : p->out + O_PCKV + (size_t)l * 2097152 + (size_t)row * 128 + lane * 2;
                *(f32x2*)o = (f32x2){y0, y1};
                *(unsigned*)(CKV + (size_t)kvrow * 256 + lane * 2) = cvt_pk(y0, y1);
                *(unsigned*)(CKV + (size_t)kvrow * 256 + 128 + lane * 2) = 0u;
            }
            if (lane < 16) {
                float a = bf2f(raw_ka), b = bf2f(raw_kb);
                const float pos = smp ? (float)(1024 + (srow & 15)) : (float)(row & 4095);
                rope_pair(a, b, pos, lane);
                float* o = smp ? p->out + O_SKR + (size_t)l * 4096 + (size_t)srow * 32 : p->out + O_PKR + (size_t)l * 524288 + (size_t)row * 32;
                o[lane] = a; o[lane + 16] = b;
                *(unsigned*)(KR + (size_t)kvrow * 32 + lane * 2) = cvt_pk(a, b);
            }
        } else if (it < NROW + 8192) {
            const int idx = it - NROW, b = idx >> 10, j = idx & 1023; const int dst = TP + b * SKEYS + j;
            const float* s = p->in[3] + ((size_t)(l * 8 + b) * 1024 + j) * 128 + lane * 2;
            *(unsigned*)(CKV + (size_t)dst * 256 + lane * 2) = cvt_pk(s[0], s[1]);
            *(unsigned*)(CKV + (size_t)dst * 256 + 128 + lane * 2) = 0u;
            if (lane < 16) { const float* r = p->in[4] + ((size_t)(l * 8 + b) * 1024 + j) * 32; *(unsigned*)(KR + (size_t)dst * 32 + lane * 2) = cvt_pk(r[lane], r[lane + 16]); }
        } else if (it >= NROW + 8192 + 36) {
            const int dst = 24704 + (it - (NROW + 8192 + 36));
            *(u32x2*)(CKV + (size_t)dst * 256 + lane * 4) = (u32x2){0u, 0u};
        } else {
            const int idx = it - NROW - 8192; int src; float* o;
            if (idx < 12) { const int b = idx / 3, k = idx % 3; src = b * 4096 + 4093 + k; o = p->out + O_PCONV + (size_t)l * 6144 + (size_t)(b * 3 + k) * 512; }
            else { const int i2 = idx - 12, b = i2 / 3, k = i2 % 3; src = TP + b * 16 + 13 + k; o = p->out + O_SCONV + (size_t)l * 12288 + (size_t)(b * 3 + k) * 512; }
            const u32x4 raw = *(const u32x4*)(Z + (size_t)src * ZW + C_BX + lane * 8); float x[8]; unpack8(raw, x);
            *(f32x4*)(o + lane * 8) = (f32x4){x[0], x[1], x[2], x[3]}; *(f32x4*)(o + lane * 8 + 4) = (f32x4){x[4], x[5], x[6], x[7]};
        }
    }
}

DI void ln_phase(KP p, int l, int tid) {
    const int G = gridDim.x, lane = tid & 63, gw = blockIdx.x * 8 + (tid >> 6), nw = G * 8;
    unsigned char* ws = p->ws;
    const float* st = (const float*)(ws + OFF_STATS) + (size_t)l * MROWS * 2;
    bf16_t* XB = (bf16_t*)(ws + OFF_XB);
    const float* g = p->in[29] + l * 1024; const float* b = p->in[30] + l * 1024;
    for (int row = gw; row < NROW; row += nw) {
        const float mean = st[row * 2] * (1.f / 1024.f); const float var = st[row * 2 + 1] * (1.f / 1024.f) - mean * mean;
        const float rstd = rsqrtf(fmaxf(var, 0.f) + LN_EPS);
        float* vr = p->out + (size_t)row * 1024;
#pragma unroll
        for (int c = 0; c < 2; ++c) {
            const int col = c * 512 + lane * 8;
            f32x4 a = *(const f32x4*)(vr + col), bq = *(const f32x4*)(vr + col + 4);
            const f32x4 g0 = *(const f32x4*)(g + col), g1 = *(const f32x4*)(g + col + 4), b0 = *(const f32x4*)(b + col), b1 = *(const f32x4*)(b + col + 4);
#pragma unroll
            for (int j = 0; j < 4; ++j) { a[j] = (a[j] - mean) * rstd * g0[j] + b0[j]; bq[j] = (bq[j] - mean) * rstd * g1[j] + b1[j]; }
            if (l == 0) *(u32x4*)(XB + (size_t)row * 1024 + col) = pack8(a, bq);
            else { *(f32x4*)(vr + col) = a; *(f32x4*)(vr + col + 4) = bq; }
        }
    }
}

DI void gmlp_tile(KP p, int l, int b, int n, int g, LAS unsigned char* lds, int tid, bool dump = false) {
    const int w = tid >> 6, lane = tid & 63, r = lane & 31, h = lane >> 5;
    bf16_t* Z = (bf16_t*)(p->ws + OFF_Z);
    const bf16_t* GW = (const bf16_t*)(p->ws + OFF_GWS) + (size_t)(l * 4 + g) * 16384;
    LAS bf16_t* Wl = (LAS bf16_t*)lds; LAS bf16_t* Vl = (LAS bf16_t*)(lds + 128 * 136 * 2);
    const int r0 = b * 4096 + n * 128;
    __syncthreads();
    for (int c = tid; c < 2048; c += 512) { const int rr = c >> 4, ch = c & 15;
        *(LAS u32x4*)(Wl + rr * 136 + ch * 8) = *(const u32x4*)(GW + rr * 128 + ch * 8);
        *(LAS u32x4*)(Vl + rr * 136 + ch * 8) = *(const u32x4*)(Z + (size_t)(r0 + rr) * ZW + C_AV + g * 128 + ch * 8); }
    __syncthreads();
    const int pb = w >> 1, cb0 = (w & 1) * 2;
    f32x16 acc0, acc1;
#pragma unroll
    for (int i = 0; i < 16; ++i) { acc0[i] = 0.f; acc1[i] = 0.f; }
    for (int s = 0; s < 2 * (pb + 1); ++s) {
        const bf16x8 a = *(const LAS bf16x8*)(Wl + (32 * pb + r) * 136 + 16 * s + 8 * h);
        bf16x8 b0, b1;
#pragma unroll
        for (int j = 0; j < 8; ++j) { b0[j] = (short)Vl[(16 * s + 8 * h + j) * 136 + 32 * cb0 + r]; b1[j] = (short)Vl[(16 * s + 8 * h + j) * 136 + 32 * (cb0 + 1) + r]; }
        acc0 = MFMA32(a, b0, acc0); acc1 = MFMA32(a, b1, acc1);
    }
    const float* bs = p->in[13] + (size_t)(l * 4 + g) * 128;
#pragma unroll
    for (int i = 0; i < 16; ++i) {
        const int pr = 32 * pb + crow(i, h); const float bias = bs[pr];
        bf16_t* zr = Z + (size_t)(r0 + pr) * ZW;
        bf16_t* zo = dump ? (bf16_t*)(p->ws + WS_NEED) : zr;
#pragma unroll
        for (int cb = 0; cb < 2; ++cb) {
            const int c = g * 128 + 32 * (cb0 + cb) + r;
            const float s = (cb ? acc1[i] : acc0[i]) + bias;
            zo[C_AU + c] = f2bf(bf2f(zr[C_AU + c]) * s * bf2f(zr[C_AG + c]));
        }
    }
}
DI void gmlp_sample(KP p, int l, int b, int g, int tid) {
    const int c = tid & 127, p0 = (tid >> 7) * 4;
    bf16_t* Z = (bf16_t*)(p->ws + OFF_Z);
    const float* wsrc = p->in[12] + (size_t)(l * 4 + g) * 16384; const float* bs = p->in[13] + (size_t)(l * 4 + g) * 128;
    const int r0 = TP + b * 16;
    float v[16];
#pragma unroll
    for (int q = 0; q < 16; ++q) v[q] = bf2f(Z[(size_t)(r0 + q) * ZW + C_AV + g * 128 + c]);
#pragma unroll
    for (int k = 0; k < 4; ++k) { const int pr = p0 + k; float s = bs[pr];
#pragma unroll
        for (int q = 0; q < 16; ++q) if (q <= pr) s += wsrc[pr * 128 + q] * v[q];
        bf16_t* zr = Z + (size_t)(r0 + pr) * ZW; const int cc = g * 128 + c;
        zr[C_AU + cc] = f2bf(bf2f(zr[C_AU + cc]) * s * bf2f(zr[C_AG + cc])); }
}

DI void lru_tile(KP p, int l, int bg, int hb, int seg, bool apply, LAS unsigned char* lds, int tid, bool dump = false) {
    const int w = tid >> 6, lane = tid & 63, r = lane & 31, h = lane >> 5;
    bf16_t* Z = (bf16_t*)(p->ws + OFF_Z);
    const bool smp = bg >= 4; const int sb = bg - 4;
    const int row0 = smp ? TP + sb * 16 : bg * 4096 + seg * 128; const int ntok = smp ? 16 : 128;
    LAS float* XC = (LAS float*)lds; LAS bf16_t* XCB = (LAS bf16_t*)(lds + 32768); LAS float* GATE = (LAS float*)(lds + 51200); LAS float* AGL = (LAS float*)(lds + 116736);
    const int c = tid & 63, sub = tid >> 6, ch = hb * 64 + c;
    __syncthreads();
    {
        const float cb = p->in[15][l * 512 + ch];
        float cw[4];
#pragma unroll
        for (int k = 0; k < 4; ++k) cw[k] = p->in[14][(size_t)(l * 4 + k) * 512 + ch];
        for (int t = sub; t < 128; t += 8) {
            float a = 0.f;
            if (t < ntok) { a = cb;
#pragma unroll
                for (int k = 0; k < 4; ++k) { const int tt = t + k - 3; float x;
                    if (!smp) { const int gt = seg * 128 + tt; x = gt >= 0 ? bf2f(Z[(size_t)(bg * 4096 + gt) * ZW + C_BX + ch]) : 0.f; }
                    else x = tt >= 0 ? bf2f(Z[(size_t)(row0 + tt) * ZW + C_BX + ch]) : p->in[8][((size_t)(l * 8 + sb) * 3 + (tt + 3)) * 512 + ch];
                    a += x * cw[k]; } }
            XC[t * 64 + c] = a; XCB[t * 72 + c] = f2bf(a);
        }
    }
    __syncthreads();
    {
        const int tb = w >> 1, nb0 = (w & 1) * 2;
        const bf16_t* WT = (const bf16_t*)(p->ws + OFF_WRI + l * SZ_WRI) + hb * 8192;
        f32x16 a0, a1;
#pragma unroll
        for (int i = 0; i < 16; ++i) { a0[i] = 0.f; a1[i] = 0.f; }
#pragma unroll
        for (int s = 0; s < 4; ++s) {
            const bf16x8 a = *(const LAS bf16x8*)(XCB + (32 * tb + r) * 72 + 16 * s + 8 * h);
            const bf16x8 b0 = *(const bf16x8*)(WT + (32 * nb0 + r) * 64 + 16 * s + 8 * h), b1 = *(const bf16x8*)(WT + (32 * (nb0 + 1) + r) * 64 + 16 * s + 8 * h);
            a0 = MFMA32(a, b0, a0); a1 = MFMA32(a, b1, a1);
        }
        const int n0 = 32 * nb0 + r, n1 = n0 + 32;
        const float bias0 = n0 < 64 ? p->in[17][l * 512 + hb * 64 + n0] : p->in[19][l * 512 + hb * 64 + n0 - 64];
        const float bias1 = n1 < 64 ? p->in[17][l * 512 + hb * 64 + n1] : p->in[19][l * 512 + hb * 64 + n1 - 64];
#pragma unroll
        for (int i = 0; i < 16; ++i) { const int t = 32 * tb + crow(i, h); GATE[t * 128 + n0] = fsigmoid(a0[i] + bias0); GATE[t * 128 + n1] = fsigmoid(a1[i] + bias1); }
    }
    __syncthreads();
    float av[16], bv[16];
    {
        const float lam = p->in[20][l * 512 + ch];
        const float sp = log1pf(__expf(-lam));
        float P = 1.f, S = 0.f;
#pragma unroll
        for (int k = 0; k < 16; ++k) { const int t = sub * 16 + k;
            float a = 1.f, bb = 0.f;
            if (t < ntok) { const float rg = GATE[t * 128 + c], ig = GATE[t * 128 + 64 + c], x = XC[t * 64 + c];
                const float la = -8.f * rg * sp; a = __expf(la); bb = sqrtf(fmaxf(-expm1f(2.f * la), 0.f)) * (ig * x); }
            av[k] = a; bv[k] = bb; S = a * S + bb; P *= a; }
        AGL[sub * 64 + c] = P; AGL[512 + sub * 64 + c] = S;
    }
    __syncthreads();
    float* AGG = (float*)(p->ws + OFF_AGG);
    if (!apply) {
        if (sub == 0 && !smp) { float A = 1.f, B = 0.f;
#pragma unroll
            for (int s2 = 0; s2 < 8; ++s2) { const float P = AGL[s2 * 64 + c], S = AGL[512 + s2 * 64 + c]; B = P * B + S; A *= P; }
            float* o = AGG + (size_t)((bg * 8 + hb) * 32 + seg) * 128; o[c] = A; o[64 + c] = B; }
    } else {
        float hcar;
        if (smp) hcar = p->in[7][(size_t)(l * 8 + sb) * 512 + ch];
        else { hcar = 0.f; for (int s2 = 0; s2 < seg; ++s2) { const float* o = AGG + (size_t)((bg * 8 + hb) * 32 + s2) * 128; hcar = o[c] * hcar + o[64 + c]; } }
        for (int s2 = 0; s2 < sub; ++s2) hcar = AGL[s2 * 64 + c] * hcar + AGL[512 + s2 * 64 + c];
#pragma unroll
        for (int k = 0; k < 16; ++k) { const int t = sub * 16 + k;
            hcar = av[k] * hcar + bv[k];
            if (t < ntok) { bf16_t* zp = Z + (size_t)(row0 + t) * ZW + C_BG + ch; bf16_t* zo = dump ? (bf16_t*)(p->ws + WS_NEED) + ch : zp; *zo = f2bf(hcar * bf2f(*zp));
                if (!dump) { if (smp) { if (t == 15) p->out[O_SH + (size_t)(l * 8 + sb) * 512 + ch] = hcar; }
                else if (seg == 31 && t == 127) p->out[O_PH + (size_t)(l * 4 + bg) * 512 + ch] = hcar; } } }
    }
}

struct AttnItem {
    const bf16_t* Q; int ldq, qcol, qrow0, nq;
    const bf16_t* Kn; int ldkn, kncol; const bf16_t* Kr; int krow0;
    const bf16_t* VT; int ldvt, vtrow0, vcol0;
    int nkeys, ntmax, tbase, causal;
    float scale;
    bf16_t* O; int ldo, ocol, gate;
};
template <bool ROPE>
DI void attn_item(const AttnItem& it, LAS unsigned char* lds, int tid) {
    constexpr int NK = ROPE ? 6 : 4;
    const int w = tid >> 6, lane = tid & 63, r = lane & 31, h = lane >> 5;
    LAS bf16_t* Kl = (LAS bf16_t*)lds; LAS bf16_t* VTl = (LAS bf16_t*)(lds + 64 * 104 * 2);
    const int qi = 32 * w + r; const bool qvalid = qi < it.nq; const int qrow = it.qrow0 + (qvalid ? qi : 0);
    const int mytiles = (32 * w >= it.nq) ? 0 : (it.causal ? it.tbase + (w >> 1) + 1 : it.ntmax);
    bf16x8 qf[NK];
#pragma unroll
    for (int ks = 0; ks < NK; ++ks) qf[ks] = *(const bf16x8*)(it.Q + (size_t)qrow * it.ldq + it.qcol + 16 * ks + 8 * h);
    f32x16 o0, o1;
#pragma unroll
    for (int i = 0; i < 16; ++i) { o0[i] = 0.f; o1[i] = 0.f; }
    float mrun = -1e30f, lsum = 0.f;
    const float sc = it.scale;
    const int lk = tid >> 3, lc = tid & 7, rk = tid >> 2, rc = tid & 3;
    u32x4 kreg, rreg = {0u, 0u, 0u, 0u}, vreg;
    kreg = *(const u32x4*)(it.Kn + (size_t)(it.krow0 + lk) * it.ldkn + it.kncol + lc * 8);
    if (ROPE && tid < 256) rreg = *(const u32x4*)(it.Kr + (size_t)(it.krow0 + rk) * 32 + rc * 8);
    vreg = *(const u32x4*)(it.VT + (size_t)(it.vtrow0 + lk) * it.ldvt + it.vcol0 + lc * 8);
    for (int kt = 0; kt < it.ntmax; ++kt) {
        __syncthreads();
        *(LAS u32x4*)(Kl + lk * 104 + lc * 8) = kreg;
        if (ROPE && tid < 256) *(LAS u32x4*)(Kl + rk * 104 + 64 + rc * 8) = rreg;
        *(LAS u32x4*)(VTl + lk * 72 + lc * 8) = vreg;
        __syncthreads();
        if (kt + 1 < it.ntmax) {
            const int k0 = (kt + 1) * 64;
            kreg = *(const u32x4*)(it.Kn + (size_t)(it.krow0 + k0 + lk) * it.ldkn + it.kncol + lc * 8);
            if (ROPE && tid < 256) rreg = *(const u32x4*)(it.Kr + (size_t)(it.krow0 + k0 + rk) * 32 + rc * 8);
            vreg = *(const u32x4*)(it.VT + (size_t)(it.vtrow0 + lk) * it.ldvt + it.vcol0 + k0 + lc * 8);
        }
        if (kt < mytiles) {
            f32x16 s0, s1;
#pragma unroll
            for (int i = 0; i < 16; ++i) { s0[i] = 0.f; s1[i] = 0.f; }
#pragma unroll
            for (int ks = 0; ks < NK; ++ks) {
                const bf16x8 ka0 = *(const LAS bf16x8*)(Kl + r * 104 + 16 * ks + 8 * h), ka1 = *(const LAS bf16x8*)(Kl + (32 + r) * 104 + 16 * ks + 8 * h);
                s0 = MFMA32(ka0, qf[ks], s0); s1 = MFMA32(ka1, qf[ks], s1);
            }
            if ((kt + 1) * 64 > it.nkeys) {
#pragma unroll
                for (int i = 0; i < 16; ++i) { const int key = kt * 64 + crow(i, h); if (key >= it.nkeys) s0[i] = -1e30f; if (key + 32 >= it.nkeys) s1[i] = -1e30f; }
            }
            float mx = s0[0];
#pragma unroll
            for (int i = 1; i < 16; ++i) mx = fmaxf(mx, s0[i]);
#pragma unroll
            for (int i = 0; i < 16; ++i) mx = fmaxf(mx, s1[i]);
            mx = fmaxf(mx, __shfl_xor(mx, 32));
            const float mnew = fmaxf(mrun, mx);
            const float alpha = __builtin_amdgcn_exp2f((mrun - mnew) * sc);
            mrun = mnew;
            const float mc = mnew * sc;
            float ps = 0.f;
#pragma unroll
            for (int i = 0; i < 16; ++i) { s0[i] = __builtin_amdgcn_exp2f(s0[i] * sc - mc); s1[i] = __builtin_amdgcn_exp2f(s1[i] * sc - mc); ps += s0[i] + s1[i]; }
            lsum = lsum * alpha + ps;
#pragma unroll
            for (int i = 0; i < 16; ++i) { o0[i] *= alpha; o1[i] *= alpha; }
#pragma unroll
            for (int kk = 0; kk < 4; ++kk) {
                const int s8 = (kk & 1) * 8;
                u32x4 pw;
                if (kk < 2) { pw.x = cvt_pk(s0[s8], s0[s8 + 1]); pw.y = cvt_pk(s0[s8 + 2], s0[s8 + 3]); pw.z = cvt_pk(s0[s8 + 4], s0[s8 + 5]); pw.w = cvt_pk(s0[s8 + 6], s0[s8 + 7]); }
                else { pw.x = cvt_pk(s1[s8], s1[s8 + 1]); pw.y = cvt_pk(s1[s8 + 2], s1[s8 + 3]); pw.z = cvt_pk(s1[s8 + 4], s1[s8 + 5]); pw.w = cvt_pk(s1[s8 + 6], s1[s8 + 7]); }
                const bf16x8 pf = __builtin_bit_cast(bf16x8, pw);
                const s16x4 a0l = *(const LAS s16x4*)(VTl + r * 72 + 16 * kk + 4 * h), a0h = *(const LAS s16x4*)(VTl + r * 72 + 16 * kk + 8 + 4 * h);
                const s16x4 a1l = *(const LAS s16x4*)(VTl + (32 + r) * 72 + 16 * kk + 4 * h), a1h = *(const LAS s16x4*)(VTl + (32 + r) * 72 + 16 * kk + 8 + 4 * h);
                const bf16x8 va0 = __builtin_shufflevector(a0l, a0h, 0, 1, 2, 3, 4, 5, 6, 7), va1 = __builtin_shufflevector(a1l, a1h, 0, 1, 2, 3, 4, 5, 6, 7);
                o0 = MFMA32(va0, pf, o0); o1 = MFMA32(va1, pf, o1);
            }
        }
    }
    const float ltot = lsum + __shfl_xor(lsum, 32);
    if (qvalid && mytiles > 0) {
        const float inv = 1.f / ltot;
        bf16_t* orow = it.O + (size_t)qrow * it.ldo + it.ocol;
#pragma unroll
        for (int db = 0; db < 2; ++db)
#pragma unroll
            for (int g4 = 0; g4 < 4; ++g4) {
                const int dv0 = 32 * db + 8 * g4 + 4 * h;
                float v[4];
#pragma unroll
                for (int j = 0; j < 4; ++j) v[j] = (db ? o1[4 * g4 + j] : o0[4 * g4 + j]) * inv;
                u32x2* dst = (u32x2*)(orow + dv0);
                if (it.gate) { const u32x2 gw = *dst; v[0] *= bflo(gw.x); v[1] *= bfhi(gw.x); v[2] *= bflo(gw.y); v[3] *= bfhi(gw.y); }
                u32x2 ow; ow.x = cvt_pk(v[0], v[1]); ow.y = cvt_pk(v[2], v[3]);
                *dst = ow;
            }
    }
}

#define XB_TMO      128
#define XB_XCNT(j)  (256  + 64 * (j))
#define XB_XSUB(j)  (1280 + 64 * (j))
#define XB_XGEN(j)  (2304 + 64 * (j))
#define XB_TOP      3328
#define XB_TOPGEN   3392
#define XCD_BAR_WORDS 3456
#define XB_SPIN_CAP (1u << 18)
DI unsigned xb_ld(unsigned* p)              { return __hip_atomic_load(p, __ATOMIC_RELAXED, __HIP_MEMORY_SCOPE_AGENT); }
DI unsigned xb_add(unsigned* p, unsigned v) { return __hip_atomic_fetch_add(p, v, __ATOMIC_RELAXED, __HIP_MEMORY_SCOPE_AGENT); }
DI unsigned xb_xcc_id() { return (unsigned)__builtin_amdgcn_s_getreg((3 << 11) | 20) & 0xFu; }
#define XB_SPIN(cond, bar) do { unsigned _sp = 0; while (cond) { __builtin_amdgcn_s_sleep(1); \
    if ((++_sp & 255u) == 0u) { if (xb_ld(&(bar)[XB_TMO])) break; if (_sp > XB_SPIN_CAP) { atomicAdd(&(bar)[XB_TMO], 1u); break; } } } } while (0)
struct XcdBarrier { unsigned* bar; unsigned x; volatile LAS unsigned* st; };
DI XcdBarrier xcd_barrier_post(unsigned* bar, volatile LAS unsigned* st) {
    XcdBarrier b; b.bar = bar; b.x = xb_xcc_id(); b.st = st;
    if (threadIdx.x == 0) (void)xb_add(&bar[XB_XCNT(b.x)], 1u);
    return b;
}
DI void xcd_barrier_complete(unsigned* bar, unsigned x, unsigned& nloc, unsigned& nx) {
    const unsigned G = gridDim.x * gridDim.y * gridDim.z;
    unsigned sum, cnt, mine, sp = 0u;
    for (;;) {
        sum = 0u; cnt = 0u; mine = 0u;
#pragma unroll
        for (unsigned j = 0; j < 16; ++j) { const unsigned c = xb_ld(&bar[XB_XCNT(j)]); sum += c; cnt += (c > 0u) ? 1u : 0u; mine = (j == x) ? c : mine; }
        if (sum == G) break;
        __builtin_amdgcn_s_sleep(1);
        if ((++sp & 255u) == 0u) { if (xb_ld(&bar[XB_TMO])) break; if (sp > XB_SPIN_CAP) { atomicAdd(&bar[XB_TMO], 1u); break; } }
    }
    nloc = mine > 0u ? mine : 1u; nx = cnt > 0u ? cnt : 1u;
}
DI void xcd_barrier(const XcdBarrier& b) {
    asm volatile("s_waitcnt vmcnt(0)" ::: "memory");
    __syncthreads();
    if (threadIdx.x == 0) {
        unsigned* bar = b.bar;
        __builtin_amdgcn_s_waitcnt(0);
        unsigned nloc = b.st[0], nx = b.st[1];
        if (nloc == 0u) { xcd_barrier_complete(bar, b.x, nloc, nx); b.st[0] = nloc; b.st[1] = nx; }
        const unsigned old = xb_add(&bar[XB_XSUB(b.x)], 1u);
        const unsigned gen = old / nloc;
        if (old + 1u == (gen + 1u) * nloc) {
            __builtin_amdgcn_fence(__ATOMIC_RELEASE, "agent");
            asm volatile("s_waitcnt vmcnt(0)" ::: "memory");
            const unsigned og = xb_add(&bar[XB_TOP], 1u);
            const unsigned tg = og / nx;
            if (og + 1u == (tg + 1u) * nx) xb_add(&bar[XB_TOPGEN], 1u);
            else XB_SPIN(xb_ld(&bar[XB_TOPGEN]) == tg, bar);
            __builtin_amdgcn_fence(__ATOMIC_ACQUIRE, "agent");
            xb_add(&bar[XB_XGEN(b.x)], 1u);
            asm volatile("s_waitcnt vmcnt(0)" ::: "memory");
        } else {
            XB_SPIN(xb_ld(&bar[XB_XGEN(b.x)]) == gen, bar);
            __builtin_amdgcn_fence(__ATOMIC_ACQUIRE, "agent");
            asm volatile("s_waitcnt vmcnt(0)" ::: "memory");
        }
    }
    __syncthreads();
}

__global__ void __launch_bounds__(512, 2) mega(Params pk) {
    extern __shared__ __attribute__((aligned(16))) unsigned char shm[];
    LAS unsigned char* lds = (LAS unsigned char*)shm;
    cg::grid_group grid = cg::this_grid();
    __shared__ uint4 xb_words;
    if (threadIdx.x == 0) xb_words = make_uint4(0u, 0u, 0u, 0u);
    __syncthreads();
    XcdBarrier xb = xcd_barrier_post((unsigned*)(((KP)__builtin_amdgcn_kernarg_segment_ptr())->ws + OFF_BAR), (volatile LAS unsigned*)&xb_words);
    { KP p = (KP)__builtin_amdgcn_kernarg_segment_ptr(); int tid0 = threadIdx.x; asm volatile("" : "+v"(tid0)); prep_phase(p, lds, tid0); if (PROBE & 64) { grid.sync(); prep_phase(p, lds, tid0); } }
    grid.sync();
    if (PROBE & 256) { for (int k = 0; k < 20; ++k) xcd_barrier(xb); }
    for (int step = 0; step < 14; ++step) {
        const int l = step / 7, ph = step % 7;
        KP p = (KP)__builtin_amdgcn_kernarg_segment_ptr(); asm volatile("" : "+s"(p));
        int tid = threadIdx.x; asm volatile("" : "+v"(tid));
        int wg = blockIdx.x, G = gridDim.x; asm volatile("" : "+s"(wg), "+s"(G));
        unsigned char* ws = p->ws; unsigned char* dob = (unsigned char*)p->out;
        const int gph = ph == 0 ? 0 : ph == 2 ? 1 : ph == 4 ? 2 : ph == 5 ? 3 : -1;
        if (gph >= 0) {
            const int ndup = ((PROBE & 1) && gph == 0) || ((PROBE & 2) && gph == 1) || ((PROBE & 4) && gph == 2) || ((PROBE & 128) && gph == 3) ? 2 : 1;
#pragma unroll 1
            for (int rep = 0; rep < ndup; ++rep) { gemm_stream(p, gph, l, lds, tid, wg, G, rep + 1 < ndup); if (rep + 1 < ndup) xcd_barrier(xb); }
        }
        if (ph == 1) rows_phase(p, l, tid);
        else if (ph == 2) {
            __syncthreads();
            for (int t = wg; t < 512 + 32; t += G) {
                if (t < 512) { if (PROBE & 32) gmlp_tile(p, l, t >> 7, (t >> 2) & 31, t & 3, lds, tid, true); gmlp_tile(p, l, t >> 7, (t >> 2) & 31, t & 3, lds, tid); }
                else { const int s = t - 512; gmlp_sample(p, l, s >> 2, s & 3, tid); }
            }
            for (int t = wg; t < 256 + 32; t += G) {
                AttnItem it;
                it.Q = (const bf16_t*)(ws + OFF_Z); it.ldq = ZW; it.Kr = nullptr; it.scale = 0.125f * 1.44269504089f;
                it.O = (bf16_t*)(ws + OFF_Z); it.ldo = ZW; it.gate = 0; it.nkeys = 256; it.ntmax = 4; it.tbase = 0; it.causal = 0; it.krow0 = 0; it.vcol0 = 0;
                if (t < 256) { const int b = t >> 6, hh = (t >> 4) & 3, qb = t & 15;
                    it.qcol = C_MQ + hh * 64; it.qrow0 = b * 4096 + qb * 256; it.nq = 256;
                    it.Kn = (const bf16_t*)(ws + OFF_MK) + (size_t)b * 256 * 256; it.ldkn = 256; it.kncol = hh * 64;
                    it.VT = (const bf16_t*)(ws + OFF_MVT); it.ldvt = 1024; it.vtrow0 = hh * 64; it.vcol0 = b * 256; }
                else { const int s = t - 256, b = s >> 2, hh = s & 3;
                    it.qcol = C_MQ + hh * 64; it.qrow0 = TP + b * 16; it.nq = 16;
                    it.Kn = (const bf16_t*)(ws + OFF_MKS) + (size_t)(l * 8 + b) * 65536; it.ldkn = 256; it.kncol = hh * 64;
                    it.VT = (const bf16_t*)(ws + OFF_MVTS) + (size_t)(l * 8 + b) * 65536; it.ldvt = 256; it.vtrow0 = hh * 64; }
                it.ocol = it.qcol;
                if (PROBE & 32) { AttnItem d = it; d.O = (bf16_t*)(ws + WS_NEED); d.ldo = 64; d.ocol = 0; attn_item<false>(d, lds, tid); }
                attn_item<false>(it, lds, tid);
            }
            for (int t = wg; t < 1024; t += G) { if (PROBE & 8) lru_tile(p, l, t >> 8, (t >> 5) & 7, t & 31, false, lds, tid); lru_tile(p, l, t >> 8, (t >> 5) & 7, t & 31, false, lds, tid); }
        } else if (ph == 3) {
            for (int t = wg; t < 256 + 64; t += G) {
                AttnItem it;
                it.Q = (const bf16_t*)(dob + DO_Q); it.ldq = 768; it.Kn = (const bf16_t*)(dob + DO_KN); it.ldkn = 512; it.Kr = (const bf16_t*)(dob + DO_KR);
                it.VT = (const bf16_t*)(ws + OFF_VT); it.ldvt = KVROWS; it.scale = 0.10206207262f * 1.44269504089f;
                it.O = (bf16_t*)(ws + OFF_Z); it.ldo = ZW; it.gate = 1;
                if (t < 256) { const int b = t >> 6, hh = (t >> 3) & 7, x = t & 7;
                    it.qcol = hh * 96; it.kncol = hh * 64; it.krow0 = b * 4096; it.vtrow0 = hh * 64; it.vcol0 = b * 4096; it.ocol = C_CG + hh * 64; it.nq = 256; it.nkeys = 4096; it.causal = 1;
#pragma unroll 1
                    for (int half = 0; half < 2; ++half) { const int qb = half ? 15 - x : x;
                        it.qrow0 = b * 4096 + qb * 256; it.tbase = 4 * qb; it.ntmax = 4 * qb + 4;
                        if (PROBE & 16) { AttnItem d = it; d.O = (bf16_t*)(ws + WS_NEED); d.ldo = 64; d.ocol = 0; d.gate = 0; attn_item<true>(d, lds, tid); }
                        attn_item<true>(it, lds, tid); } }
                else { const int s = t - 256, b = s >> 3, hh = s & 7;
                    it.qcol = hh * 96; it.kncol = hh * 64; it.krow0 = TP + b * SKEYS; it.vtrow0 = hh * 64; it.vcol0 = TP + b * SKEYS; it.ocol = C_CG + hh * 64;
                    it.qrow0 = TP + b * 16; it.nq = 16; it.nkeys = SKEYS; it.causal = 0; it.tbase = 0; it.ntmax = 17;
                    if (PROBE & 16) { AttnItem d = it; d.O = (bf16_t*)(ws + WS_NEED); d.ldo = 64; d.ocol = 0; d.gate = 0; attn_item<true>(d, lds, tid); }
                    attn_item<true>(it, lds, tid); }
            }
            for (int t = wg; t < 1024 + 64; t += G) {
                if (t < 1024) { if (PROBE & 8) lru_tile(p, l, t >> 8, (t >> 5) & 7, t & 31, true, lds, tid, true); lru_tile(p, l, t >> 8, (t >> 5) & 7, t & 31, true, lds, tid); }
                else { const int s = t - 1024; lru_tile(p, l, 4 + (s >> 3), s & 7, 0, true, lds, tid); }
            }
        } else if (ph == 6) { if ((PROBE & 1024) && l == 0) { ln_phase(p, l, tid); xcd_barrier(xb); } ln_phase(p, l, tid); }
        if (step < 13) xcd_barrier(xb);
    }
}

extern "C" void kernel_launch(void* const* d_in, const int* in_sizes, int n_in, void* d_out, int out_size, void* d_ws, size_t ws_size, hipStream_t stream) {
    constexpr size_t kDynLds = 131072;
    static int grid_blocks = 0;
    if (!grid_blocks) {
        int dev = 0, cus = 0, per_cu = 0;
        (void)hipGetDevice(&dev);
        (void)hipDeviceGetAttribute(&cus, hipDeviceAttributeMultiprocessorCount, dev);
        (void)hipFuncSetAttribute((const void*)mega, hipFuncAttributeMaxDynamicSharedMemorySize, (int)kDynLds);
        (void)hipOccupancyMaxActiveBlocksPerMultiprocessor(&per_cu, mega, 512, kDynLds);
        if (per_cu > 1) per_cu = 1;
        grid_blocks = cus * per_cu;
        if (grid_blocks > 256) grid_blocks = 256;
    }
    if (ws_size < WS_NEED) { fprintf(stderr, "workspace too small: %zu < %zu\n", ws_size, (size_t)WS_NEED); return; }
    Params p{};
    for (int i = 0; i < 31; ++i) p.in[i] = (const float*)d_in[i];
    p.out = (float*)d_out; p.ws = (unsigned char*)d_ws;
    (void)hipMemsetAsync((unsigned char*)d_ws + OFF_BAR, 0, 16384, stream);
    void* args[] = {&p};
    hipError_t e = hipLaunchCooperativeKernel((void*)mega, dim3(grid_blocks), dim3(512), args, kDynLds, stream);
    if (e != hipSuccess) fprintf(stderr, "cooperative launch failed: %s (grid %d)\n", hipGetErrorString(e), grid_blocks);
}
```

```cpp
#include <hip/hip_runtime.h>
#include <hip/hip_cooperative_groups.h>
#include <cstdio>
namespace cg = cooperative_groups;

#define LAS __attribute__((address_space(3)))
#define DI __device__ __forceinline__
typedef unsigned short bf16_t;
typedef short bf16x8 __attribute__((ext_vector_type(8)));
typedef short s16x4 __attribute__((ext_vector_type(4)));
typedef float f32x2 __attribute__((ext_vector_type(2)));
typedef float f32x4 __attribute__((ext_vector_type(4)));
typedef float f32x16 __attribute__((ext_vector_type(16)));
typedef unsigned u32x2 __attribute__((ext_vector_type(2)));
typedef unsigned u32x4 __attribute__((ext_vector_type(4)));
typedef __bf16 bf16v2 __attribute__((ext_vector_type(2)));

#ifndef PROBE
#define PROBE 0
#endif
constexpr int TP = 16384, NROW = 16512, MROWS = 16640;
constexpr int ZW = 3840;
constexpr int C_AU = 0, C_AV = 512, C_AG = 1024, C_BX = 1536, C_BG = 2048, C_CQ = 2560, C_CKV = 2816, C_CKR = 2944, C_CG = 2976, C_MQ = 3488;
constexpr int KVROWS = 24832, SKEYS = 1040;
constexpr float LN_EPS = 1e-6f;
constexpr float ALPHA_RES = 1.41421356237f;

constexpr size_t SZ_WIN = (size_t)7936 * 1024 * 2, SZ_WUQ = 768 * 256 * 2, SZ_WUK = 512 * 256 * 2, SZ_WBR = (size_t)1024 * 1792 * 2, SZ_WOUT = 1024 * 1024 * 2,
                 SZ_MEMW = 512 * 1024 * 2, SZ_WRI = 8 * 128 * 64 * 2, SZ_GWS = 4 * 128 * 128 * 2;
constexpr size_t OFF_WIN = 0;
constexpr size_t OFF_WUQ = OFF_WIN + 2 * SZ_WIN;
constexpr size_t OFF_WUK = OFF_WUQ + 2 * SZ_WUQ;
constexpr size_t OFF_WUV = OFF_WUK + 2 * SZ_WUK;
constexpr size_t OFF_WBR = OFF_WUV + 2 * SZ_WUK;
constexpr size_t OFF_WOUT = OFF_WBR + 2 * SZ_WBR;
constexpr size_t OFF_MEMW = OFF_WOUT + 2 * SZ_WOUT;
constexpr size_t OFF_WRI = OFF_MEMW + 2 * SZ_MEMW;
constexpr size_t OFF_GWS = OFF_WRI + 2 * SZ_WRI;
constexpr size_t OFF_XB = OFF_GWS + 2 * SZ_GWS;
constexpr size_t OFF_MEMB = OFF_XB + (size_t)MROWS * 1024 * 2;
constexpr size_t OFF_MK = OFF_MEMB + (size_t)1024 * 1024 * 2;
constexpr size_t OFF_MVT = OFF_MK + 1024 * 256 * 2;
constexpr size_t OFF_MKS = OFF_MVT + 256 * 1024 * 2;
constexpr size_t OFF_MVTS = OFF_MKS + (size_t)2 * 2048 * 256 * 2;
constexpr size_t OFF_Z = OFF_MVTS + (size_t)2 * 2048 * 256 * 2;
constexpr size_t OFF_VT = OFF_Z + (size_t)MROWS * ZW * 2;
constexpr size_t OFF_MERGED = OFF_VT;
constexpr size_t OFF_STATS = OFF_VT + (size_t)MROWS * 1024 * 2;
constexpr size_t OFF_AGG = OFF_STATS + (size_t)2 * MROWS * 64 * 4;
constexpr size_t OFF_BAR = OFF_AGG + (size_t)1024 * 128 * 4;
constexpr size_t OFF_MS = OFF_BAR + 16384;
constexpr size_t WS_NEED = OFF_MS + (size_t)128 * 1024 * 4;
static_assert(WS_NEED <= (size_t)256 * 1024 * 1024, "workspace over 256 MiB");
constexpr size_t DO_Q = 0;
constexpr size_t DO_CKV = DO_Q + (size_t)MROWS * 768 * 2;
constexpr size_t DO_KR = DO_CKV + (size_t)KVROWS * 256 * 2;
constexpr size_t DO_KN = DO_KR + (size_t)KVROWS * 32 * 2;
constexpr size_t DO_END = DO_KN + (size_t)KVROWS * 512 * 2;
constexpr size_t DO_GSCR = 0;
static_assert(DO_END <= (size_t)NROW * 4096, "scratch in d_out too large");
static_assert((size_t)256 * 4 * 16 * 512 * 8 <= (size_t)NROW * 4096, "gscr too large");
constexpr size_t O_YS = 16777216, O_PCKV = 16908288, O_PKR = 21102592, O_PMK = 22151168, O_PMV = 22675456, O_PH = 23199744, O_PCONV = 23203840,
                 O_SCKV = 23216128, O_SKR = 23248896, O_SH = 23257088, O_SCONV = 23265280, O_SGV = 23289856;

struct Params {
    const float* in[31];
    float* out;
    unsigned char* ws;
};
typedef const __attribute__((address_space(4))) Params* KP;

DI float bf2f(unsigned short b) { return __uint_as_float(((unsigned)b) << 16); }
DI float bflo(unsigned w) { return __uint_as_float(w << 16); }
DI float bfhi(unsigned w) { return __uint_as_float(w & 0xffff0000u); }
DI unsigned cvt_pk(float lo, float hi) { f32x2 v = {lo, hi}; return __builtin_bit_cast(unsigned, __builtin_convertvector(v, bf16v2)); }
DI unsigned short f2bf(float x) { return (unsigned short)(cvt_pk(x, x) & 0xffffu); }
DI u32x4 pack8(f32x4 a, f32x4 b) { u32x4 w; w.x = cvt_pk(a[0], a[1]); w.y = cvt_pk(a[2], a[3]); w.z = cvt_pk(b[0], b[1]); w.w = cvt_pk(b[2], b[3]); return w; }
DI void unpack8(u32x4 w, float* f) { f[0] = bflo(w.x); f[1] = bfhi(w.x); f[2] = bflo(w.y); f[3] = bfhi(w.y); f[4] = bflo(w.z); f[5] = bfhi(w.z); f[6] = bflo(w.w); f[7] = bfhi(w.w); }
DI float fsigmoid(float x) { return __builtin_amdgcn_rcpf(1.f + __expf(-x)); }
DI float fsilu(float x) { return x * fsigmoid(x); }
DI float fgelu(float x) { return x * fsigmoid(1.5957691216f * (x + 0.044715f * x * x * x)); }
DI float wave_sum(float v) {
#pragma unroll
    for (int o = 32; o >= 1; o >>= 1) v += __shfl_xor(v, o);
    return v;
}
DI int crow(int reg, int h) { return (reg & 3) + 8 * (reg >> 2) + 4 * h; }
#define MFMA32(a, b, c) __builtin_amdgcn_mfma_f32_32x32x16_bf16((a), (b), (c), 0, 0, 0)

constexpr int HTB = 128 * 64 * 2;
DI int lds_byte(int r, int c) { const int st = (r >> 4) * 2 + (c >> 5), rr = r & 15, cc = c & 31, ob = rr * 64 + cc * 2; return st * 1024 + (ob ^ (((ob >> 9) & 1) << 5)); }
DI void stage_rc(int b, int& R, int& C) { const int st = b / 1024, sb = b % 1024, swz = sb ^ (((sb >> 9) & 1) << 5); R = (st >> 1) * 16 + swz / 64; C = (st & 1) * 32 + (swz % 64) / 2; }
DI int perm32(int rho) { const int n = rho >> 4, i = rho & 15; return 8 * (i >> 2) + 4 * n + (i & 3); }

enum { K_Z = 0, K_MEMKV = 1, K_PLAIN = 2, K_QP = 3, K_EG = 4, K_EY = 5, K_F = 6 };
struct GU {
    const char* A; const char* B;
    int lda, ldb;
    int nt;
    int kind, pm, pn, aux;
    bf16_t* C; int ldc;
};

DI bool next_unit(KP p, int gph, int l, int i, GU& u, int wg, int G) {
    unsigned char* ws = p->ws; unsigned char* dob = (unsigned char*)p->out;
    u.aux = 0; u.C = nullptr; u.ldc = 0;
    const bool xm = (G == 256);
    const int x = wg & 7, j = wg >> 3;
    if (gph == 0) {
        int e = -1;
        if (xm) { const int uu = j + 32 * i;
            if (uu < 120) { u.pm = 8 * x + (uu & 7); u.pn = uu >> 3; }
            else { if (j >= 24 && i == 3) e = (j - 24) * 8 + x; if (e < 0 || e >= 12) return false; } }
        else { const int L = i * G + wg; if (L < 960) { u.pm = L & 63; u.pn = L >> 6; } else { e = L - 960; if (e >= 12) return false; } }
        if (e < 0) { u.A = (const char*)(ws + OFF_XB) + (size_t)u.pm * 256 * 2048; u.B = (const char*)(ws + OFF_WIN + l * SZ_WIN) + (size_t)u.pn * 256 * 2048;
            u.lda = 2048; u.ldb = 2048; u.nt = 16; u.kind = K_Z; return true; }
        if (e < 8) { u.pm = e & 3; u.pn = e >> 2; u.A = (const char*)(ws + OFF_MEMB) + (size_t)u.pm * 256 * 2048; u.B = (const char*)(ws + OFF_MEMW + l * SZ_MEMW) + (size_t)u.pn * 256 * 2048;
            u.lda = 2048; u.ldb = 2048; u.nt = 16; u.kind = K_MEMKV; return true; }
        u.pm = 0; u.pn = e - 8; u.A = (const char*)(ws + OFF_MEMW + l * SZ_MEMW) + (size_t)256 * 2048; u.B = (const char*)(ws + OFF_MEMB) + (size_t)u.pn * 256 * 2048;
        u.lda = 2048; u.ldb = 2048; u.nt = 16; u.kind = K_PLAIN; u.C = (bf16_t*)(ws + OFF_MVT); u.ldc = 1024; return true;
    } else if (gph == 1) {
        int v;
        if (xm) { if (i == 0 && j < 24) { v = -1; u.pm = 8 * x + (j & 7); u.pn = j >> 3; } else v = ((j + 8) & 31) * 8 + x + 256 * (j < 24 ? i - 1 : i); }
        else { const int L = i * G + wg; if (L < 192) { v = -1; u.pm = L & 63; u.pn = L >> 6; } else v = L - 192; }
        if (v < 0) { u.A = (const char*)(ws + OFF_Z) + (size_t)u.pm * 256 * (ZW * 2) + C_CQ * 2; u.lda = ZW * 2;
            u.B = (const char*)(ws + OFF_WUQ + l * SZ_WUQ) + (size_t)u.pn * 256 * 512; u.ldb = 512; u.nt = 4; u.kind = K_QP; return true; }
        if (v < 194) { u.pm = v % 97; u.pn = v / 97; u.A = (const char*)(dob + DO_CKV) + (size_t)u.pm * 256 * 512; u.lda = 512;
            u.B = (const char*)(ws + OFF_WUK + l * SZ_WUK) + (size_t)u.pn * 256 * 512; u.ldb = 512; u.nt = 4; u.kind = K_PLAIN; u.C = (bf16_t*)(dob + DO_KN); u.ldc = 512; return true; }
        v -= 194;
        if (v < 194) { u.pm = v / 97; u.pn = v % 97; u.A = (const char*)(ws + OFF_WUV + l * SZ_WUK) + (size_t)u.pm * 256 * 512; u.lda = 512;
            u.B = (const char*)(dob + DO_CKV) + (size_t)u.pn * 256 * 512; u.ldb = 512; u.nt = 4; u.kind = K_PLAIN; u.C = (bf16_t*)(ws + OFF_VT); u.ldc = KVROWS; return true; }
        return false;
    } else if (gph == 2) {
        const int rr = i >> 3, sub = i & 7;
        if (xm) { if (rr > 0) return false; u.pm = 8 * x + (j & 7); u.pn = j >> 3; }
        else { const int tt = wg + G * rr; if (tt >= 256) return false; u.pm = tt & 63; u.pn = tt >> 6; }
        const int ib = sub & 3; u.aux = ib;
        if (sub < 4) { u.A = (const char*)(ws + OFF_XB) + (size_t)u.pm * 256 * 2048; u.lda = 2048;
            u.B = (const char*)(ws + OFF_WIN + l * SZ_WIN) + (size_t)(3840 + ib * 1024 + u.pn * 256) * 2048; u.ldb = 2048; u.nt = 16; u.kind = K_EG; }
        else { const int zc = ib == 0 ? C_AU : ib == 1 ? C_BG : ib == 2 ? C_CG : C_MQ;
            u.A = (const char*)(ws + OFF_Z) + (size_t)u.pm * 256 * (ZW * 2) + zc * 2; u.lda = ZW * 2;
            u.B = (const char*)(ws + OFF_WBR + l * SZ_WBR) + (size_t)u.pn * 256 * 3584 + ib * 512 * 2; u.ldb = 3584; u.nt = ib < 3 ? 8 : 4; u.kind = K_EY; }
        return true;
    } else {
        if (xm) { if (i > 0) return false; u.pm = 8 * x + (j & 7); u.pn = j >> 3; }
        else { const int L = i * G + wg; if (L >= 256) return false; u.pm = L & 63; u.pn = L >> 6; }
        u.A = (const char*)(ws + OFF_MERGED) + (size_t)u.pm * 256 * 2048; u.lda = 2048;
        u.B = (const char*)(ws + OFF_WOUT + l * SZ_WOUT) + (size_t)u.pn * 256 * 2048; u.ldb = 2048; u.nt = 16; u.kind = K_F; return true;
    }
}

DI void rope_pair(float& a, float& b, float pos, int jj) {
    const float freq = exp2f(-(float)jj * 0.83048202372f);
    const float ang = pos * freq;
    const float rev = __builtin_amdgcn_fractf(ang * 0.15915494309f);
    const float sn = __builtin_amdgcn_sinf(rev), cs = __builtin_amdgcn_cosf(rev);
    const float x1 = a, x2 = b;
    a = x1 * cs - x2 * sn; b = x1 * sn + x2 * cs;
}

DI void epi_z(KP p, int row, int col, f32x4 v0, f32x4 v1) {
    int act = 0;
    if (col < C_AG) act = 1; else if (col < C_BX) act = 2; else if (col < C_BG) act = 0; else if (col < C_CQ) act = 2; else if (col < C_CG) act = 0; else if (col < C_MQ) act = 2;
    if (act == 1) {
#pragma unroll
        for (int j = 0; j < 4; ++j) { v0[j] = fgelu(v0[j]); v1[j] = fgelu(v1[j]); }
    } else if (act == 2) {
#pragma unroll
        for (int j = 0; j < 4; ++j) { v0[j] = fsilu(v0[j]); v1[j] = fsilu(v1[j]); }
    }
    *(u32x4*)((bf16_t*)(p->ws + OFF_Z) + (size_t)row * ZW + col) = pack8(v0, v1);
}
DI void epi_qp(KP p, int row, int col, f32x4 v0, f32x4 v1) {
    const int d = col % 96;
    if (d >= 64) {
        const float pos = row < TP ? (float)(row & 4095) : (float)(1024 + ((row - TP) & 15));
        const int j0 = (d - 64) >> 1;
        float t0 = v0[0], t1 = v0[1], t2 = v0[2], t3 = v0[3], t4 = v1[0], t5 = v1[1], t6 = v1[2], t7 = v1[3];
        rope_pair(t0, t1, pos, j0); rope_pair(t2, t3, pos, j0 + 1); rope_pair(t4, t5, pos, j0 + 2); rope_pair(t6, t7, pos, j0 + 3);
        v0 = (f32x4){t0, t1, t2, t3}; v1 = (f32x4){t4, t5, t6, t7};
    }
    *(u32x4*)((bf16_t*)((unsigned char*)p->out + DO_Q) + (size_t)row * 768 + col) = pack8(v0, v1);
}
DI void epi_f(KP p, int l, int row, int col, f32x4 v0, f32x4 v1, float& s1, float& s2) {
    float x[8];
    if (l == 0) { const float* xs = row < TP ? p->in[0] + (size_t)row * 1024 + col : p->in[1] + (size_t)((row < NROW ? row : TP) - TP) * 1024 + col;
        const f32x4 a = *(const f32x4*)xs, b = *(const f32x4*)(xs + 4);
#pragma unroll
        for (int j = 0; j < 4; ++j) { x[j] = a[j]; x[4 + j] = b[j]; } }
    else { const u32x4 xw = *(const u32x4*)((const bf16_t*)(p->ws + OFF_XB) + (size_t)row * 1024 + col); unpack8(xw, x); }
#pragma unroll
    for (int j = 0; j < 4; ++j) { v0[j] = ALPHA_RES * x[j] + v0[j]; v1[j] = ALPHA_RES * x[4 + j] + v1[j]; s1 += v0[j] + v1[j]; s2 += v0[j] * v0[j] + v1[j] * v1[j]; }
    if (row < NROW) { float* o = p->out + (size_t)row * 1024 + col; *(f32x4*)o = v0; *(f32x4*)(o + 4) = v1; }
}

DI bool gemm_epilogue(KP p, int l, f32x4 (&acc)[2][2][4][2], const GU& u, int tid_in, int wg, bool dumpst) {
    unsigned char* ws = p->ws;
    int tid = tid_in; asm volatile("" : "+v"(tid));
    const int wid = tid >> 6, lane = tid & 63, wr = wid >> 2, wc = wid & 3, fr = lane & 15, fq = lane >> 4;
#pragma unroll
    for (int ai = 0; ai < 2; ++ai)
#pragma unroll
        for (int m = 0; m < 4; ++m) {
            const int row = u.pm * 256 + ai * 128 + wr * 64 + m * 16 + fr;
            float s1 = 0.f, s2 = 0.f;
#pragma unroll
            for (int bj = 0; bj < 2; ++bj) {
                const int col = u.pn * 256 + bj * 128 + wc * 32 + 8 * fq;
                f32x4 v0 = acc[ai][bj][m][0], v1 = acc[ai][bj][m][1];
                const int vec = (ai * 4 + m) * 2 + bj;
                if (u.kind == K_Z) {
                    epi_z(p, row, col, v0, v1);
                } else if (u.kind == K_MEMKV) {
                    float* o = p->out + (col < 256 ? O_PMK : O_PMV) + (size_t)l * 262144 + (size_t)row * 256 + (col & 255);
                    *(f32x4*)o = v0; *(f32x4*)(o + 4) = v1;
                    if (col < 256) *(u32x4*)((bf16_t*)(ws + OFF_MK) + (size_t)row * 256 + col) = pack8(v0, v1);
                } else if (u.kind == K_PLAIN) {
                    *(u32x4*)(u.C + (size_t)row * u.ldc + col) = pack8(v0, v1);
                } else if (u.kind == K_QP) {
                    epi_qp(p, row, col, v0, v1);
                } else if (u.kind == K_EG) {
                    unsigned q[8];
#pragma unroll
                    for (int j = 0; j < 4; ++j) { q[j] = (unsigned)fminf(fmaxf(__builtin_rintf(255.f * fsigmoid(v0[j])), 1.f), 255.f); q[4 + j] = (unsigned)fminf(fmaxf(__builtin_rintf(255.f * fsigmoid(v1[j])), 1.f), 255.f); }
                    u32x2 w; w.x = q[0] | (q[1] << 8) | (q[2] << 16) | (q[3] << 24); w.y = q[4] | (q[5] << 8) | (q[6] << 16) | (q[7] << 24);
                    *((u32x2*)((unsigned char*)p->out + DO_GSCR) + (((size_t)wg * 4 + u.aux) * 16 + vec) * 512 + tid) = w;
                } else if (u.kind == K_EY) {
                    const u32x2 gw = *((const u32x2*)((unsigned char*)p->out + DO_GSCR) + (((size_t)wg * 4 + u.aux) * 16 + vec) * 512 + tid);
                    float g[8];
#pragma unroll
                    for (int j = 0; j < 4; ++j) { g[j] = (float)((gw.x >> (8 * j)) & 0xffu) * (1.f / 255.f); g[4 + j] = (float)((gw.y >> (8 * j)) & 0xffu) * (1.f / 255.f); }
                    if (u.aux < 3) {
                        const u32x2 nw_ = *((const u32x2*)((unsigned char*)p->out + DO_GSCR) + (((size_t)wg * 4 + u.aux + 1) * 16 + vec) * 512 + tid);
#pragma unroll
                        for (int j = 0; j < 4; ++j) { g[j] *= 255.f * __builtin_amdgcn_rcpf((float)((nw_.x >> (8 * j)) & 0xffu)); g[4 + j] *= 255.f * __builtin_amdgcn_rcpf((float)((nw_.y >> (8 * j)) & 0xffu)); }
                    }
#pragma unroll
                    for (int j = 0; j < 4; ++j) { v0[j] *= g[j]; v1[j] *= g[4 + j]; }
                    if (u.aux < 3) { acc[ai][bj][m][0] = v0; acc[ai][bj][m][1] = v1; }
                    else *(u32x4*)((bf16_t*)(ws + OFF_MERGED) + (size_t)row * 1024 + col) = pack8(v0, v1);
                } else {
                    epi_f(p, l, row, col, v0, v1, s1, s2);
                }
            }
            if (u.kind == K_F) {
                s1 += __shfl_xor(s1, 16); s1 += __shfl_xor(s1, 32); s2 += __shfl_xor(s2, 16); s2 += __shfl_xor(s2, 32);
                if (fq == 0) { float* st = dumpst ? (float*)(ws + WS_NEED) + (row & 1023) * 2 : (float*)(ws + OFF_STATS) + (((size_t)l * MROWS + row) * 32 + u.pn * 4 + wc) * 2;
                    *(f32x2*)st = (f32x2){s1, s2}; }
            }
        }
    return u.kind == K_EY && u.aux < 3;
}

DI void gemm_stream(KP p, int gph, int l, LAS unsigned char* lds, int tid, int wg, int G, bool dumpst = false) {
    const int wid = __builtin_amdgcn_readfirstlane(tid >> 6), lane = tid & 63, wr = wid >> 2, wc = wid & 3, fr = lane & 15, fq = lane >> 4;
    const unsigned ldsw = (unsigned)wid * 1024u;
    const int aoff = lds_byte(wr * 64 + fr, fq * 8), boff = lds_byte(wc * 32 + fr, fq * 8);
#define PG8_SA(b, h) (((b) * 2 + (h)) * HTB)
#define PG8_SB(b, h) ((4 + (b) * 2 + (h)) * HTB)
#define PG8_STAGE(bufoff, gbase, voff) do { const char* _g = (const char*)(gbase); asm volatile("" : "+s"(_g)); _Pragma("unroll") for (int _i = 0; _i < 2; ++_i) \
        __builtin_amdgcn_global_load_lds((const unsigned*)(_g + (voff)[_i]), (LAS unsigned*)(lds + (bufoff) + ldsw + _i * 8192), 16, 0, 0); } while (0)
#define PG8_LDA(dst, b, h) do { _Pragma("unroll") for (int m = 0; m < 4; ++m) _Pragma("unroll") for (int k = 0; k < 2; ++k) dst[m][k] = *(const LAS bf16x8*)(lds + PG8_SA(b, h) + aoff + m * 2048 + k * 1024); } while (0)
#define PG8_LDB(dst, b, h) do { _Pragma("unroll") for (int n = 0; n < 2; ++n) _Pragma("unroll") for (int k = 0; k < 2; ++k) dst[n][k] = *(const LAS bf16x8*)(lds + PG8_SB(b, h) + boff + n * 2048 + k * 1024); } while (0)
#define PG8_MMA(ai, bj, At, Bt) do { __builtin_amdgcn_s_setprio(1); _Pragma("unroll") for (int m = 0; m < 4; ++m) _Pragma("unroll") for (int n = 0; n < 2; ++n) _Pragma("unroll") for (int k = 0; k < 2; ++k) \
        acc[ai][bj][m][n] = __builtin_amdgcn_mfma_f32_16x16x32_bf16(Bt[n][k], At[m][k], acc[ai][bj][m][n], 0, 0, 0); __builtin_amdgcn_s_setprio(0); } while (0)
#define PG8_WAIT_V(n) asm volatile("s_waitcnt vmcnt(" #n ")" ::: "memory")
#define PG8_WAIT_L(n) asm volatile("s_waitcnt lgkmcnt(" #n ")" ::: "memory")
#define PG8_BAR __builtin_amdgcn_s_barrier()
#define PG8_SCHED __builtin_amdgcn_sched_barrier(0)
#define PG8_VOFF(vA, vB, U) do { _Pragma("unroll") for (int _i = 0; _i < 2; ++_i) { int _R, _C; stage_rc(tid * 16 + _i * 8192, _R, _C); const int _Rb = (_R & ~31) + perm32(_R & 31); \
        vA[_i] = (unsigned)(_R * (U).lda + _C * 2); vB[_i] = (unsigned)(_Rb * (U).ldb + _C * 2); } } while (0)
    GU cur, nxt; int ui = 0;
    if (!next_unit(p, gph, l, 0, cur, wg, G)) return;
    f32x4 acc[2][2][4][2];
#pragma unroll
    for (int a = 0; a < 2; ++a)
#pragma unroll
        for (int b = 0; b < 2; ++b)
#pragma unroll
            for (int m = 0; m < 4; ++m)
#pragma unroll
                for (int n = 0; n < 2; ++n) acc[a][b][m][n] = (f32x4){0.f, 0.f, 0.f, 0.f};
    bf16x8 At[4][2], B0[2][2], B1[2][2];
    unsigned cvA[2], cvB[2];
    PG8_VOFF(cvA, cvB, cur);
    const char* cA = cur.A; const char* cB = cur.B;
    size_t chA = (size_t)128 * cur.lda, chB = (size_t)128 * cur.ldb;
    const size_t kstep = 128;
    PG8_STAGE(PG8_SB(0, 0), cB, cvB); PG8_STAGE(PG8_SA(0, 0), cA, cvA); PG8_STAGE(PG8_SB(0, 1), cB + chB, cvB); PG8_STAGE(PG8_SA(0, 1), cA + chA, cvA);
    if (wr == 1) PG8_BAR;
    PG8_WAIT_V(4); PG8_BAR;
    PG8_STAGE(PG8_SB(1, 0), cB + kstep, cvB); PG8_STAGE(PG8_SA(1, 0), cA + kstep, cvA); PG8_STAGE(PG8_SB(1, 1), cB + chB + kstep, cvB);
    PG8_WAIT_V(6); PG8_BAR;
    for (;;) {
        const bool has_next = next_unit(p, gph, l, ui + 1, nxt, wg, G);
        if (!has_next) nxt = cur;
        const char* nA = nxt.A; const char* nB = nxt.B;
        const size_t nhA = (size_t)128 * nxt.lda, nhB = (size_t)128 * nxt.ldb;
        const int nt = cur.nt;
        for (int t = 0; t < nt; t += 2) {
            const bool last = (t == nt - 2);
            const char* a1 = cA + (size_t)(t + 1) * kstep;
            const char* a2 = last ? nA : cA + (size_t)(t + 2) * kstep; const char* b2 = last ? nB : cB + (size_t)(t + 2) * kstep;
            const char* a3 = a2 + kstep; const char* b3 = b2 + kstep;
            unsigned vA2[2], vB2[2];
            if (last) { PG8_VOFF(vA2, vB2, nxt); }
            else {
#pragma unroll
                for (int _i = 0; _i < 2; ++_i) { vA2[_i] = cvA[_i]; vB2[_i] = cvB[_i]; } }
            const size_t hA2 = last ? nhA : chA, hB2 = last ? nhB : chB;
            PG8_LDB(B0, 0, 0); PG8_SCHED; PG8_LDA(At, 0, 0); PG8_STAGE(PG8_SA(1, 1), a1 + chA, cvA);
            PG8_WAIT_L(8); PG8_BAR; PG8_WAIT_L(0); PG8_MMA(0, 0, At, B0); PG8_BAR; PG8_SCHED;
            PG8_LDB(B1, 0, 1); PG8_STAGE(PG8_SB(0, 0), b2, vB2);
            PG8_BAR; PG8_WAIT_L(0); PG8_MMA(0, 1, At, B1); PG8_BAR;
            PG8_LDA(At, 0, 1); PG8_STAGE(PG8_SA(0, 0), a2, vA2);
            PG8_BAR; PG8_WAIT_L(0); PG8_MMA(1, 0, At, B0); PG8_BAR; PG8_SCHED;
            PG8_STAGE(PG8_SB(0, 1), b2 + hB2, vB2);
            PG8_WAIT_V(6); PG8_BAR; PG8_MMA(1, 1, At, B1); PG8_BAR;
            PG8_LDB(B0, 1, 0); PG8_SCHED; PG8_LDA(At, 1, 0); PG8_STAGE(PG8_SA(0, 1), a2 + hA2, vA2);
            PG8_WAIT_L(8); PG8_BAR; PG8_WAIT_L(0); PG8_MMA(0, 0, At, B0); PG8_BAR; PG8_SCHED;
            PG8_LDB(B1, 1, 1); PG8_STAGE(PG8_SB(1, 0), b3, vB2);
            PG8_BAR; PG8_WAIT_L(0); PG8_MMA(0, 1, At, B1); PG8_BAR;
            PG8_LDA(At, 1, 1); PG8_STAGE(PG8_SA(1, 0), a3, vA2);
            PG8_BAR; PG8_WAIT_L(0); PG8_MMA(1, 0, At, B0); PG8_BAR; PG8_SCHED;
            PG8_STAGE(PG8_SB(1, 1), b3 + hB2, vB2);
            PG8_WAIT_V(6); PG8_BAR; PG8_MMA(1, 1, At, B1); PG8_BAR;
        }
        const bool keep = gemm_epilogue(p, l, acc, cur, tid, wg, dumpst);
        if (!has_next) break;
        if (!keep)
#pragma unroll
        for (int a = 0; a < 2; ++a)
#pragma unroll
            for (int b = 0; b < 2; ++b)
#pragma unroll
                for (int m = 0; m < 4; ++m)
#pragma unroll
                    for (int n = 0; n < 2; ++n) acc[a][b][m][n] = (f32x4){0.f, 0.f, 0.f, 0.f};
        cur = nxt; cA = nA; cB = nB; chA = nhA; chB = nhB;
        PG8_VOFF(cvA, cvB, cur);
        ++ui;
    }
    PG8_WAIT_V(0);
    if (wr == 0) PG8_BAR;
    PG8_BAR;
}

template <bool AF32>
DI void skinny_mm(const void* Abase, int lda, const bf16_t* Bt, int ldb, int K, LAS float* T, int tid) {
    const int w = tid >> 6, lane = tid & 63, r = lane & 31, h = lane >> 5, mb = w & 3, kh = w >> 2, K2 = K >> 1;
    f32x16 acc;
#pragma unroll
    for (int i = 0; i < 16; ++i) acc[i] = 0.f;
    const bf16_t* bp = Bt + (size_t)r * ldb + kh * K2 + 8 * h;
    const size_t aoff = (size_t)(32 * mb + r) * lda + kh * K2 + 8 * h;
    for (int k = 0; k < K2; k += 64) {
        bf16x8 a[4], b[4];
#pragma unroll
        for (int u = 0; u < 4; ++u) {
            b[u] = *(const bf16x8*)(bp + k + 16 * u);
            if (AF32) { const float* ap = (const float*)Abase + aoff + k + 16 * u; a[u] = __builtin_bit_cast(bf16x8, pack8(*(const f32x4*)ap, *(const f32x4*)(ap + 4))); }
            else a[u] = *(const bf16x8*)((const bf16_t*)Abase + aoff + k + 16 * u);
        }
#pragma unroll
        for (int u = 0; u < 4; ++u) acc = MFMA32(a[u], b[u], acc);
    }
    __syncthreads();
    if (kh == 0) {
#pragma unroll
        for (int i = 0; i < 16; ++i) T[(32 * mb + crow(i, h)) * 33 + r] = acc[i];
    }
    __syncthreads();
    if (kh == 1) {
#pragma unroll
        for (int i = 0; i < 16; ++i) T[(32 * mb + crow(i, h)) * 33 + r] += acc[i];
    }
    __syncthreads();
}
DI void skinny_read(LAS const float* T, int tid, f32x4& v0, f32x4& v1) {
    const int row = tid >> 2, c8 = (tid & 3) * 8;
#pragma unroll
    for (int j = 0; j < 4; ++j) { v0[j] = T[row * 33 + c8 + j]; v1[j] = T[row * 33 + c8 + 4 + j]; }
}
DI void sample_gemm_phase(KP p, int gph, int l, LAS unsigned char* lds, int tid, int wg, int G) {
    unsigned char* ws = p->ws;
    LAS float* T = (LAS float*)lds;
    const int row = TP + (tid >> 2), c8 = (tid & 3) * 8;
    const bf16_t* XS = (const bf16_t*)(ws + OFF_XB) + (size_t)TP * 1024;
    const bf16_t* ZS = (const bf16_t*)(ws + OFF_Z) + (size_t)TP * ZW;
    f32x4 v0, v1;
    if (gph == 0) {
        for (int s = G - 1 - wg; s < 117; s += G) {
            skinny_mm<false>(XS, 1024, (const bf16_t*)(ws + OFF_WIN + l * SZ_WIN) + (size_t)s * 32 * 1024, 1024, 1024, T, tid);
            skinny_read(T, tid, v0, v1); epi_z(p, row, s * 32 + c8, v0, v1);
        }
    } else if (gph == 1) {
        for (int s = G - 1 - wg; s < 24; s += G) {
            skinny_mm<false>(ZS + C_CQ, ZW, (const bf16_t*)(ws + OFF_WUQ + l * SZ_WUQ) + (size_t)s * 32 * 256, 256, 256, T, tid);
            skinny_read(T, tid, v0, v1); epi_qp(p, row, s * 32 + c8, v0, v1);
        }
    } else if (gph == 2) {
        float* MS = (float*)(ws + OFF_MS);
        for (int it = G - 1 - wg; it < 128; it += G) {
            const int s = it >> 2, ib = it & 3, n0 = s * 32;
            skinny_mm<false>(XS, 1024, (const bf16_t*)(ws + OFF_WIN + l * SZ_WIN) + (size_t)(3840 + ib * 1024 + n0) * 1024, 1024, 1024, T, tid);
            f32x4 g0, g1; skinny_read(T, tid, g0, g1);
            const int zc = ib == 0 ? C_AU : ib == 1 ? C_BG : ib == 2 ? C_CG : C_MQ;
            skinny_mm<false>(ZS + zc, ZW, (const bf16_t*)(ws + OFF_WBR + l * SZ_WBR) + (size_t)n0 * 1792 + ib * 512, 1792, ib < 3 ? 512 : 256, T, tid);
            skinny_read(T, tid, v0, v1);
            float* mp = MS + (size_t)(tid >> 2) * 1024 + n0 + c8;
#pragma unroll
            for (int j = 0; j < 4; ++j) { __hip_atomic_fetch_add(mp + j, fsigmoid(g0[j]) * v0[j], __ATOMIC_RELAXED, __HIP_MEMORY_SCOPE_AGENT);
                __hip_atomic_fetch_add(mp + 4 + j, fsigmoid(g1[j]) * v1[j], __ATOMIC_RELAXED, __HIP_MEMORY_SCOPE_AGENT); }
        }
    } else {
        for (int s = G - 1 - wg; s < 32; s += G) {
            skinny_mm<true>((const float*)(ws + OFF_MS), 1024, (const bf16_t*)(ws + OFF_WOUT + l * SZ_WOUT) + (size_t)s * 32 * 1024, 1024, 1024, T, tid);
            skinny_read(T, tid, v0, v1);
            float s1 = 0.f, s2 = 0.f;
            epi_f(p, l, row, s * 32 + c8, v0, v1, s1, s2);
            s1 += __shfl_xor(s1, 1); s1 += __shfl_xor(s1, 2); s2 += __shfl_xor(s2, 1); s2 += __shfl_xor(s2, 2);
            if ((tid & 3) == 0) { float* st = (float*)(ws + OFF_STATS) + (((size_t)l * MROWS + row) * 32 + s) * 2; *(f32x2*)st = (f32x2){s1, s2}; }
        }
    }
    __syncthreads();
}

struct TJob { const float* src; int lds_, Ks; bf16_t* dst; int ldd, nN, nK, map; };
DI int tmap(int kind, int n) {
    if (kind == 0) return n;
    if (kind == 1) return n < 3744 ? n : (n < 3840 ? -1 : n - 96);
    if (kind == 2) { const int h = n / 96, d = n % 96; if (d < 64) return n; const int jj = (d - 64) >> 1, e = (d - 64) & 1; return h * 96 + 64 + jj + 16 * e; }
    if (kind == 3) { const int h = n >> 6, d = n & 63; return h * 128 + d; }
    const int h = n >> 6, d = n & 63; return h * 128 + 64 + d;
}
DI bool tjob(KP p, int j, TJob& t) {
    unsigned char* ws = p->ws;
    if (j < 18) { const int l = j / 9, k = j % 9;
        switch (k) {
        case 0: t = {p->in[9] + (size_t)l * 1024 * 7840, 7840, 1024, (bf16_t*)(ws + OFF_WIN + l * SZ_WIN), 1024, 124, 16, 1}; break;
        case 1: t = {p->in[22] + (size_t)l * 256 * 768, 768, 256, (bf16_t*)(ws + OFF_WUQ + l * SZ_WUQ), 256, 12, 4, 2}; break;
        case 2: t = {p->in[24] + (size_t)l * 128 * 1024, 1024, 128, (bf16_t*)(ws + OFF_WUK + l * SZ_WUK), 256, 8, 4, 3}; break;
        case 3: t = {p->in[24] + (size_t)l * 128 * 1024, 1024, 128, (bf16_t*)(ws + OFF_WUV + l * SZ_WUK), 256, 8, 4, 4}; break;
        case 4: t = {p->in[27] + (size_t)l * 1792 * 1024, 1024, 1792, (bf16_t*)(ws + OFF_WBR + l * SZ_WBR), 1792, 16, 28, 0}; break;
        case 5: t = {p->in[28] + (size_t)l * 1024 * 1024, 1024, 1024, (bf16_t*)(ws + OFF_WOUT + l * SZ_WOUT), 1024, 16, 16, 0}; break;
        case 6: t = {p->in[25] + (size_t)l * 1024 * 256, 256, 1024, (bf16_t*)(ws + OFF_MEMW + l * SZ_MEMW), 1024, 4, 16, 0}; break;
        case 7: t = {p->in[26] + (size_t)l * 1024 * 256, 256, 1024, (bf16_t*)(ws + OFF_MEMW + l * SZ_MEMW) + 256 * 1024, 1024, 4, 16, 0}; break;
        default: t = {p->in[6] + (size_t)l * 8 * 65536, 256, 256, (bf16_t*)(ws + OFF_MVTS) + (size_t)l * 8 * 65536, 256, 4, 4, 0}; break;
        }
        return true; }
    j -= 18;
    if (j < 14) { const int l = j / 7, b = j % 7 + 1; t = {p->in[6] + (size_t)(l * 8 + b) * 65536, 256, 256, (bf16_t*)(ws + OFF_MVTS) + (size_t)(l * 8 + b) * 65536, 256, 4, 4, 0}; return true; }
    j -= 14;
    if (j < 32) { const int l = j / 16, r = j % 16, hb = r >> 1, gi = r & 1;
        t = {p->in[gi ? 18 : 16] + (size_t)(l * 8 + hb) * 4096, 64, 64, (bf16_t*)(ws + OFF_WRI + l * SZ_WRI) + hb * 8192 + gi * 4096, 64, 1, 1, 0}; return true; }
    return false;
}

DI void prep_phase(KP p, LAS unsigned char* lds, int tid) {
    const int G = gridDim.x, wg = blockIdx.x;
    unsigned char* ws = p->ws;
    {
        bf16_t* XB = (bf16_t*)(ws + OFF_XB);
        const size_t nvec = (size_t)MROWS * 1024 / 8;
        for (size_t v = (size_t)wg * 512 + tid; v < nvec; v += (size_t)G * 512) {
            const size_t e = v * 8; const int row = (int)(e >> 10);
            u32x4 o = {0u, 0u, 0u, 0u};
            if (row < NROW) { const float* src = row < TP ? p->in[0] + e : p->in[1] + (e - (size_t)TP * 1024); o = pack8(*(const f32x4*)src, *(const f32x4*)(src + 4)); }
            *(u32x4*)(XB + e) = o;
        }
    }
    {
        bf16_t* MB = (bf16_t*)(ws + OFF_MEMB);
        for (size_t v = (size_t)wg * 512 + tid; v < (size_t)1024 * 1024 / 8; v += (size_t)G * 512) { const float* s = p->in[2] + v * 8; *(u32x4*)(MB + v * 8) = pack8(*(const f32x4*)s, *(const f32x4*)(s + 4)); }
        bf16_t* MKS = (bf16_t*)(ws + OFF_MKS);
        for (size_t v = (size_t)wg * 512 + tid; v < (size_t)2 * 2048 * 256 / 8; v += (size_t)G * 512) { const float* s = p->in[5] + v * 8; *(u32x4*)(MKS + v * 8) = pack8(*(const f32x4*)s, *(const f32x4*)(s + 4)); }
        bf16_t* GW = (bf16_t*)(ws + OFF_GWS);
        for (size_t v = (size_t)wg * 512 + tid; v < (size_t)2 * 4 * 128 * 128 / 8; v += (size_t)G * 512) {
            const size_t e = v * 8; const int q0 = (int)(e & 127), pr = (int)((e >> 7) & 127); const float* s = p->in[12] + e;
            f32x4 a = *(const f32x4*)s, b = *(const f32x4*)(s + 4);
#pragma unroll
            for (int j = 0; j < 4; ++j) { if (q0 + j > pr) a[j] = 0.f; if (q0 + 4 + j > pr) b[j] = 0.f; }
            *(u32x4*)(GW + e) = pack8(a, b); }
    }
    LAS float* tile = (LAS float*)lds;
    int base = 0;
    for (int j = 0;; ++j) {
        TJob t; if (!tjob(p, j, t)) break;
        const int ntile = t.nN * t.nK;
        int first = wg - (base % G); if (first < 0) first += G;
        for (int tt = first; tt < ntile; tt += G) {
            const int tn = tt / t.nK, tk = tt % t.nK, n0 = tn * 64, k0 = tk * 64;
            __syncthreads();
            for (int e = tid; e < 4096; e += 512) { const int kk = e >> 6, nn = e & 63; const int sc = tmap(t.map, n0 + nn); const int k = k0 + kk;
                tile[kk * 65 + nn] = (sc >= 0 && k < t.Ks) ? t.src[(size_t)k * t.lds_ + sc] : 0.f; }
            __syncthreads();
            for (int e = tid; e < 2048; e += 512) { const int nn = e >> 5, k2 = (e & 31) * 2;
                *(unsigned*)(t.dst + (size_t)(n0 + nn) * t.ldd + k0 + k2) = cvt_pk(tile[k2 * 65 + nn], tile[(k2 + 1) * 65 + nn]); }
        }
        base += ntile;
    }
    __syncthreads();
}

struct RawRow { u32x4 av; u32x2 cq; unsigned kv; unsigned short ka, kb; };
DI RawRow rows_load(const bf16_t* Z, int row, int lane) {
    const bf16_t* zr = Z + (size_t)row * ZW; RawRow r;
    r.av = *(const u32x4*)(zr + C_AV + lane * 8); r.cq = *(const u32x2*)(zr + C_CQ + lane * 4); r.kv = *(const unsigned*)(zr + C_CKV + lane * 2);
    r.ka = zr[C_CKR + (lane & 15)]; r.kb = zr[C_CKR + 16 + (lane & 15)]; return r;
}
DI void rows_phase(KP p, int l, int tid, bool dump = false) {
    const int G = gridDim.x, lane = tid & 63, gw = blockIdx.x * 8 + (tid >> 6), nw = G * 8;
    unsigned char* ws = p->ws; unsigned char* dob = (unsigned char*)p->out;
    bf16_t* Z = (bf16_t*)(ws + OFF_Z); bf16_t* CKV = (bf16_t*)(dob + DO_CKV); bf16_t* KR = (bf16_t*)(dob + DO_KR);
    {
        const f32x4 g0 = *(const f32x4*)(p->in[10] + l * 512 + lane * 8), g1 = *(const f32x4*)(p->in[10] + l * 512 + lane * 8 + 4);
        const f32x4 b0 = *(const f32x4*)(p->in[11] + l * 512 + lane * 8), b1 = *(const f32x4*)(p->in[11] + l * 512 + lane * 8 + 4);
        const f32x4 gq = *(const f32x4*)(p->in[21] + l * 256 + lane * 4);
        const f32x2 gk = *(const f32x2*)(p->in[23] + l * 128 + lane * 2);
        RawRow cur; if (gw < NROW) cur = rows_load(Z, gw, lane);
        for (int row = gw; row < NROW; row += nw) {
            RawRow nxt = cur; if (row + nw < NROW) nxt = rows_load(Z, row + nw, lane);
            const bool smp = row >= TP; const int srow = row - TP;
            bf16_t* zr = dump ? (bf16_t*)(ws + WS_NEED) : Z + (size_t)row * ZW;
            float x[8]; unpack8(cur.av, x);
            float xq[4] = {bflo(cur.cq.x), bfhi(cur.cq.x), bflo(cur.cq.y), bfhi(cur.cq.y)};
            const float k0 = bflo(cur.kv), k1 = bfhi(cur.kv);
            float s = 0.f;
#pragma unroll
            for (int j = 0; j < 8; ++j) s += x[j];
            float ssq = xq[0] * xq[0] + xq[1] * xq[1] + xq[2] * xq[2] + xq[3] * xq[3];
            float ssk = k0 * k0 + k1 * k1;
#pragma unroll
            for (int o = 32; o >= 1; o >>= 1) { s += __shfl_xor(s, o); ssq += __shfl_xor(ssq, o); ssk += __shfl_xor(ssk, o); }
            const float mean = s * (1.f / 512.f);
            float q = 0.f;
#pragma unroll
            for (int j = 0; j < 8; ++j) { x[j] -= mean; q += x[j] * x[j]; }
            const float rstd = rsqrtf(wave_sum(q) * (1.f / 512.f) + LN_EPS);
            {
                f32x4 y0, y1;
#pragma unroll
                for (int j = 0; j < 4; ++j) { y0[j] = x[j] * rstd * g0[j] + b0[j]; y1[j] = x[4 + j] * rstd * g1[j] + b1[j]; }
                *(u32x4*)(zr + C_AV + lane * 8) = pack8(y0, y1);
                if (smp && !dump) { float* o = p->out + O_SGV + (size_t)l * 65536 + (size_t)srow * 512 + lane * 8; *(f32x4*)o = y0; *(f32x4*)(o + 4) = y1; }
            }
            {
                const float r = rsqrtf(ssq * (1.f / 256.f) + LN_EPS);
                u32x2 o; o.x = cvt_pk(xq[0] * r * gq[0], xq[1] * r * gq[1]); o.y = cvt_pk(xq[2] * r * gq[2], xq[3] * r * gq[3]);
                *(u32x2*)(zr + C_CQ + lane * 4) = o;
            }
            const int kvrow = smp ? TP + (srow >> 4) * SKEYS + 1024 + (srow & 15) : row;
            if (dump) { CKV = (bf16_t*)(ws + WS_NEED) + 8192 - (size_t)kvrow * 256; KR = (bf16_t*)(ws + WS_NEED) + 16384 - (size_t)kvrow * 32; }
            {
                const float r = rsqrtf(ssk * (1.f / 128.f) + LN_EPS);
                const float y0 = k0 * r * gk[0], y1 = k1 * r * gk[1];
                float* o = smp ? p->out + O_SCKV + (size_t)l * 16384 + (size_t)srow * 128 + lane * 2 : p->out + O_PCKV + (size_t)l * 2097152 + (size_t)row * 128 + lane * 2;
                if (dump) o = (float*)(ws + WS_NEED) + 32768 + lane * 2;
                *(f32x2*)o = (f32x2){y0, y1};
                *(unsigned*)(CKV + (size_t)kvrow * 256 + lane * 2) = cvt_pk(y0, y1);
                *(unsigned*)(CKV + (size_t)kvrow * 256 + 128 + lane * 2) = 0u;
            }
            if (lane < 16) {
                float a = bf2f(cur.ka), b = bf2f(cur.kb);
                const float pos = smp ? (float)(1024 + (srow & 15)) : (float)(row & 4095);
                rope_pair(a, b, pos, lane);
                float* o = smp ? p->out + O_SKR + (size_t)l * 4096 + (size_t)srow * 32 : p->out + O_PKR + (size_t)l * 524288 + (size_t)row * 32;
                if (dump) o = (float*)(ws + WS_NEED) + 36864;
                o[lane] = a; o[lane + 16] = b;
                *(unsigned*)(KR + (size_t)kvrow * 32 + lane * 2) = cvt_pk(a, b);
            }
            cur = nxt;
        }
    }
    if (dump) return;
    for (int i0 = gw * 4; i0 < 8192; i0 += nw * 4) {
        f32x2 sv[4]; f32x2 rv[4];
#pragma unroll
        for (int k = 0; k < 4; ++k) { const int idx = i0 + k, b = idx >> 10, j = idx & 1023;
            sv[k] = *(const f32x2*)(p->in[3] + ((size_t)(l * 8 + b) * 1024 + j) * 128 + lane * 2);
            const float* r = p->in[4] + ((size_t)(l * 8 + b) * 1024 + j) * 32; rv[k] = (f32x2){r[lane & 15], r[(lane & 15) + 16]}; }
#pragma unroll
        for (int k = 0; k < 4; ++k) { const int idx = i0 + k, b = idx >> 10, j = idx & 1023; const int dst = TP + b * SKEYS + j;
            *(unsigned*)(CKV + (size_t)dst * 256 + lane * 2) = cvt_pk(sv[k][0], sv[k][1]);
            *(unsigned*)(CKV + (size_t)dst * 256 + 128 + lane * 2) = 0u;
            if (lane < 16) *(unsigned*)(KR + (size_t)dst * 32 + lane * 2) = cvt_pk(rv[k][0], rv[k][1]); }
    }
    for (int it = gw; it < 36 + 128 + 128; it += nw) {
        if (it < 36) {
            const int idx = it; int src; float* o;
            if (idx < 12) { const int b = idx / 3, k = idx % 3; src = b * 4096 + 4093 + k; o = p->out + O_PCONV + (size_t)l * 6144 + (size_t)(b * 3 + k) * 512; }
            else { const int i2 = idx - 12, b = i2 / 3, k = i2 % 3; src = TP + b * 16 + 13 + k; o = p->out + O_SCONV + (size_t)l * 12288 + (size_t)(b * 3 + k) * 512; }
            const u32x4 raw = *(const u32x4*)(Z + (size_t)src * ZW + C_BX + lane * 8); float x[8]; unpack8(raw, x);
            *(f32x4*)(o + lane * 8) = (f32x4){x[0], x[1], x[2], x[3]}; *(f32x4*)(o + lane * 8 + 4) = (f32x4){x[4], x[5], x[6], x[7]};
        } else if (it < 36 + 128) {
            const int dst = 24704 + (it - 36);
            *(u32x2*)(CKV + (size_t)dst * 256 + lane * 4) = (u32x2){0u, 0u};
        } else {
            float* ms = (float*)(ws + OFF_MS) + (size_t)(it - (36 + 128)) * 1024 + lane * 16;
#pragma unroll
            for (int j = 0; j < 4; ++j) *(f32x4*)(ms + 4 * j) = (f32x4){0.f, 0.f, 0.f, 0.f};
        }
    }
}

DI void ln_phase(KP p, int l, int tid) {
    const int G = gridDim.x, lane = tid & 63, gw = blockIdx.x * 8 + (tid >> 6), nw = G * 8;
    unsigned char* ws = p->ws;
    const float* st = (const float*)(ws + OFF_STATS) + (size_t)l * MROWS * 64;
    bf16_t* XB = (bf16_t*)(ws + OFF_XB);
    const float* g = p->in[29] + l * 1024; const float* b = p->in[30] + l * 1024;
    for (int row = gw; row < NROW; row += nw) {
        f32x2 part = {0.f, 0.f};
        if (lane < (row < TP ? 16 : 32)) part = *(const f32x2*)(st + (size_t)row * 64 + lane * 2);
        float ps1 = part[0], ps2 = part[1];
#pragma unroll
        for (int o = 16; o >= 1; o >>= 1) { ps1 += __shfl_xor(ps1, o); ps2 += __shfl_xor(ps2, o); }
        ps1 = __shfl(ps1, 0); ps2 = __shfl(ps2, 0);
        const float mean = ps1 * (1.f / 1024.f); const float var = ps2 * (1.f / 1024.f) - mean * mean;
        const float rstd = rsqrtf(fmaxf(var, 0.f) + LN_EPS);
        float* vr = p->out + (size_t)row * 1024;
#pragma unroll
        for (int c = 0; c < 2; ++c) {
            const int col = c * 512 + lane * 8;
            f32x4 a = *(const f32x4*)(vr + col), bq = *(const f32x4*)(vr + col + 4);
            const f32x4 g0 = *(const f32x4*)(g + col), g1 = *(const f32x4*)(g + col + 4), b0 = *(const f32x4*)(b + col), b1 = *(const f32x4*)(b + col + 4);
#pragma unroll
            for (int j = 0; j < 4; ++j) { a[j] = (a[j] - mean) * rstd * g0[j] + b0[j]; bq[j] = (bq[j] - mean) * rstd * g1[j] + b1[j]; }
            if (l == 0) *(u32x4*)(XB + (size_t)row * 1024 + col) = pack8(a, bq);
            else { *(f32x4*)(vr + col) = a; *(f32x4*)(vr + col + 4) = bq; }
        }
    }
}

DI void gmlp_tile(KP p, int l, int b, int n, int g, LAS unsigned char* lds, int tid, bool dump = false) {
    const int w = tid >> 6, lane = tid & 63, r = lane & 31, h = lane >> 5;
    bf16_t* Z = (bf16_t*)(p->ws + OFF_Z);
    const bf16_t* GW = (const bf16_t*)(p->ws + OFF_GWS) + (size_t)(l * 4 + g) * 16384;
    LAS bf16_t* Wl = (LAS bf16_t*)lds; LAS bf16_t* Vl = (LAS bf16_t*)(lds + 128 * 136 * 2);
    const int r0 = b * 4096 + n * 128;
    __syncthreads();
    for (int c = tid; c < 2048; c += 512) { const int rr = c >> 4, ch = c & 15;
        *(LAS u32x4*)(Wl + rr * 136 + ch * 8) = *(const u32x4*)(GW + rr * 128 + ch * 8);
        *(LAS u32x4*)(Vl + rr * 136 + ch * 8) = *(const u32x4*)(Z + (size_t)(r0 + rr) * ZW + C_AV + g * 128 + ch * 8); }
    __syncthreads();
    const int pb = w >> 1, cb0 = (w & 1) * 2;
    f32x16 acc0, acc1;
#pragma unroll
    for (int i = 0; i < 16; ++i) { acc0[i] = 0.f; acc1[i] = 0.f; }
    for (int s = 0; s < 2 * (pb + 1); ++s) {
        const bf16x8 a = *(const LAS bf16x8*)(Wl + (32 * pb + r) * 136 + 16 * s + 8 * h);
        bf16x8 b0, b1;
#pragma unroll
        for (int j = 0; j < 8; ++j) { b0[j] = (short)Vl[(16 * s + 8 * h + j) * 136 + 32 * cb0 + r]; b1[j] = (short)Vl[(16 * s + 8 * h + j) * 136 + 32 * (cb0 + 1) + r]; }
        acc0 = MFMA32(a, b0, acc0); acc1 = MFMA32(a, b1, acc1);
    }
    const float* bs = p->in[13] + (size_t)(l * 4 + g) * 128;
#pragma unroll
    for (int i = 0; i < 16; ++i) {
        const int pr = 32 * pb + crow(i, h); const float bias = bs[pr];
        bf16_t* zr = Z + (size_t)(r0 + pr) * ZW;
        bf16_t* zo = dump ? (bf16_t*)(p->ws + WS_NEED) : zr;
#pragma unroll
        for (int cb = 0; cb < 2; ++cb) {
            const int c = g * 128 + 32 * (cb0 + cb) + r;
            const float s = (cb ? acc1[i] : acc0[i]) + bias;
            zo[C_AU + c] = f2bf(bf2f(zr[C_AU + c]) * s * bf2f(zr[C_AG + c]));
        }
    }
}
DI void gmlp_sample(KP p, int l, int b, int g, int tid) {
    const int c = tid & 127, p0 = (tid >> 7) * 4;
    bf16_t* Z = (bf16_t*)(p->ws + OFF_Z);
    const float* wsrc = p->in[12] + (size_t)(l * 4 + g) * 16384; const float* bs = p->in[13] + (size_t)(l * 4 + g) * 128;
    const int r0 = TP + b * 16;
    float v[16];
#pragma unroll
    for (int q = 0; q < 16; ++q) v[q] = bf2f(Z[(size_t)(r0 + q) * ZW + C_AV + g * 128 + c]);
#pragma unroll
    for (int k = 0; k < 4; ++k) { const int pr = p0 + k; float s = bs[pr];
#pragma unroll
        for (int q = 0; q < 16; ++q) if (q <= pr) s += wsrc[pr * 128 + q] * v[q];
        bf16_t* zr = Z + (size_t)(r0 + pr) * ZW; const int cc = g * 128 + c;
        zr[C_AU + cc] = f2bf(bf2f(zr[C_AU + cc]) * s * bf2f(zr[C_AG + cc])); }
}

DI void lru_tile(KP p, int l, int bg, int hb, int seg, bool apply, LAS unsigned char* lds, int tid, bool dump = false) {
    const int w = tid >> 6, lane = tid & 63, r = lane & 31, h = lane >> 5;
    bf16_t* Z = (bf16_t*)(p->ws + OFF_Z);
    const bool smp = bg >= 4; const int sb = bg - 4;
    const int row0 = smp ? TP + sb * 16 : bg * 4096 + seg * 128; const int ntok = smp ? 16 : 128;
    LAS float* XC = (LAS float*)lds; LAS bf16_t* XCB = (LAS bf16_t*)(lds + 32768); LAS float* GATE = (LAS float*)(lds + 51200); LAS float* AGL = (LAS float*)(lds + 116736);
    const int c = tid & 63, sub = tid >> 6, ch = hb * 64 + c;
    __syncthreads();
    {
        const float cb = p->in[15][l * 512 + ch];
        float cw[4];
#pragma unroll
        for (int k = 0; k < 4; ++k) cw[k] = p->in[14][(size_t)(l * 4 + k) * 512 + ch];
        for (int t = sub; t < 128; t += 8) {
            float a = 0.f;
            if (t < ntok) { a = cb;
#pragma unroll
                for (int k = 0; k < 4; ++k) { const int tt = t + k - 3; float x;
                    if (!smp) { const int gt = seg * 128 + tt; x = gt >= 0 ? bf2f(Z[(size_t)(bg * 4096 + gt) * ZW + C_BX + ch]) : 0.f; }
                    else x = tt >= 0 ? bf2f(Z[(size_t)(row0 + tt) * ZW + C_BX + ch]) : p->in[8][((size_t)(l * 8 + sb) * 3 + (tt + 3)) * 512 + ch];
                    a += x * cw[k]; } }
            XC[t * 64 + c] = a; XCB[t * 72 + c] = f2bf(a);
        }
    }
    __syncthreads();
    {
        const int tb = w >> 1, nb0 = (w & 1) * 2;
        const bf16_t* WT = (const bf16_t*)(p->ws + OFF_WRI + l * SZ_WRI) + hb * 8192;
        f32x16 a0, a1;
#pragma unroll
        for (int i = 0; i < 16; ++i) { a0[i] = 0.f; a1[i] = 0.f; }
#pragma unroll
        for (int s = 0; s < 4; ++s) {
            const bf16x8 a = *(const LAS bf16x8*)(XCB + (32 * tb + r) * 72 + 16 * s + 8 * h);
            const bf16x8 b0 = *(const bf16x8*)(WT + (32 * nb0 + r) * 64 + 16 * s + 8 * h), b1 = *(const bf16x8*)(WT + (32 * (nb0 + 1) + r) * 64 + 16 * s + 8 * h);
            a0 = MFMA32(a, b0, a0); a1 = MFMA32(a, b1, a1);
        }
        const int n0 = 32 * nb0 + r, n1 = n0 + 32;
        const float bias0 = n0 < 64 ? p->in[17][l * 512 + hb * 64 + n0] : p->in[19][l * 512 + hb * 64 + n0 - 64];
        const float bias1 = n1 < 64 ? p->in[17][l * 512 + hb * 64 + n1] : p->in[19][l * 512 + hb * 64 + n1 - 64];
#pragma unroll
        for (int i = 0; i < 16; ++i) { const int t = 32 * tb + crow(i, h); GATE[t * 128 + n0] = fsigmoid(a0[i] + bias0); GATE[t * 128 + n1] = fsigmoid(a1[i] + bias1); }
    }
    __syncthreads();
    float av[16], bv[16];
    {
        const float lam = p->in[20][l * 512 + ch];
        const float sp = log1pf(__expf(-lam));
        float P = 1.f, S = 0.f;
#pragma unroll
        for (int k = 0; k < 16; ++k) { const int t = sub * 16 + k;
            float a = 1.f, bb = 0.f;
            if (t < ntok) { const float rg = GATE[t * 128 + c], ig = GATE[t * 128 + 64 + c], x = XC[t * 64 + c];
                const float la = -8.f * rg * sp; a = __expf(la); bb = sqrtf(fmaxf(-expm1f(2.f * la), 0.f)) * (ig * x); }
            av[k] = a; bv[k] = bb; S = a * S + bb; P *= a; }
        AGL[sub * 64 + c] = P; AGL[512 + sub * 64 + c] = S;
    }
    __syncthreads();
    float* AGG = (float*)(p->ws + OFF_AGG);
    if (!apply) {
        if (sub == 0 && !smp) { float A = 1.f, B = 0.f;
#pragma unroll
            for (int s2 = 0; s2 < 8; ++s2) { const float P = AGL[s2 * 64 + c], S = AGL[512 + s2 * 64 + c]; B = P * B + S; A *= P; }
            float* o = AGG + (size_t)((bg * 8 + hb) * 32 + seg) * 128; o[c] = A; o[64 + c] = B; }
    } else {
        float hcar;
        if (smp) hcar = p->in[7][(size_t)(l * 8 + sb) * 512 + ch];
        else { hcar = 0.f; for (int s2 = 0; s2 < seg; ++s2) { const float* o = AGG + (size_t)((bg * 8 + hb) * 32 + s2) * 128; hcar = o[c] * hcar + o[64 + c]; } }
        for (int s2 = 0; s2 < sub; ++s2) hcar = AGL[s2 * 64 + c] * hcar + AGL[512 + s2 * 64 + c];
#pragma unroll
        for (int k = 0; k < 16; ++k) { const int t = sub * 16 + k;
            hcar = av[k] * hcar + bv[k];
            if (t < ntok) { bf16_t* zp = Z + (size_t)(row0 + t) * ZW + C_BG + ch; bf16_t* zo = dump ? (bf16_t*)(p->ws + WS_NEED) + ch : zp; *zo = f2bf(hcar * bf2f(*zp));
                if (!dump) { if (smp) { if (t == 15) p->out[O_SH + (size_t)(l * 8 + sb) * 512 + ch] = hcar; }
                else if (seg == 31 && t == 127) p->out[O_PH + (size_t)(l * 4 + bg) * 512 + ch] = hcar; } } }
    }
}

struct AttnItem {
    const bf16_t* Q; int ldq, qcol, qrow0, nq;
    const bf16_t* Kn; int ldkn, kncol; const bf16_t* Kr; int krow0;
    const bf16_t* VT; int ldvt, vtrow0, vcol0;
    int nkeys, ntmax, tbase, causal;
    float scale;
    bf16_t* O; int ldo, ocol, gate;
};
template <bool ROPE>
DI void attn_item(const AttnItem& it, LAS unsigned char* lds, int tid) {
    constexpr int NK = ROPE ? 6 : 4;
    const int w = tid >> 6, lane = tid & 63, r = lane & 31, h = lane >> 5;
    LAS bf16_t* Kl = (LAS bf16_t*)lds; LAS bf16_t* VTl = (LAS bf16_t*)(lds + 64 * 104 * 2);
    const int qi = 32 * w + r; const bool qvalid = qi < it.nq; const int qrow = it.qrow0 + (qvalid ? qi : 0);
    const int mytiles = (32 * w >= it.nq) ? 0 : (it.causal ? it.tbase + (w >> 1) + 1 : it.ntmax);
    bf16x8 qf[NK];
#pragma unroll
    for (int ks = 0; ks < NK; ++ks) qf[ks] = *(const bf16x8*)(it.Q + (size_t)qrow * it.ldq + it.qcol + 16 * ks + 8 * h);
    f32x16 o0, o1;
#pragma unroll
    for (int i = 0; i < 16; ++i) { o0[i] = 0.f; o1[i] = 0.f; }
    float mrun = -1e30f, lsum = 0.f;
    const float sc = it.scale;
    const int lk = tid >> 3, lc = tid & 7, rk = tid >> 2, rc = tid & 3;
    u32x4 kreg, rreg = {0u, 0u, 0u, 0u}, vreg;
    kreg = *(const u32x4*)(it.Kn + (size_t)(it.krow0 + lk) * it.ldkn + it.kncol + lc * 8);
    if (ROPE && tid < 256) rreg = *(const u32x4*)(it.Kr + (size_t)(it.krow0 + rk) * 32 + rc * 8);
    vreg = *(const u32x4*)(it.VT + (size_t)(it.vtrow0 + lk) * it.ldvt + it.vcol0 + lc * 8);
    for (int kt = 0; kt < it.ntmax; ++kt) {
        __syncthreads();
        *(LAS u32x4*)(Kl + lk * 104 + lc * 8) = kreg;
        if (ROPE && tid < 256) *(LAS u32x4*)(Kl + rk * 104 + 64 + rc * 8) = rreg;
        *(LAS u32x4*)(VTl + lk * 72 + lc * 8) = vreg;
        __syncthreads();
        if (kt + 1 < it.ntmax) {
            const int k0 = (kt + 1) * 64;
            kreg = *(const u32x4*)(it.Kn + (size_t)(it.krow0 + k0 + lk) * it.ldkn + it.kncol + lc * 8);
            if (ROPE && tid < 256) rreg = *(const u32x4*)(it.Kr + (size_t)(it.krow0 + k0 + rk) * 32 + rc * 8);
            vreg = *(const u32x4*)(it.VT + (size_t)(it.vtrow0 + lk) * it.ldvt + it.vcol0 + k0 + lc * 8);
        }
        if (kt < mytiles) {
            f32x16 s0, s1;
#pragma unroll
            for (int i = 0; i < 16; ++i) { s0[i] = 0.f; s1[i] = 0.f; }
#pragma unroll
            for (int ks = 0; ks < NK; ++ks) {
                const bf16x8 ka0 = *(const LAS bf16x8*)(Kl + r * 104 + 16 * ks + 8 * h), ka1 = *(const LAS bf16x8*)(Kl + (32 + r) * 104 + 16 * ks + 8 * h);
                s0 = MFMA32(ka0, qf[ks], s0); s1 = MFMA32(ka1, qf[ks], s1);
            }
            if ((kt + 1) * 64 > it.nkeys) {
#pragma unroll
                for (int i = 0; i < 16; ++i) { const int key = kt * 64 + crow(i, h); if (key >= it.nkeys) s0[i] = -1e30f; if (key + 32 >= it.nkeys) s1[i] = -1e30f; }
            }
            float mx = s0[0];
#pragma unroll
            for (int i = 1; i < 16; ++i) mx = fmaxf(mx, s0[i]);
#pragma unroll
            for (int i = 0; i < 16; ++i) mx = fmaxf(mx, s1[i]);
            mx = fmaxf(mx, __shfl_xor(mx, 32));
            const float mnew = fmaxf(mrun, mx);
            const float alpha = __builtin_amdgcn_exp2f((mrun - mnew) * sc);
            mrun = mnew;
            const float mc = mnew * sc;
            float ps = 0.f;
#pragma unroll
            for (int i = 0; i < 16; ++i) { s0[i] = __builtin_amdgcn_exp2f(s0[i] * sc - mc); s1[i] = __builtin_amdgcn_exp2f(s1[i] * sc - mc); ps += s0[i] + s1[i]; }
            lsum = lsum * alpha + ps;
#pragma unroll
            for (int i = 0; i < 16; ++i) { o0[i] *= alpha; o1[i] *= alpha; }
#pragma unroll
            for (int kk = 0; kk < 4; ++kk) {
                const int s8 = (kk & 1) * 8;
                u32x4 pw;
                if (kk < 2) { pw.x = cvt_pk(s0[s8], s0[s8 + 1]); pw.y = cvt_pk(s0[s8 + 2], s0[s8 + 3]); pw.z = cvt_pk(s0[s8 + 4], s0[s8 + 5]); pw.w = cvt_pk(s0[s8 + 6], s0[s8 + 7]); }
                else { pw.x = cvt_pk(s1[s8], s1[s8 + 1]); pw.y = cvt_pk(s1[s8 + 2], s1[s8 + 3]); pw.z = cvt_pk(s1[s8 + 4], s1[s8 + 5]); pw.w = cvt_pk(s1[s8 + 6], s1[s8 + 7]); }
                const bf16x8 pf = __builtin_bit_cast(bf16x8, pw);
                const s16x4 a0l = *(const LAS s16x4*)(VTl + r * 72 + 16 * kk + 4 * h), a0h = *(const LAS s16x4*)(VTl + r * 72 + 16 * kk + 8 + 4 * h);
                const s16x4 a1l = *(const LAS s16x4*)(VTl + (32 + r) * 72 + 16 * kk + 4 * h), a1h = *(const LAS s16x4*)(VTl + (32 + r) * 72 + 16 * kk + 8 + 4 * h);
                const bf16x8 va0 = __builtin_shufflevector(a0l, a0h, 0, 1, 2, 3, 4, 5, 6, 7), va1 = __builtin_shufflevector(a1l, a1h, 0, 1, 2, 3, 4, 5, 6, 7);
                o0 = MFMA32(va0, pf, o0); o1 = MFMA32(va1, pf, o1);
            }
        }
    }
    const float ltot = lsum + __shfl_xor(lsum, 32);
    if (qvalid && mytiles > 0) {
        const float inv = 1.f / ltot;
        bf16_t* orow = it.O + (size_t)qrow * it.ldo + it.ocol;
#pragma unroll
        for (int db = 0; db < 2; ++db)
#pragma unroll
            for (int g4 = 0; g4 < 4; ++g4) {
                const int dv0 = 32 * db + 8 * g4 + 4 * h;
                float v[4];
#pragma unroll
                for (int j = 0; j < 4; ++j) v[j] = (db ? o1[4 * g4 + j] : o0[4 * g4 + j]) * inv;
                u32x2* dst = (u32x2*)(orow + dv0);
                if (it.gate) { const u32x2 gw = *dst; v[0] *= bflo(gw.x); v[1] *= bfhi(gw.x); v[2] *= bflo(gw.y); v[3] *= bfhi(gw.y); }
                u32x2 ow; ow.x = cvt_pk(v[0], v[1]); ow.y = cvt_pk(v[2], v[3]);
                *dst = ow;
            }
    }
}

#define XB_TMO      128
#define XB_XCNT(j)  (256  + 64 * (j))
#define XB_XSUB(j)  (1280 + 64 * (j))
#define XB_XGEN(j)  (2304 + 64 * (j))
#define XB_TOP      3328
#define XB_TOPGEN   3392
#define XCD_BAR_WORDS 3456
#define XB_SPIN_CAP (1u << 18)
DI unsigned xb_ld(unsigned* p)              { return __hip_atomic_load(p, __ATOMIC_RELAXED, __HIP_MEMORY_SCOPE_AGENT); }
DI unsigned xb_add(unsigned* p, unsigned v) { return __hip_atomic_fetch_add(p, v, __ATOMIC_RELAXED, __HIP_MEMORY_SCOPE_AGENT); }
DI unsigned xb_xcc_id() { return (unsigned)__builtin_amdgcn_s_getreg((3 << 11) | 20) & 0xFu; }
#define XB_SPIN(cond, bar) do { unsigned _sp = 0; while (cond) { __builtin_amdgcn_s_sleep(1); \
    if ((++_sp & 255u) == 0u) { if (xb_ld(&(bar)[XB_TMO])) break; if (_sp > XB_SPIN_CAP) { atomicAdd(&(bar)[XB_TMO], 1u); break; } } } } while (0)
struct XcdBarrier { unsigned* bar; unsigned x; volatile LAS unsigned* st; };
DI XcdBarrier xcd_barrier_post(unsigned* bar, volatile LAS unsigned* st) {
    XcdBarrier b; b.bar = bar; b.x = xb_xcc_id(); b.st = st;
    if (threadIdx.x == 0) (void)xb_add(&bar[XB_XCNT(b.x)], 1u);
    return b;
}
DI void xcd_barrier_complete(unsigned* bar, unsigned x, unsigned& nloc, unsigned& nx) {
    const unsigned G = gridDim.x * gridDim.y * gridDim.z;
    unsigned sum, cnt, mine, sp = 0u;
    for (;;) {
        sum = 0u; cnt = 0u; mine = 0u;
#pragma unroll
        for (unsigned j = 0; j < 16; ++j) { const unsigned c = xb_ld(&bar[XB_XCNT(j)]); sum += c; cnt += (c > 0u) ? 1u : 0u; mine = (j == x) ? c : mine; }
        if (sum == G) break;
        __builtin_amdgcn_s_sleep(1);
        if ((++sp & 255u) == 0u) { if (xb_ld(&bar[XB_TMO])) break; if (sp > XB_SPIN_CAP) { atomicAdd(&bar[XB_TMO], 1u); break; } }
    }
    nloc = mine > 0u ? mine : 1u; nx = cnt > 0u ? cnt : 1u;
}
DI void xcd_barrier(const XcdBarrier& b) {
    asm volatile("s_waitcnt vmcnt(0)" ::: "memory");
    __syncthreads();
    if (threadIdx.x == 0) {
        unsigned* bar = b.bar;
        __builtin_amdgcn_s_waitcnt(0);
        unsigned nloc = b.st[0], nx = b.st[1];
        if (nloc == 0u) { xcd_barrier_complete(bar, b.x, nloc, nx); b.st[0] = nloc; b.st[1] = nx; }
        const unsigned old = xb_add(&bar[XB_XSUB(b.x)], 1u);
        const unsigned gen = old / nloc;
        if (old + 1u == (gen + 1u) * nloc) {
            __builtin_amdgcn_fence(__ATOMIC_RELEASE, "agent");
            asm volatile("s_waitcnt vmcnt(0)" ::: "memory");
            const unsigned og = xb_add(&bar[XB_TOP], 1u);
            const unsigned tg = og / nx;
            if (og + 1u == (tg + 1u) * nx) xb_add(&bar[XB_TOPGEN], 1u);
            else XB_SPIN(xb_ld(&bar[XB_TOPGEN]) == tg, bar);
            __builtin_amdgcn_fence(__ATOMIC_ACQUIRE, "agent");
            xb_add(&bar[XB_XGEN(b.x)], 1u);
            asm volatile("s_waitcnt vmcnt(0)" ::: "memory");
        } else {
            XB_SPIN(xb_ld(&bar[XB_XGEN(b.x)]) == gen, bar);
            __builtin_amdgcn_fence(__ATOMIC_ACQUIRE, "agent");
            asm volatile("s_waitcnt vmcnt(0)" ::: "memory");
        }
    }
    __syncthreads();
}

__global__ void __launch_bounds__(512, 2) mega(Params pk) {
    extern __shared__ __attribute__((aligned(16))) unsigned char shm[];
    LAS unsigned char* lds = (LAS unsigned char*)shm;
    cg::grid_group grid = cg::this_grid();
    __shared__ uint4 xb_words;
    if (threadIdx.x == 0) xb_words = make_uint4(0u, 0u, 0u, 0u);
    __syncthreads();
    XcdBarrier xb = xcd_barrier_post((unsigned*)(((KP)__builtin_amdgcn_kernarg_segment_ptr())->ws + OFF_BAR), (volatile LAS unsigned*)&xb_words);
    { KP p = (KP)__builtin_amdgcn_kernarg_segment_ptr(); int tid0 = threadIdx.x; asm volatile("" : "+v"(tid0)); prep_phase(p, lds, tid0); if (PROBE & 64) { grid.sync(); prep_phase(p, lds, tid0); } }
    grid.sync();
    if (PROBE & 256) { for (int k = 0; k < 20; ++k) xcd_barrier(xb); }
    for (int step = 0; step < 14; ++step) {
        const int l = step / 7, ph = step % 7;
        KP p = (KP)__builtin_amdgcn_kernarg_segment_ptr(); asm volatile("" : "+s"(p));
        int tid = threadIdx.x; asm volatile("" : "+v"(tid));
        int wg = blockIdx.x, G = gridDim.x; asm volatile("" : "+s"(wg), "+s"(G));
        unsigned char* ws = p->ws; unsigned char* dob = (unsigned char*)p->out;
        const int gph = ph == 0 ? 0 : ph == 2 ? 1 : ph == 4 ? 2 : ph == 5 ? 3 : -1;
        if (gph >= 0) {
            const int ndup = ((PROBE & 1) && gph == 0) || ((PROBE & 2) && gph == 1) || ((PROBE & 4) && gph == 2) || ((PROBE & 128) && gph == 3) ? 2 : 1;
#pragma unroll 1
            for (int rep = 0; rep < ndup; ++rep) { gemm_stream(p, gph, l, lds, tid, wg, G, rep + 1 < ndup); if (rep + 1 < ndup) xcd_barrier(xb); }
            sample_gemm_phase(p, gph, l, lds, tid, wg, G);
        }
        if (ph == 1) { if (PROBE & 512) { rows_phase(p, l, tid, true); xcd_barrier(xb); } rows_phase(p, l, tid); }
        else if (ph == 2) {
            __syncthreads();
            for (int t = wg; t < 512 + 32; t += G) {
                if (t < 512) { if (PROBE & 32) gmlp_tile(p, l, t >> 7, (t >> 2) & 31, t & 3, lds, tid, true); gmlp_tile(p, l, t >> 7, (t >> 2) & 31, t & 3, lds, tid); }
                else { const int s = t - 512; gmlp_sample(p, l, s >> 2, s & 3, tid); }
            }
            for (int t = wg; t < 256 + 32; t += G) {
                AttnItem it;
                it.Q = (const bf16_t*)(ws + OFF_Z); it.ldq = ZW; it.Kr = nullptr; it.scale = 0.125f * 1.44269504089f;
                it.O = (bf16_t*)(ws + OFF_Z); it.ldo = ZW; it.gate = 0; it.nkeys = 256; it.ntmax = 4; it.tbase = 0; it.causal = 0; it.krow0 = 0; it.vcol0 = 0;
                if (t < 256) { const int b = t >> 6, hh = (t >> 4) & 3, qb = t & 15;
                    it.qcol = C_MQ + hh * 64; it.qrow0 = b * 4096 + qb * 256; it.nq = 256;
                    it.Kn = (const bf16_t*)(ws + OFF_MK) + (size_t)b * 256 * 256; it.ldkn = 256; it.kncol = hh * 64;
                    it.VT = (const bf16_t*)(ws + OFF_MVT); it.ldvt = 1024; it.vtrow0 = hh * 64; it.vcol0 = b * 256; }
                else { const int s = t - 256, b = s >> 2, hh = s & 3;
                    it.qcol = C_MQ + hh * 64; it.qrow0 = TP + b * 16; it.nq = 16;
                    it.Kn = (const bf16_t*)(ws + OFF_MKS) + (size_t)(l * 8 + b) * 65536; it.ldkn = 256; it.kncol = hh * 64;
                    it.VT = (const bf16_t*)(ws + OFF_MVTS) + (size_t)(l * 8 + b) * 65536; it.ldvt = 256; it.vtrow0 = hh * 64; }
                it.ocol = it.qcol;
                if (PROBE & 32) { AttnItem d = it; d.O = (bf16_t*)(ws + WS_NEED); d.ldo = 64; d.ocol = 0; attn_item<false>(d, lds, tid); }
                attn_item<false>(it, lds, tid);
            }
            for (int t = wg; t < 1024; t += G) { if (PROBE & 8) lru_tile(p, l, t >> 8, (t >> 5) & 7, t & 31, false, lds, tid); lru_tile(p, l, t >> 8, (t >> 5) & 7, t & 31, false, lds, tid); }
        } else if (ph == 3) {
            for (int t = wg; t < 256 + 64; t += G) {
                AttnItem it;
                it.Q = (const bf16_t*)(dob + DO_Q); it.ldq = 768; it.Kn = (const bf16_t*)(dob + DO_KN); it.ldkn = 512; it.Kr = (const bf16_t*)(dob + DO_KR);
                it.VT = (const bf16_t*)(ws + OFF_VT); it.ldvt = KVROWS; it.scale = 0.10206207262f * 1.44269504089f;
                it.O = (bf16_t*)(ws + OFF_Z); it.ldo = ZW; it.gate = 1;
                if (t < 256) { const int b = t >> 6, hh = (t >> 3) & 7, x = t & 7;
                    it.qcol = hh * 96; it.kncol = hh * 64; it.krow0 = b * 4096; it.vtrow0 = hh * 64; it.vcol0 = b * 4096; it.ocol = C_CG + hh * 64; it.nq = 256; it.nkeys = 4096; it.causal = 1;
#pragma unroll 1
                    for (int half = 0; half < 2; ++half) { const int qb = half ? 15 - x : x;
                        it.qrow0 = b * 4096 + qb * 256; it.tbase = 4 * qb; it.ntmax = 4 * qb + 4;
                        if (PROBE & 16) { AttnItem d = it; d.O = (bf16_t*)(ws + WS_NEED); d.ldo = 64; d.ocol = 0; d.gate = 0; attn_item<true>(d, lds, tid); }
                        attn_item<true>(it, lds, tid); } }
                else { const int s = t - 256, b = s >> 3, hh = s & 7;
                    it.qcol = hh * 96; it.kncol = hh * 64; it.krow0 = TP + b * SKEYS; it.vtrow0 = hh * 64; it.vcol0 = TP + b * SKEYS; it.ocol = C_CG + hh * 64;
                    it.qrow0 = TP + b * 16; it.nq = 16; it.nkeys = SKEYS; it.causal = 0; it.tbase = 0; it.ntmax = 17;
                    if (PROBE & 16) { AttnItem d = it; d.O = (bf16_t*)(ws + WS_NEED); d.ldo = 64; d.ocol = 0; d.gate = 0; attn_item<true>(d, lds, tid); }
                    attn_item<true>(it, lds, tid); }
            }
            for (int t = wg; t < 1024 + 64; t += G) {
                if (t < 1024) { if (PROBE & 8) lru_tile(p, l, t >> 8, (t >> 5) & 7, t & 31, true, lds, tid, true); lru_tile(p, l, t >> 8, (t >> 5) & 7, t & 31, true, lds, tid); }
                else { const int s = t - 1024; lru_tile(p, l, 4 + (s >> 3), s & 7, 0, true, lds, tid); }
            }
        } else if (ph == 6) { if ((PROBE & 1024) && l == 0) { ln_phase(p, l, tid); xcd_barrier(xb); } ln_phase(p, l, tid); }
        if (step < 13) xcd_barrier(xb);
    }
}

extern "C" void kernel_launch(void* const* d_in, const int* in_sizes, int n_in, void* d_out, int out_size, void* d_ws, size_t ws_size, hipStream_t stream) {
    constexpr size_t kDynLds = 131072;
    static int grid_blocks = 0;
    if (!grid_blocks) {
        int dev = 0, cus = 0, per_cu = 0;
        (void)hipGetDevice(&dev);
        (void)hipDeviceGetAttribute(&cus, hipDeviceAttributeMultiprocessorCount, dev);
        (void)hipFuncSetAttribute((const void*)mega, hipFuncAttributeMaxDynamicSharedMemorySize, (int)kDynLds);
        (void)hipOccupancyMaxActiveBlocksPerMultiprocessor(&per_cu, mega, 512, kDynLds);
        if (per_cu > 1) per_cu = 1;
        grid_blocks = cus * per_cu;
        if (grid_blocks > 256) grid_blocks = 256;
    }
    if (ws_size < WS_NEED) { fprintf(stderr, "workspace too small: %zu < %zu\n", ws_size, (size_t)WS_NEED); return; }
    Params p{};
    for (int i = 0; i < 31; ++i) p.in[i] = (const float*)d_in[i];
    p.out = (float*)d_out; p.ws = (unsigned char*)d_ws;
    (void)hipMemsetAsync((unsigned char*)d_ws + OFF_BAR, 0, 16384, stream);
    void* args[] = {&p};
    hipError_t e = hipLaunchCooperativeKernel((void*)mega, dim3(grid_blocks), dim3(512), args, kDynLds, stream);
    if (e != hipSuccess) fprintf(stderr, "cooperative launch failed: %s (grid %d)\n", hipGetErrorString(e), grid_blocks);
}
```

```cpp
#include <hip/hip_runtime.h>
#include <hip/hip_cooperative_groups.h>
#include <cstdio>
namespace cg = cooperative_groups;

#define LAS __attribute__((address_space(3)))
#define DI __device__ __forceinline__
typedef unsigned short bf16_t;
typedef short bf16x8 __attribute__((ext_vector_type(8)));
typedef short s16x4 __attribute__((ext_vector_type(4)));
typedef float f32x2 __attribute__((ext_vector_type(2)));
typedef float f32x4 __attribute__((ext_vector_type(4)));
typedef float f32x16 __attribute__((ext_vector_type(16)));
typedef unsigned u32x2 __attribute__((ext_vector_type(2)));
typedef unsigned u32x4 __attribute__((ext_vector_type(4)));
typedef __bf16 bf16v2 __attribute__((ext_vector_type(2)));

#ifndef PROBE
#define PROBE 0
#endif
constexpr int TP = 16384, NROW = 16512, MROWS = 16640;
constexpr int ZW = 3840;
constexpr int C_AU = 0, C_AV = 512, C_AG = 1024, C_BX = 1536, C_BG = 2048, C_CQ = 2560, C_CKV = 2816, C_CKR = 2944, C_CG = 2976, C_MQ = 3488;
constexpr int KVROWS = 24832, SKEYS = 1040;
constexpr float LN_EPS = 1e-6f;
constexpr float ALPHA_RES = 1.41421356237f;

constexpr size_t SZ_WIN = (size_t)7936 * 1024 * 2, SZ_WUQ = 768 * 256 * 2, SZ_WUK = 512 * 256 * 2, SZ_WBR = (size_t)1024 * 1792 * 2, SZ_WOUT = 1024 * 1024 * 2,
                 SZ_MEMW = 512 * 1024 * 2, SZ_WRI = 8 * 128 * 64 * 2, SZ_GWS = 4 * 128 * 128 * 2;
constexpr size_t OFF_WIN = 0;
constexpr size_t OFF_WUQ = OFF_WIN + 2 * SZ_WIN;
constexpr size_t OFF_WUK = OFF_WUQ + 2 * SZ_WUQ;
constexpr size_t OFF_WUV = OFF_WUK + 2 * SZ_WUK;
constexpr size_t OFF_WBR = OFF_WUV + 2 * SZ_WUK;
constexpr size_t OFF_WOUT = OFF_WBR + 2 * SZ_WBR;
constexpr size_t OFF_MEMW = OFF_WOUT + 2 * SZ_WOUT;
constexpr size_t OFF_WRI = OFF_MEMW + 2 * SZ_MEMW;
constexpr size_t OFF_GWS = OFF_WRI + 2 * SZ_WRI;
constexpr size_t OFF_XB = OFF_GWS + 2 * SZ_GWS;
constexpr size_t OFF_MEMB = OFF_XB + (size_t)MROWS * 1024 * 2;
constexpr size_t OFF_MK = OFF_MEMB + (size_t)1024 * 1024 * 2;
constexpr size_t OFF_MVT = OFF_MK + 1024 * 256 * 2;
constexpr size_t OFF_MKS = OFF_MVT + 256 * 1024 * 2;
constexpr size_t OFF_MVTS = OFF_MKS + (size_t)2 * 2048 * 256 * 2;
constexpr size_t OFF_Z = OFF_MVTS + (size_t)2 * 2048 * 256 * 2;
constexpr size_t OFF_VT = OFF_Z + (size_t)MROWS * ZW * 2;
constexpr size_t OFF_MERGED = OFF_VT;
constexpr size_t OFF_STATS = OFF_VT + (size_t)MROWS * 1024 * 2;
constexpr size_t OFF_AGG = OFF_STATS + (size_t)2 * MROWS * 64 * 4;
constexpr size_t OFF_BAR = OFF_AGG + (size_t)1024 * 128 * 4;
constexpr size_t OFF_MS = OFF_BAR + 16384;
constexpr size_t WS_NEED = OFF_MS + (size_t)128 * 1024 * 4;
static_assert(WS_NEED <= (size_t)256 * 1024 * 1024, "workspace over 256 MiB");
constexpr size_t DO_Q = 0;
constexpr size_t DO_CKV = DO_Q + (size_t)MROWS * 768 * 2;
constexpr size_t DO_KR = DO_CKV + (size_t)KVROWS * 256 * 2;
constexpr size_t DO_KN = DO_KR + (size_t)KVROWS * 32 * 2;
constexpr size_t DO_END = DO_KN + (size_t)KVROWS * 512 * 2;
constexpr size_t DO_GSCR = 0;
static_assert(DO_END <= (size_t)NROW * 4096, "scratch in d_out too large");
static_assert((size_t)256 * 4 * 16 * 512 * 8 <= (size_t)NROW * 4096, "gscr too large");
constexpr size_t O_YS = 16777216, O_PCKV = 16908288, O_PKR = 21102592, O_PMK = 22151168, O_PMV = 22675456, O_PH = 23199744, O_PCONV = 23203840,
                 O_SCKV = 23216128, O_SKR = 23248896, O_SH = 23257088, O_SCONV = 23265280, O_SGV = 23289856;

struct Params {
    const float* in[31];
    float* out;
    unsigned char* ws;
};
typedef const __attribute__((address_space(4))) Params* KP;

DI float bf2f(unsigned short b) { return __uint_as_float(((unsigned)b) << 16); }
DI float bflo(unsigned w) { return __uint_as_float(w << 16); }
DI float bfhi(unsigned w) { return __uint_as_float(w & 0xffff0000u); }
DI unsigned cvt_pk(float lo, float hi) { f32x2 v = {lo, hi}; return __builtin_bit_cast(unsigned, __builtin_convertvector(v, bf16v2)); }
DI unsigned short f2bf(float x) { return (unsigned short)(cvt_pk(x, x) & 0xffffu); }
DI u32x4 pack8(f32x4 a, f32x4 b) { u32x4 w; w.x = cvt_pk(a[0], a[1]); w.y = cvt_pk(a[2], a[3]); w.z = cvt_pk(b[0], b[1]); w.w = cvt_pk(b[2], b[3]); return w; }
DI void unpack8(u32x4 w, float* f) { f[0] = bflo(w.x); f[1] = bfhi(w.x); f[2] = bflo(w.y); f[3] = bfhi(w.y); f[4] = bflo(w.z); f[5] = bfhi(w.z); f[6] = bflo(w.w); f[7] = bfhi(w.w); }
DI float fsigmoid(float x) { return __builtin_amdgcn_rcpf(1.f + __expf(-x)); }
DI float fsilu(float x) { return x * fsigmoid(x); }
DI float fgelu(float x) { return x * fsigmoid(1.5957691216f * (x + 0.044715f * x * x * x)); }
DI float wave_sum(float v) {
#pragma unroll
    for (int o = 32; o >= 1; o >>= 1) v += __shfl_xor(v, o);
    return v;
}
DI int crow(int reg, int h) { return (reg & 3) + 8 * (reg >> 2) + 4 * h; }
#define MFMA32(a, b, c) __builtin_amdgcn_mfma_f32_32x32x16_bf16((a), (b), (c), 0, 0, 0)

constexpr int HTB = 128 * 64 * 2;
DI int lds_byte(int r, int c) { const int st = (r >> 4) * 2 + (c >> 5), rr = r & 15, cc = c & 31, ob = rr * 64 + cc * 2; return st * 1024 + (ob ^ (((ob >> 9) & 1) << 5)); }
DI void stage_rc(int b, int& R, int& C) { const int st = b / 1024, sb = b % 1024, swz = sb ^ (((sb >> 9) & 1) << 5); R = (st >> 1) * 16 + swz / 64; C = (st & 1) * 32 + (swz % 64) / 2; }
DI int perm32(int rho) { const int n = rho >> 4, i = rho & 15; return 8 * (i >> 2) + 4 * n + (i & 3); }

enum { K_Z = 0, K_MEMKV = 1, K_PLAIN = 2, K_QP = 3, K_EG = 4, K_EY = 5, K_F = 6 };
struct GU {
    const char* A; const char* B;
    int lda, ldb;
    int nt;
    int kind, pm, pn, aux;
    bf16_t* C; int ldc;
};

DI bool next_unit(KP p, int gph, int l, int i, GU& u, int wg, int G) {
    unsigned char* ws = p->ws; unsigned char* dob = (unsigned char*)p->out;
    u.aux = 0; u.C = nullptr; u.ldc = 0;
    const bool xm = (G == 256);
    const int x = wg & 7, j = wg >> 3;
    if (gph == 0) {
        int e = -1;
        if (xm) { const int uu = j + 32 * i;
            if (uu < 120) { u.pm = 8 * x + (uu & 7); u.pn = uu >> 3; }
            else { if (j >= 24 && i == 3) e = (j - 24) * 8 + x; if (e < 0 || e >= 12) return false; } }
        else { const int L = i * G + wg; if (L < 960) { u.pm = L & 63; u.pn = L >> 6; } else { e = L - 960; if (e >= 12) return false; } }
        if (e < 0) { u.A = (const char*)(ws + OFF_XB) + (size_t)u.pm * 256 * 2048; u.B = (const char*)(ws + OFF_WIN + l * SZ_WIN) + (size_t)u.pn * 256 * 2048;
            u.lda = 2048; u.ldb = 2048; u.nt = 16; u.kind = K_Z; return true; }
        if (e < 8) { u.pm = e & 3; u.pn = e >> 2; u.A = (const char*)(ws + OFF_MEMB) + (size_t)u.pm * 256 * 2048; u.B = (const char*)(ws + OFF_MEMW + l * SZ_MEMW) + (size_t)u.pn * 256 * 2048;
            u.lda = 2048; u.ldb = 2048; u.nt = 16; u.kind = K_MEMKV; return true; }
        u.pm = 0; u.pn = e - 8; u.A = (const char*)(ws + OFF_MEMW + l * SZ_MEMW) + (size_t)256 * 2048; u.B = (const char*)(ws + OFF_MEMB) + (size_t)u.pn * 256 * 2048;
        u.lda = 2048; u.ldb = 2048; u.nt = 16; u.kind = K_PLAIN; u.C = (bf16_t*)(ws + OFF_MVT); u.ldc = 1024; return true;
    } else if (gph == 1) {
        int v;
        if (xm) { if (i == 0 && j < 24) { v = -1; u.pm = 8 * x + (j & 7); u.pn = j >> 3; } else v = ((j + 8) & 31) * 8 + x + 256 * (j < 24 ? i - 1 : i); }
        else { const int L = i * G + wg; if (L < 192) { v = -1; u.pm = L & 63; u.pn = L >> 6; } else v = L - 192; }
        if (v < 0) { u.A = (const char*)(ws + OFF_Z) + (size_t)u.pm * 256 * (ZW * 2) + C_CQ * 2; u.lda = ZW * 2;
            u.B = (const char*)(ws + OFF_WUQ + l * SZ_WUQ) + (size_t)u.pn * 256 * 512; u.ldb = 512; u.nt = 4; u.kind = K_QP; return true; }
        if (v < 194) { u.pm = v % 97; u.pn = v / 97; u.A = (const char*)(dob + DO_CKV) + (size_t)u.pm * 256 * 512; u.lda = 512;
            u.B = (const char*)(ws + OFF_WUK + l * SZ_WUK) + (size_t)u.pn * 256 * 512; u.ldb = 512; u.nt = 4; u.kind = K_PLAIN; u.C = (bf16_t*)(dob + DO_KN); u.ldc = 512; return true; }
        v -= 194;
        if (v < 194) { u.pm = v / 97; u.pn = v % 97; u.A = (const char*)(ws + OFF_WUV + l * SZ_WUK) + (size_t)u.pm * 256 * 512; u.lda = 512;
            u.B = (const char*)(dob + DO_CKV) + (size_t)u.pn * 256 * 512; u.ldb = 512; u.nt = 4; u.kind = K_PLAIN; u.C = (bf16_t*)(ws + OFF_VT); u.ldc = KVROWS; return true; }
        return false;
    } else if (gph == 2) {
        const int rr = i >> 3, sub = i & 7;
        if (xm) { if (rr > 0) return false; u.pm = 8 * x + (j & 7); u.pn = j >> 3; }
        else { const int tt = wg + G * rr; if (tt >= 256) return false; u.pm = tt & 63; u.pn = tt >> 6; }
        const int ib = sub & 3; u.aux = ib;
        if (sub < 4) { u.A = (const char*)(ws + OFF_XB) + (size_t)u.pm * 256 * 2048; u.lda = 2048;
            u.B = (const char*)(ws + OFF_WIN + l * SZ_WIN) + (size_t)(3840 + ib * 1024 + u.pn * 256) * 2048; u.ldb = 2048; u.nt = 16; u.kind = K_EG; }
        else { const int zc = ib == 0 ? C_AU : ib == 1 ? C_BG : ib == 2 ? C_CG : C_MQ;
            u.A = (const char*)(ws + OFF_Z) + (size_t)u.pm * 256 * (ZW * 2) + zc * 2; u.lda = ZW * 2;
            u.B = (const char*)(ws + OFF_WBR + l * SZ_WBR) + (size_t)u.pn * 256 * 3584 + ib * 512 * 2; u.ldb = 3584; u.nt = ib < 3 ? 8 : 4; u.kind = K_EY; }
        return true;
    } else {
        if (xm) { if (i > 0) return false; u.pm = 8 * x + (j & 7); u.pn = j >> 3; }
        else { const int L = i * G + wg; if (L >= 256) return false; u.pm = L & 63; u.pn = L >> 6; }
        u.A = (const char*)(ws + OFF_MERGED) + (size_t)u.pm * 256 * 2048; u.lda = 2048;
        u.B = (const char*)(ws + OFF_WOUT + l * SZ_WOUT) + (size_t)u.pn * 256 * 2048; u.ldb = 2048; u.nt = 16; u.kind = K_F; return true;
    }
}

DI void rope_pair(float& a, float& b, float pos, int jj) {
    const float freq = exp2f(-(float)jj * 0.83048202372f);
    const float ang = pos * freq;
    const float rev = __builtin_amdgcn_fractf(ang * 0.15915494309f);
    const float sn = __builtin_amdgcn_sinf(rev), cs = __builtin_amdgcn_cosf(rev);
    const float x1 = a, x2 = b;
    a = x1 * cs - x2 * sn; b = x1 * sn + x2 * cs;
}

DI void epi_z(KP p, int row, int col, f32x4 v0, f32x4 v1) {
    int act = 0;
    if (col < C_AG) act = 1; else if (col < C_BX) act = 2; else if (col < C_BG) act = 0; else if (col < C_CQ) act = 2; else if (col < C_CG) act = 0; else if (col < C_MQ) act = 2;
    if (act == 1) {
#pragma unroll
        for (int j = 0; j < 4; ++j) { v0[j] = fgelu(v0[j]); v1[j] = fgelu(v1[j]); }
    } else if (act == 2) {
#pragma unroll
        for (int j = 0; j < 4; ++j) { v0[j] = fsilu(v0[j]); v1[j] = fsilu(v1[j]); }
    }
    *(u32x4*)((bf16_t*)(p->ws + OFF_Z) + (size_t)row * ZW + col) = pack8(v0, v1);
}
DI void epi_qp(KP p, int row, int col, f32x4 v0, f32x4 v1) {
    const int d = col % 96;
    if (d >= 64) {
        const float pos = row < TP ? (float)(row & 4095) : (float)(1024 + ((row - TP) & 15));
        const int j0 = (d - 64) >> 1;
        float t0 = v0[0], t1 = v0[1], t2 = v0[2], t3 = v0[3], t4 = v1[0], t5 = v1[1], t6 = v1[2], t7 = v1[3];
        rope_pair(t0, t1, pos, j0); rope_pair(t2, t3, pos, j0 + 1); rope_pair(t4, t5, pos, j0 + 2); rope_pair(t6, t7, pos, j0 + 3);
        v0 = (f32x4){t0, t1, t2, t3}; v1 = (f32x4){t4, t5, t6, t7};
    }
    *(u32x4*)((bf16_t*)((unsigned char*)p->out + DO_Q) + (size_t)row * 768 + col) = pack8(v0, v1);
}
DI void epi_f(KP p, int l, int row, int col, f32x4 v0, f32x4 v1, float& s1, float& s2) {
    float x[8];
    { const u32x4 xw = *(const u32x4*)((const bf16_t*)(p->ws + OFF_XB) + (size_t)row * 1024 + col); unpack8(xw, x); }
#pragma unroll
    for (int j = 0; j < 4; ++j) { v0[j] = ALPHA_RES * x[j] + v0[j]; v1[j] = ALPHA_RES * x[4 + j] + v1[j]; s1 += v0[j] + v1[j]; s2 += v0[j] * v0[j] + v1[j] * v1[j]; }
    if (row < NROW) { float* o = p->out + (size_t)row * 1024 + col; *(f32x4*)o = v0; *(f32x4*)(o + 4) = v1; }
}

DI bool gemm_epilogue(KP p, int l, f32x4 (&acc)[2][2][4][2], const GU& u, int tid_in, int wg, bool dumpst) {
    unsigned char* ws = p->ws;
    int tid = tid_in; asm volatile("" : "+v"(tid));
    const int wid = tid >> 6, lane = tid & 63, wr = wid >> 2, wc = wid & 3, fr = lane & 15, fq = lane >> 4;
    const int row0 = u.pm * 256 + wr * 64 + fr, col0 = u.pn * 256 + wc * 32 + 8 * fq;
    if (u.kind == K_EY) {
        const u32x2* gs = (const u32x2*)((unsigned char*)p->out + DO_GSCR) + (((size_t)wg * 4 + u.aux) * 16) * 512 + tid;
#pragma unroll
        for (int ai = 0; ai < 2; ++ai) {
            u32x2 gc[8], gn[8];
#pragma unroll
            for (int v = 0; v < 8; ++v) gc[v] = gs[(ai * 8 + v) * 512];
            if (u.aux < 3) {
#pragma unroll
                for (int v = 0; v < 8; ++v) gn[v] = gs[(16 + ai * 8 + v) * 512];
            } else {
#pragma unroll
                for (int v = 0; v < 8; ++v) gn[v] = (u32x2){0xffffffffu, 0xffffffffu};
            }
#pragma unroll
            for (int m = 0; m < 4; ++m)
#pragma unroll
                for (int bj = 0; bj < 2; ++bj) {
                    const int vec = m * 2 + bj;
                    f32x4 v0 = acc[ai][bj][m][0], v1 = acc[ai][bj][m][1];
#pragma unroll
                    for (int j = 0; j < 4; ++j) {
                        v0[j] *= (float)((gc[vec].x >> (8 * j)) & 0xffu) * __builtin_amdgcn_rcpf((float)((gn[vec].x >> (8 * j)) & 0xffu));
                        v1[j] *= (float)((gc[vec].y >> (8 * j)) & 0xffu) * __builtin_amdgcn_rcpf((float)((gn[vec].y >> (8 * j)) & 0xffu)); }
                    if (u.aux < 3) { acc[ai][bj][m][0] = v0; acc[ai][bj][m][1] = v1; }
                    else *(u32x4*)((bf16_t*)(ws + OFF_MERGED) + (size_t)(row0 + ai * 128 + m * 16) * 1024 + col0 + bj * 128) = pack8(v0, v1);
                }
        }
        return u.aux < 3;
    }
    if (u.kind == K_F) {
        const bf16_t* XB = (const bf16_t*)(ws + OFF_XB);
#pragma unroll
        for (int ai = 0; ai < 2; ++ai) {
            u32x4 xr[8];
#pragma unroll
            for (int m = 0; m < 4; ++m)
#pragma unroll
                for (int bj = 0; bj < 2; ++bj) xr[m * 2 + bj] = *(const u32x4*)(XB + (size_t)(row0 + ai * 128 + m * 16) * 1024 + col0 + bj * 128);
#pragma unroll
            for (int m = 0; m < 4; ++m) {
                const int row = row0 + ai * 128 + m * 16;
                float s1 = 0.f, s2 = 0.f;
#pragma unroll
                for (int bj = 0; bj < 2; ++bj) {
                    f32x4 v0 = acc[ai][bj][m][0], v1 = acc[ai][bj][m][1];
                    float x[8]; unpack8(xr[m * 2 + bj], x);
#pragma unroll
                    for (int j = 0; j < 4; ++j) { v0[j] = ALPHA_RES * x[j] + v0[j]; v1[j] = ALPHA_RES * x[4 + j] + v1[j]; s1 += v0[j] + v1[j]; s2 += v0[j] * v0[j] + v1[j] * v1[j]; }
                    float* o = p->out + (size_t)row * 1024 + col0 + bj * 128; *(f32x4*)o = v0; *(f32x4*)(o + 4) = v1;
                }
                s1 += __shfl_xor(s1, 16); s1 += __shfl_xor(s1, 32); s2 += __shfl_xor(s2, 16); s2 += __shfl_xor(s2, 32);
                if (fq == 0) { float* st = dumpst ? (float*)(ws + WS_NEED) + (row & 1023) * 2 : (float*)(ws + OFF_STATS) + (((size_t)l * MROWS + row) * 32 + u.pn * 4 + wc) * 2;
                    *(f32x2*)st = (f32x2){s1, s2}; }
            }
        }
        return false;
    }
#pragma unroll
    for (int ai = 0; ai < 2; ++ai)
#pragma unroll
        for (int m = 0; m < 4; ++m) {
            const int row = row0 + ai * 128 + m * 16;
#pragma unroll
            for (int bj = 0; bj < 2; ++bj) {
                const int col = col0 + bj * 128;
                f32x4 v0 = acc[ai][bj][m][0], v1 = acc[ai][bj][m][1];
                const int vec = (ai * 4 + m) * 2 + bj;
                if (u.kind == K_Z) {
                    epi_z(p, row, col, v0, v1);
                } else if (u.kind == K_MEMKV) {
                    float* o = p->out + (col < 256 ? O_PMK : O_PMV) + (size_t)l * 262144 + (size_t)row * 256 + (col & 255);
                    *(f32x4*)o = v0; *(f32x4*)(o + 4) = v1;
                    if (col < 256) *(u32x4*)((bf16_t*)(ws + OFF_MK) + (size_t)row * 256 + col) = pack8(v0, v1);
                } else if (u.kind == K_PLAIN) {
                    *(u32x4*)(u.C + (size_t)row * u.ldc + col) = pack8(v0, v1);
                } else if (u.kind == K_QP) {
                    epi_qp(p, row, col, v0, v1);
                } else {
                    unsigned q[8];
#pragma unroll
                    for (int j = 0; j < 4; ++j) { q[j] = (unsigned)fminf(fmaxf(__builtin_rintf(255.f * fsigmoid(v0[j])), 1.f), 255.f); q[4 + j] = (unsigned)fminf(fmaxf(__builtin_rintf(255.f * fsigmoid(v1[j])), 1.f), 255.f); }
                    u32x2 w; w.x = q[0] | (q[1] << 8) | (q[2] << 16) | (q[3] << 24); w.y = q[4] | (q[5] << 8) | (q[6] << 16) | (q[7] << 24);
                    *((u32x2*)((unsigned char*)p->out + DO_GSCR) + (((size_t)wg * 4 + u.aux) * 16 + vec) * 512 + tid) = w;
                }
            }
        }
    return false;
}

DI void gemm_stream(KP p, int gph, int l, LAS unsigned char* lds, int tid, int wg, int G, bool dumpst = false) {
    const int wid = __builtin_amdgcn_readfirstlane(tid >> 6), lane = tid & 63, wr = wid >> 2, wc = wid & 3, fr = lane & 15, fq = lane >> 4;
    const unsigned ldsw = (unsigned)wid * 1024u;
    const int aoff = lds_byte(wr * 64 + fr, fq * 8), boff = lds_byte(wc * 32 + fr, fq * 8);
#define PG8_SA(b, h) (((b) * 2 + (h)) * HTB)
#define PG8_SB(b, h) ((4 + (b) * 2 + (h)) * HTB)
#define PG8_STAGE(bufoff, gbase, voff) do { const char* _g = (const char*)(gbase); asm volatile("" : "+s"(_g)); _Pragma("unroll") for (int _i = 0; _i < 2; ++_i) \
        __builtin_amdgcn_global_load_lds((const unsigned*)(_g + (voff)[_i]), (LAS unsigned*)(lds + (bufoff) + ldsw + _i * 8192), 16, 0, 0); } while (0)
#define PG8_LDA(dst, b, h) do { _Pragma("unroll") for (int m = 0; m < 4; ++m) _Pragma("unroll") for (int k = 0; k < 2; ++k) dst[m][k] = *(const LAS bf16x8*)(lds + PG8_SA(b, h) + aoff + m * 2048 + k * 1024); } while (0)
#define PG8_LDB(dst, b, h) do { _Pragma("unroll") for (int n = 0; n < 2; ++n) _Pragma("unroll") for (int k = 0; k < 2; ++k) dst[n][k] = *(const LAS bf16x8*)(lds + PG8_SB(b, h) + boff + n * 2048 + k * 1024); } while (0)
#define PG8_MMA(ai, bj, At, Bt) do { __builtin_amdgcn_s_setprio(1); _Pragma("unroll") for (int m = 0; m < 4; ++m) _Pragma("unroll") for (int n = 0; n < 2; ++n) _Pragma("unroll") for (int k = 0; k < 2; ++k) \
        acc[ai][bj][m][n] = __builtin_amdgcn_mfma_f32_16x16x32_bf16(Bt[n][k], At[m][k], acc[ai][bj][m][n], 0, 0, 0); __builtin_amdgcn_s_setprio(0); } while (0)
#define PG8_WAIT_V(n) asm volatile("s_waitcnt vmcnt(" #n ")" ::: "memory")
#define PG8_WAIT_L(n) asm volatile("s_waitcnt lgkmcnt(" #n ")" ::: "memory")
#define PG8_BAR __builtin_amdgcn_s_barrier()
#define PG8_SCHED __builtin_amdgcn_sched_barrier(0)
#define PG8_VOFF(vA, vB, U) do { _Pragma("unroll") for (int _i = 0; _i < 2; ++_i) { int _R, _C; stage_rc(tid * 16 + _i * 8192, _R, _C); const int _Rb = (_R & ~31) + perm32(_R & 31); \
        vA[_i] = (unsigned)(_R * (U).lda + _C * 2); vB[_i] = (unsigned)(_Rb * (U).ldb + _C * 2); } } while (0)
    GU cur, nxt; int ui = 0;
    if (!next_unit(p, gph, l, 0, cur, wg, G)) return;
    f32x4 acc[2][2][4][2];
#pragma unroll
    for (int a = 0; a < 2; ++a)
#pragma unroll
        for (int b = 0; b < 2; ++b)
#pragma unroll
            for (int m = 0; m < 4; ++m)
#pragma unroll
                for (int n = 0; n < 2; ++n) acc[a][b][m][n] = (f32x4){0.f, 0.f, 0.f, 0.f};
    bf16x8 At[4][2], B0[2][2], B1[2][2];
    unsigned cvA[2], cvB[2];
    PG8_VOFF(cvA, cvB, cur);
    const char* cA = cur.A; const char* cB = cur.B;
    size_t chA = (size_t)128 * cur.lda, chB = (size_t)128 * cur.ldb;
    const size_t kstep = 128;
    PG8_STAGE(PG8_SB(0, 0), cB, cvB); PG8_STAGE(PG8_SA(0, 0), cA, cvA); PG8_STAGE(PG8_SB(0, 1), cB + chB, cvB); PG8_STAGE(PG8_SA(0, 1), cA + chA, cvA);
    if (wr == 1) PG8_BAR;
    PG8_WAIT_V(4); PG8_BAR;
    PG8_STAGE(PG8_SB(1, 0), cB + kstep, cvB); PG8_STAGE(PG8_SA(1, 0), cA + kstep, cvA); PG8_STAGE(PG8_SB(1, 1), cB + chB + kstep, cvB);
    PG8_WAIT_V(6); PG8_BAR;
    for (;;) {
        const bool has_next = next_unit(p, gph, l, ui + 1, nxt, wg, G);
        if (!has_next) nxt = cur;
        const char* nA = nxt.A; const char* nB = nxt.B;
        const size_t nhA = (size_t)128 * nxt.lda, nhB = (size_t)128 * nxt.ldb;
        const int nt = cur.nt;
        for (int t = 0; t < nt; t += 2) {
            const bool last = (t == nt - 2);
            const char* a1 = cA + (size_t)(t + 1) * kstep;
            const char* a2 = last ? nA : cA + (size_t)(t + 2) * kstep; const char* b2 = last ? nB : cB + (size_t)(t + 2) * kstep;
            const char* a3 = a2 + kstep; const char* b3 = b2 + kstep;
            unsigned vA2[2], vB2[2];
            if (last) { PG8_VOFF(vA2, vB2, nxt); }
            else {
#pragma unroll
                for (int _i = 0; _i < 2; ++_i) { vA2[_i] = cvA[_i]; vB2[_i] = cvB[_i]; } }
            const size_t hA2 = last ? nhA : chA, hB2 = last ? nhB : chB;
            PG8_LDB(B0, 0, 0); PG8_SCHED; PG8_LDA(At, 0, 0); PG8_STAGE(PG8_SA(1, 1), a1 + chA, cvA);
            PG8_WAIT_L(8); PG8_BAR; PG8_WAIT_L(0); PG8_MMA(0, 0, At, B0); PG8_BAR; PG8_SCHED;
            PG8_LDB(B1, 0, 1); PG8_STAGE(PG8_SB(0, 0), b2, vB2);
            PG8_BAR; PG8_WAIT_L(0); PG8_MMA(0, 1, At, B1); PG8_BAR;
            PG8_LDA(At, 0, 1); PG8_STAGE(PG8_SA(0, 0), a2, vA2);
            PG8_BAR; PG8_WAIT_L(0); PG8_MMA(1, 0, At, B0); PG8_BAR; PG8_SCHED;
            PG8_STAGE(PG8_SB(0, 1), b2 + hB2, vB2);
            PG8_WAIT_V(6); PG8_BAR; PG8_MMA(1, 1, At, B1); PG8_BAR;
            PG8_LDB(B0, 1, 0); PG8_SCHED; PG8_LDA(At, 1, 0); PG8_STAGE(PG8_SA(0, 1), a2 + hA2, vA2);
            PG8_WAIT_L(8); PG8_BAR; PG8_WAIT_L(0); PG8_MMA(0, 0, At, B0); PG8_BAR; PG8_SCHED;
            PG8_LDB(B1, 1, 1); PG8_STAGE(PG8_SB(1, 0), b3, vB2);
            PG8_BAR; PG8_WAIT_L(0); PG8_MMA(0, 1, At, B1); PG8_BAR;
            PG8_LDA(At, 1, 1); PG8_STAGE(PG8_SA(1, 0), a3, vA2);
            PG8_BAR; PG8_WAIT_L(0); PG8_MMA(1, 0, At, B0); PG8_BAR; PG8_SCHED;
            PG8_STAGE(PG8_SB(1, 1), b3 + hB2, vB2);
            PG8_WAIT_V(6); PG8_BAR; PG8_MMA(1, 1, At, B1); PG8_BAR;
        }
        const bool keep = gemm_epilogue(p, l, acc, cur, tid, wg, dumpst);
        if (!has_next) break;
        if (!keep)
#pragma unroll
        for (int a = 0; a < 2; ++a)
#pragma unroll
            for (int b = 0; b < 2; ++b)
#pragma unroll
                for (int m = 0; m < 4; ++m)
#pragma unroll
                    for (int n = 0; n < 2; ++n) acc[a][b][m][n] = (f32x4){0.f, 0.f, 0.f, 0.f};
        cur = nxt; cA = nA; cB = nB; chA = nhA; chB = nhB;
        PG8_VOFF(cvA, cvB, cur);
        ++ui;
    }
    PG8_WAIT_V(0);
    if (wr == 0) PG8_BAR;
    PG8_BAR;
}

template <bool AF32>
DI void skinny_mm(const void* Abase, int lda, const bf16_t* Bt, int ldb, int K, LAS float* T, int tid) {
    const int w = tid >> 6, lane = tid & 63, r = lane & 31, h = lane >> 5, mb = w & 3, kh = w >> 2, K2 = K >> 1;
    f32x16 acc;
#pragma unroll
    for (int i = 0; i < 16; ++i) acc[i] = 0.f;
    const bf16_t* bp = Bt + (size_t)r * ldb + kh * K2 + 8 * h;
    const size_t aoff = (size_t)(32 * mb + r) * lda + kh * K2 + 8 * h;
    for (int k = 0; k < K2; k += 64) {
        bf16x8 a[4], b[4];
#pragma unroll
        for (int u = 0; u < 4; ++u) {
            b[u] = *(const bf16x8*)(bp + k + 16 * u);
            if (AF32) { const float* ap = (const float*)Abase + aoff + k + 16 * u; a[u] = __builtin_bit_cast(bf16x8, pack8(*(const f32x4*)ap, *(const f32x4*)(ap + 4))); }
            else a[u] = *(const bf16x8*)((const bf16_t*)Abase + aoff + k + 16 * u);
        }
#pragma unroll
        for (int u = 0; u < 4; ++u) acc = MFMA32(a[u], b[u], acc);
    }
    __syncthreads();
    if (kh == 0) {
#pragma unroll
        for (int i = 0; i < 16; ++i) T[(32 * mb + crow(i, h)) * 33 + r] = acc[i];
    }
    __syncthreads();
    if (kh == 1) {
#pragma unroll
        for (int i = 0; i < 16; ++i) T[(32 * mb + crow(i, h)) * 33 + r] += acc[i];
    }
    __syncthreads();
}
DI void skinny_read(LAS const float* T, int tid, f32x4& v0, f32x4& v1) {
    const int row = tid >> 2, c8 = (tid & 3) * 8;
#pragma unroll
    for (int j = 0; j < 4; ++j) { v0[j] = T[row * 33 + c8 + j]; v1[j] = T[row * 33 + c8 + 4 + j]; }
}
DI void sample_gemm_phase(KP p, int gph, int l, LAS unsigned char* lds, int tid, int wg, int G) {
    unsigned char* ws = p->ws;
    LAS float* T = (LAS float*)lds;
    const int row = TP + (tid >> 2), c8 = (tid & 3) * 8;
    const bf16_t* XS = (const bf16_t*)(ws + OFF_XB) + (size_t)TP * 1024;
    const bf16_t* ZS = (const bf16_t*)(ws + OFF_Z) + (size_t)TP * ZW;
    f32x4 v0, v1;
    if (gph == 0) {
        for (int s = G - 1 - wg; s < 117; s += G) {
            skinny_mm<false>(XS, 1024, (const bf16_t*)(ws + OFF_WIN + l * SZ_WIN) + (size_t)s * 32 * 1024, 1024, 1024, T, tid);
            skinny_read(T, tid, v0, v1); epi_z(p, row, s * 32 + c8, v0, v1);
        }
    } else if (gph == 1) {
        for (int s = G - 1 - wg; s < 24; s += G) {
            skinny_mm<false>(ZS + C_CQ, ZW, (const bf16_t*)(ws + OFF_WUQ + l * SZ_WUQ) + (size_t)s * 32 * 256, 256, 256, T, tid);
            skinny_read(T, tid, v0, v1); epi_qp(p, row, s * 32 + c8, v0, v1);
        }
    } else if (gph == 2) {
        float* MS = (float*)(ws + OFF_MS);
        for (int it = G - 1 - wg; it < 128; it += G) {
            const int s = it >> 2, ib = it & 3, n0 = s * 32;
            skinny_mm<false>(XS, 1024, (const bf16_t*)(ws + OFF_WIN + l * SZ_WIN) + (size_t)(3840 + ib * 1024 + n0) * 1024, 1024, 1024, T, tid);
            f32x4 g0, g1; skinny_read(T, tid, g0, g1);
            const int zc = ib == 0 ? C_AU : ib == 1 ? C_BG : ib == 2 ? C_CG : C_MQ;
            skinny_mm<false>(ZS + zc, ZW, (const bf16_t*)(ws + OFF_WBR + l * SZ_WBR) + (size_t)n0 * 1792 + ib * 512, 1792, ib < 3 ? 512 : 256, T, tid);
            skinny_read(T, tid, v0, v1);
            float* mp = MS + (size_t)(tid >> 2) * 1024 + n0 + c8;
#pragma unroll
            for (int j = 0; j < 4; ++j) { __hip_atomic_fetch_add(mp + j, fsigmoid(g0[j]) * v0[j], __ATOMIC_RELAXED, __HIP_MEMORY_SCOPE_AGENT);
                __hip_atomic_fetch_add(mp + 4 + j, fsigmoid(g1[j]) * v1[j], __ATOMIC_RELAXED, __HIP_MEMORY_SCOPE_AGENT); }
        }
    } else {
        for (int s = G - 1 - wg; s < 32; s += G) {
            skinny_mm<true>((const float*)(ws + OFF_MS), 1024, (const bf16_t*)(ws + OFF_WOUT + l * SZ_WOUT) + (size_t)s * 32 * 1024, 1024, 1024, T, tid);
            skinny_read(T, tid, v0, v1);
            float s1 = 0.f, s2 = 0.f;
            epi_f(p, l, row, s * 32 + c8, v0, v1, s1, s2);
            s1 += __shfl_xor(s1, 1); s1 += __shfl_xor(s1, 2); s2 += __shfl_xor(s2, 1); s2 += __shfl_xor(s2, 2);
            if ((tid & 3) == 0) { float* st = (float*)(ws + OFF_STATS) + (((size_t)l * MROWS + row) * 32 + s) * 2; *(f32x2*)st = (f32x2){s1, s2}; }
        }
    }
    __syncthreads();
}

struct TJob { const float* src; int lds_, Ks; bf16_t* dst; int ldd, nN, nK, map; };
DI int tmap(int kind, int n) {
    if (kind == 0) return n;
    if (kind == 1) return n < 3744 ? n : (n < 3840 ? -1 : n - 96);
    if (kind == 2) { const int h = n / 96, d = n % 96; if (d < 64) return n; const int jj = (d - 64) >> 1, e = (d - 64) & 1; return h * 96 + 64 + jj + 16 * e; }
    if (kind == 3) { const int h = n >> 6, d = n & 63; return h * 128 + d; }
    const int h = n >> 6, d = n & 63; return h * 128 + 64 + d;
}
DI bool tjob(KP p, int j, TJob& t) {
    unsigned char* ws = p->ws;
    if (j < 18) { const int l = j / 9, k = j % 9;
        switch (k) {
        case 0: t = {p->in[9] + (size_t)l * 1024 * 7840, 7840, 1024, (bf16_t*)(ws + OFF_WIN + l * SZ_WIN), 1024, 124, 16, 1}; break;
        case 1: t = {p->in[22] + (size_t)l * 256 * 768, 768, 256, (bf16_t*)(ws + OFF_WUQ + l * SZ_WUQ), 256, 12, 4, 2}; break;
        case 2: t = {p->in[24] + (size_t)l * 128 * 1024, 1024, 128, (bf16_t*)(ws + OFF_WUK + l * SZ_WUK), 256, 8, 4, 3}; break;
        case 3: t = {p->in[24] + (size_t)l * 128 * 1024, 1024, 128, (bf16_t*)(ws + OFF_WUV + l * SZ_WUK), 256, 8, 4, 4}; break;
        case 4: t = {p->in[27] + (size_t)l * 1792 * 1024, 1024, 1792, (bf16_t*)(ws + OFF_WBR + l * SZ_WBR), 1792, 16, 28, 0}; break;
        case 5: t = {p->in[28] + (size_t)l * 1024 * 1024, 1024, 1024, (bf16_t*)(ws + OFF_WOUT + l * SZ_WOUT), 1024, 16, 16, 0}; break;
        case 6: t = {p->in[25] + (size_t)l * 1024 * 256, 256, 1024, (bf16_t*)(ws + OFF_MEMW + l * SZ_MEMW), 1024, 4, 16, 0}; break;
        case 7: t = {p->in[26] + (size_t)l * 1024 * 256, 256, 1024, (bf16_t*)(ws + OFF_MEMW + l * SZ_MEMW) + 256 * 1024, 1024, 4, 16, 0}; break;
        default: t = {p->in[6] + (size_t)l * 8 * 65536, 256, 256, (bf16_t*)(ws + OFF_MVTS) + (size_t)l * 8 * 65536, 256, 4, 4, 0}; break;
        }
        return true; }
    j -= 18;
    if (j < 14) { const int l = j / 7, b = j % 7 + 1; t = {p->in[6] + (size_t)(l * 8 + b) * 65536, 256, 256, (bf16_t*)(ws + OFF_MVTS) + (size_t)(l * 8 + b) * 65536, 256, 4, 4, 0}; return true; }
    j -= 14;
    if (j < 32) { const int l = j / 16, r = j % 16, hb = r >> 1, gi = r & 1;
        t = {p->in[gi ? 18 : 16] + (size_t)(l * 8 + hb) * 4096, 64, 64, (bf16_t*)(ws + OFF_WRI + l * SZ_WRI) + hb * 8192 + gi * 4096, 64, 1, 1, 0}; return true; }
    return false;
}

DI void prep_phase(KP p, LAS unsigned char* lds, int tid) {
    const int G = gridDim.x, wg = blockIdx.x;
    unsigned char* ws = p->ws;
    {
        bf16_t* XB = (bf16_t*)(ws + OFF_XB);
        const size_t nvec = (size_t)MROWS * 1024 / 8;
        for (size_t v = (size_t)wg * 512 + tid; v < nvec; v += (size_t)G * 512) {
            const size_t e = v * 8; const int row = (int)(e >> 10);
            u32x4 o = {0u, 0u, 0u, 0u};
            if (row < NROW) { const float* src = row < TP ? p->in[0] + e : p->in[1] + (e - (size_t)TP * 1024); o = pack8(*(const f32x4*)src, *(const f32x4*)(src + 4)); }
            *(u32x4*)(XB + e) = o;
        }
    }
    {
        bf16_t* MB = (bf16_t*)(ws + OFF_MEMB);
        for (size_t v = (size_t)wg * 512 + tid; v < (size_t)1024 * 1024 / 8; v += (size_t)G * 512) { const float* s = p->in[2] + v * 8; *(u32x4*)(MB + v * 8) = pack8(*(const f32x4*)s, *(const f32x4*)(s + 4)); }
        bf16_t* MKS = (bf16_t*)(ws + OFF_MKS);
        for (size_t v = (size_t)wg * 512 + tid; v < (size_t)2 * 2048 * 256 / 8; v += (size_t)G * 512) { const float* s = p->in[5] + v * 8; *(u32x4*)(MKS + v * 8) = pack8(*(const f32x4*)s, *(const f32x4*)(s + 4)); }
        bf16_t* GW = (bf16_t*)(ws + OFF_GWS);
        for (size_t v = (size_t)wg * 512 + tid; v < (size_t)2 * 4 * 128 * 128 / 8; v += (size_t)G * 512) {
            const size_t e = v * 8; const int q0 = (int)(e & 127), pr = (int)((e >> 7) & 127); const float* s = p->in[12] + e;
            f32x4 a = *(const f32x4*)s, b = *(const f32x4*)(s + 4);
#pragma unroll
            for (int j = 0; j < 4; ++j) { if (q0 + j > pr) a[j] = 0.f; if (q0 + 4 + j > pr) b[j] = 0.f; }
            *(u32x4*)(GW + e) = pack8(a, b); }
    }
    LAS float* tile = (LAS float*)lds;
    int base = 0;
    for (int j = 0;; ++j) {
        TJob t; if (!tjob(p, j, t)) break;
        const int ntile = t.nN * t.nK;
        int first = wg - (base % G); if (first < 0) first += G;
        for (int tt = first; tt < ntile; tt += G) {
            const int tn = tt / t.nK, tk = tt % t.nK, n0 = tn * 64, k0 = tk * 64;
            __syncthreads();
            for (int e = tid; e < 4096; e += 512) { const int kk = e >> 6, nn = e & 63; const int sc = tmap(t.map, n0 + nn); const int k = k0 + kk;
                tile[kk * 65 + nn] = (sc >= 0 && k < t.Ks) ? t.src[(size_t)k * t.lds_ + sc] : 0.f; }
            __syncthreads();
            for (int e = tid; e < 2048; e += 512) { const int nn = e >> 5, k2 = (e & 31) * 2;
                *(unsigned*)(t.dst + (size_t)(n0 + nn) * t.ldd + k0 + k2) = cvt_pk(tile[k2 * 65 + nn], tile[(k2 + 1) * 65 + nn]); }
        }
        base += ntile;
    }
    __syncthreads();
}

struct RawRow { u32x4 av; u32x2 cq; unsigned kv; unsigned short ka, kb; };
DI RawRow rows_load(const bf16_t* Z, int row, int lane) {
    const bf16_t* zr = Z + (size_t)row * ZW; RawRow r;
    r.av = *(const u32x4*)(zr + C_AV + lane * 8); r.cq = *(const u32x2*)(zr + C_CQ + lane * 4); r.kv = *(const unsigned*)(zr + C_CKV + lane * 2);
    r.ka = zr[C_CKR + (lane & 15)]; r.kb = zr[C_CKR + 16 + (lane & 15)]; return r;
}
DI void rows_phase(KP p, int l, int tid, bool dump = false) {
    const int G = gridDim.x, lane = tid & 63, gw = blockIdx.x * 8 + (tid >> 6), nw = G * 8;
    unsigned char* ws = p->ws; unsigned char* dob = (unsigned char*)p->out;
    bf16_t* Z = (bf16_t*)(ws + OFF_Z); bf16_t* CKV = (bf16_t*)(dob + DO_CKV); bf16_t* KR = (bf16_t*)(dob + DO_KR);
    {
        const f32x4 g0 = *(const f32x4*)(p->in[10] + l * 512 + lane * 8), g1 = *(const f32x4*)(p->in[10] + l * 512 + lane * 8 + 4);
        const f32x4 b0 = *(const f32x4*)(p->in[11] + l * 512 + lane * 8), b1 = *(const f32x4*)(p->in[11] + l * 512 + lane * 8 + 4);
        const f32x4 gq = *(const f32x4*)(p->in[21] + l * 256 + lane * 4);
        const f32x2 gk = *(const f32x2*)(p->in[23] + l * 128 + lane * 2);
        RawRow cur; if (gw < NROW) cur = rows_load(Z, gw, lane);
        for (int row = gw; row < NROW; row += nw) {
            RawRow nxt = cur; if (row + nw < NROW) nxt = rows_load(Z, row + nw, lane);
            const bool smp = row >= TP; const int srow = row - TP;
            bf16_t* zr = dump ? (bf16_t*)(ws + WS_NEED) : Z + (size_t)row * ZW;
            float x[8]; unpack8(cur.av, x);
            float xq[4] = {bflo(cur.cq.x), bfhi(cur.cq.x), bflo(cur.cq.y), bfhi(cur.cq.y)};
            const float k0 = bflo(cur.kv), k1 = bfhi(cur.kv);
            float s = 0.f;
#pragma unroll
            for (int j = 0; j < 8; ++j) s += x[j];
            float ssq = xq[0] * xq[0] + xq[1] * xq[1] + xq[2] * xq[2] + xq[3] * xq[3];
            float ssk = k0 * k0 + k1 * k1;
#pragma unroll
            for (int o = 32; o >= 1; o >>= 1) { s += __shfl_xor(s, o); ssq += __shfl_xor(ssq, o); ssk += __shfl_xor(ssk, o); }
            const float mean = s * (1.f / 512.f);
            float q = 0.f;
#pragma unroll
            for (int j = 0; j < 8; ++j) { x[j] -= mean; q += x[j] * x[j]; }
            const float rstd = rsqrtf(wave_sum(q) * (1.f / 512.f) + LN_EPS);
            {
                f32x4 y0, y1;
#pragma unroll
                for (int j = 0; j < 4; ++j) { y0[j] = x[j] * rstd * g0[j] + b0[j]; y1[j] = x[4 + j] * rstd * g1[j] + b1[j]; }
                *(u32x4*)(zr + C_AV + lane * 8) = pack8(y0, y1);
                if (smp && !dump) { float* o = p->out + O_SGV + (size_t)l * 65536 + (size_t)srow * 512 + lane * 8; *(f32x4*)o = y0; *(f32x4*)(o + 4) = y1; }
            }
            {
                const float r = rsqrtf(ssq * (1.f / 256.f) + LN_EPS);
                u32x2 o; o.x = cvt_pk(xq[0] * r * gq[0], xq[1] * r * gq[1]); o.y = cvt_pk(xq[2] * r * gq[2], xq[3] * r * gq[3]);
                *(u32x2*)(zr + C_CQ + lane * 4) = o;
            }
            const int kvrow = smp ? TP + (srow >> 4) * SKEYS + 1024 + (srow & 15) : row;
            if (dump) { CKV = (bf16_t*)(ws + WS_NEED) + 8192 - (size_t)kvrow * 256; KR = (bf16_t*)(ws + WS_NEED) + 16384 - (size_t)kvrow * 32; }
            {
                const float r = rsqrtf(ssk * (1.f / 128.f) + LN_EPS);
                const float y0 = k0 * r * gk[0], y1 = k1 * r * gk[1];
                float* o = smp ? p->out + O_SCKV + (size_t)l * 16384 + (size_t)srow * 128 + lane * 2 : p->out + O_PCKV + (size_t)l * 2097152 + (size_t)row * 128 + lane * 2;
                if (dump) o = (float*)(ws + WS_NEED) + 32768 + lane * 2;
                *(f32x2*)o = (f32x2){y0, y1};
                *(unsigned*)(CKV + (size_t)kvrow * 256 + lane * 2) = cvt_pk(y0, y1);
                *(unsigned*)(CKV + (size_t)kvrow * 256 + 128 + lane * 2) = 0u;
            }
            if (lane < 16) {
                float a = bf2f(cur.ka), b = bf2f(cur.kb);
                const float pos = smp ? (float)(1024 + (srow & 15)) : (float)(row & 4095);
                rope_pair(a, b, pos, lane);
                float* o = smp ? p->out + O_SKR + (size_t)l * 4096 + (size_t)srow * 32 : p->out + O_PKR + (size_t)l * 524288 + (size_t)row * 32;
                if (dump) o = (float*)(ws + WS_NEED) + 36864;
                o[lane] = a; o[lane + 16] = b;
                *(unsigned*)(KR + (size_t)kvrow * 32 + lane * 2) = cvt_pk(a, b);
            }
            cur = nxt;
        }
    }
    if (dump) return;
    for (int i0 = gw * 4; i0 < 8192; i0 += nw * 4) {
        f32x2 sv[4]; f32x2 rv[4];
#pragma unroll
        for (int k = 0; k < 4; ++k) { const int idx = i0 + k, b = idx >> 10, j = idx & 1023;
            sv[k] = *(const f32x2*)(p->in[3] + ((size_t)(l * 8 + b) * 1024 + j) * 128 + lane * 2);
            const float* r = p->in[4] + ((size_t)(l * 8 + b) * 1024 + j) * 32; rv[k] = (f32x2){r[lane & 15], r[(lane & 15) + 16]}; }
#pragma unroll
        for (int k = 0; k < 4; ++k) { const int idx = i0 + k, b = idx >> 10, j = idx & 1023; const int dst = TP + b * SKEYS + j;
            *(unsigned*)(CKV + (size_t)dst * 256 + lane * 2) = cvt_pk(sv[k][0], sv[k][1]);
            *(unsigned*)(CKV + (size_t)dst * 256 + 128 + lane * 2) = 0u;
            if (lane < 16) *(unsigned*)(KR + (size_t)dst * 32 + lane * 2) = cvt_pk(rv[k][0], rv[k][1]); }
    }
    for (int it = gw; it < 36 + 128 + 128; it += nw) {
        if (it < 36) {
            const int idx = it; int src; float* o;
            if (idx < 12) { const int b = idx / 3, k = idx % 3; src = b * 4096 + 4093 + k; o = p->out + O_PCONV + (size_t)l * 6144 + (size_t)(b * 3 + k) * 512; }
            else { const int i2 = idx - 12, b = i2 / 3, k = i2 % 3; src = TP + b * 16 + 13 + k; o = p->out + O_SCONV + (size_t)l * 12288 + (size_t)(b * 3 + k) * 512; }
            const u32x4 raw = *(const u32x4*)(Z + (size_t)src * ZW + C_BX + lane * 8); float x[8]; unpack8(raw, x);
            *(f32x4*)(o + lane * 8) = (f32x4){x[0], x[1], x[2], x[3]}; *(f32x4*)(o + lane * 8 + 4) = (f32x4){x[4], x[5], x[6], x[7]};
        } else if (it < 36 + 128) {
            const int dst = 24704 + (it - 36);
            *(u32x2*)(CKV + (size_t)dst * 256 + lane * 4) = (u32x2){0u, 0u};
        } else {
            float* ms = (float*)(ws + OFF_MS) + (size_t)(it - (36 + 128)) * 1024 + lane * 16;
#pragma unroll
            for (int j = 0; j < 4; ++j) *(f32x4*)(ms + 4 * j) = (f32x4){0.f, 0.f, 0.f, 0.f};
        }
    }
}

DI void ln_phase(KP p, int l, int tid) {
    const int G = gridDim.x, lane = tid & 63, gw = blockIdx.x * 8 + (tid >> 6), nw = G * 8;
    unsigned char* ws = p->ws;
    const float* st = (const float*)(ws + OFF_STATS) + (size_t)l * MROWS * 64;
    bf16_t* XB = (bf16_t*)(ws + OFF_XB);
    const float* g = p->in[29] + l * 1024; const float* b = p->in[30] + l * 1024;
    for (int row = gw; row < NROW; row += nw) {
        f32x2 part = {0.f, 0.f};
        if (lane < (row < TP ? 16 : 32)) part = *(const f32x2*)(st + (size_t)row * 64 + lane * 2);
        float ps1 = part[0], ps2 = part[1];
#pragma unroll
        for (int o = 16; o >= 1; o >>= 1) { ps1 += __shfl_xor(ps1, o); ps2 += __shfl_xor(ps2, o); }
        ps1 = __shfl(ps1, 0); ps2 = __shfl(ps2, 0);
        const float mean = ps1 * (1.f / 1024.f); const float var = ps2 * (1.f / 1024.f) - mean * mean;
        const float rstd = rsqrtf(fmaxf(var, 0.f) + LN_EPS);
        float* vr = p->out + (size_t)row * 1024;
#pragma unroll
        for (int c = 0; c < 2; ++c) {
            const int col = c * 512 + lane * 8;
            f32x4 a = *(const f32x4*)(vr + col), bq = *(const f32x4*)(vr + col + 4);
            const f32x4 g0 = *(const f32x4*)(g + col), g1 = *(const f32x4*)(g + col + 4), b0 = *(const f32x4*)(b + col), b1 = *(const f32x4*)(b + col + 4);
#pragma unroll
            for (int j = 0; j < 4; ++j) { a[j] = (a[j] - mean) * rstd * g0[j] + b0[j]; bq[j] = (bq[j] - mean) * rstd * g1[j] + b1[j]; }
            if (l == 0) *(u32x4*)(XB + (size_t)row * 1024 + col) = pack8(a, bq);
            else { *(f32x4*)(vr + col) = a; *(f32x4*)(vr + col + 4) = bq; }
        }
    }
}

DI void gmlp_tile(KP p, int l, int b, int n, int g, LAS unsigned char* lds, int tid, bool dump = false) {
    const int w = tid >> 6, lane = tid & 63, r = lane & 31, h = lane >> 5;
    bf16_t* Z = (bf16_t*)(p->ws + OFF_Z);
    const bf16_t* GW = (const bf16_t*)(p->ws + OFF_GWS) + (size_t)(l * 4 + g) * 16384;
    LAS bf16_t* Wl = (LAS bf16_t*)lds; LAS bf16_t* Vl = (LAS bf16_t*)(lds + 34816); LAS bf16_t* Ul = (LAS bf16_t*)(lds + 69632); LAS bf16_t* Gl = (LAS bf16_t*)(lds + 102400);
    const int r0 = b * 4096 + n * 128;
    __syncthreads();
    for (int c = tid; c < 2048; c += 512) { const int rr = c >> 4, ch = c & 15; const bf16_t* zr = Z + (size_t)(r0 + rr) * ZW + g * 128 + ch * 8;
        *(LAS u32x4*)(Wl + rr * 136 + ch * 8) = *(const u32x4*)(GW + rr * 128 + ch * 8);
        *(LAS u32x4*)(Vl + rr * 136 + ch * 8) = *(const u32x4*)(zr + C_AV);
        *(LAS u32x4*)(Ul + rr * 128 + ch * 8) = *(const u32x4*)(zr + C_AU);
        *(LAS u32x4*)(Gl + rr * 128 + ch * 8) = *(const u32x4*)(zr + C_AG); }
    __syncthreads();
    const int pb = w >> 1, cb0 = (w & 1) * 2;
    f32x16 acc0, acc1;
#pragma unroll
    for (int i = 0; i < 16; ++i) { acc0[i] = 0.f; acc1[i] = 0.f; }
    for (int s = 0; s < 2 * (pb + 1); ++s) {
        const bf16x8 a = *(const LAS bf16x8*)(Wl + (32 * pb + r) * 136 + 16 * s + 8 * h);
        bf16x8 b0, b1;
#pragma unroll
        for (int j = 0; j < 8; ++j) { b0[j] = (short)Vl[(16 * s + 8 * h + j) * 136 + 32 * cb0 + r]; b1[j] = (short)Vl[(16 * s + 8 * h + j) * 136 + 32 * (cb0 + 1) + r]; }
        acc0 = MFMA32(a, b0, acc0); acc1 = MFMA32(a, b1, acc1);
    }
    const float* bs = p->in[13] + (size_t)(l * 4 + g) * 128;
    float bias[16];
#pragma unroll
    for (int i = 0; i < 16; ++i) bias[i] = bs[32 * pb + crow(i, h)];
#pragma unroll
    for (int i = 0; i < 16; ++i) {
        const int pr = 32 * pb + crow(i, h);
#pragma unroll
        for (int cb = 0; cb < 2; ++cb) {
            const int c = 32 * (cb0 + cb) + r;
            const float sv = (cb ? acc1[i] : acc0[i]) + bias[i];
            Ul[pr * 128 + c] = f2bf(bf2f(Ul[pr * 128 + c]) * sv * bf2f(Gl[pr * 128 + c]));
        }
    }
    __syncthreads();
    for (int c = tid; c < 2048; c += 512) { const int rr = c >> 4, ch = c & 15;
        bf16_t* dst = dump ? (bf16_t*)(p->ws + WS_NEED) + ch * 8 : Z + (size_t)(r0 + rr) * ZW + C_AU + g * 128 + ch * 8;
        *(u32x4*)dst = *(const LAS u32x4*)(Ul + rr * 128 + ch * 8); }
}
DI void gmlp_sample(KP p, int l, int b, int g, int tid) {
    const int c = tid & 127, p0 = (tid >> 7) * 4;
    bf16_t* Z = (bf16_t*)(p->ws + OFF_Z);
    const float* wsrc = p->in[12] + (size_t)(l * 4 + g) * 16384; const float* bs = p->in[13] + (size_t)(l * 4 + g) * 128;
    const int r0 = TP + b * 16;
    float v[16];
#pragma unroll
    for (int q = 0; q < 16; ++q) v[q] = bf2f(Z[(size_t)(r0 + q) * ZW + C_AV + g * 128 + c]);
#pragma unroll
    for (int k = 0; k < 4; ++k) { const int pr = p0 + k; float s = bs[pr];
#pragma unroll
        for (int q = 0; q < 16; ++q) if (q <= pr) s += wsrc[pr * 128 + q] * v[q];
        bf16_t* zr = Z + (size_t)(r0 + pr) * ZW; const int cc = g * 128 + c;
        zr[C_AU + cc] = f2bf(bf2f(zr[C_AU + cc]) * s * bf2f(zr[C_AG + cc])); }
}

DI void lru_tile(KP p, int l, int bg, int hb, int seg, bool apply, LAS unsigned char* lds, int tid, bool dump = false) {
    const int w = tid >> 6, lane = tid & 63, r = lane & 31, h = lane >> 5;
    bf16_t* Z = (bf16_t*)(p->ws + OFF_Z);
    const bool smp = bg >= 4; const int sb = bg - 4;
    const int row0 = smp ? TP + sb * 16 : bg * 4096 + seg * 128; const int ntok = smp ? 16 : 128;
    LAS float* XC = (LAS float*)lds; LAS bf16_t* XCB = (LAS bf16_t*)(lds + 32768); LAS float* GATE = (LAS float*)(lds + 51200); LAS float* AGL = (LAS float*)(lds + 116736);
    LAS bf16_t* BXT = (LAS bf16_t*)(lds + 51200);
    LAS bf16_t* GZ = (LAS bf16_t*)(lds + 120832);
    LAS float* AGP = (LAS float*)(lds + 32768);
    const int c = tid & 63, sub = tid >> 6, ch = hb * 64 + c;
    float* AGG = (float*)(p->ws + OFF_AGG);
    __syncthreads();
    f32x2 agr[4];
    if (apply && !smp) {
#pragma unroll
        for (int k = 0; k < 4; ++k) { const int s2 = sub + 8 * k; agr[k] = (f32x2){1.f, 0.f};
            if (s2 < seg) { const float* o = AGG + (size_t)((bg * 8 + hb) * 32 + s2) * 128; agr[k] = (f32x2){o[c], o[64 + c]}; } }
    }
    for (int q = tid; q < 131 * 8; q += 512) {
        const int rr = q >> 3, cc = (q & 7) * 8; const int tt = rr - 3;
        u32x4 v = {0u, 0u, 0u, 0u};
        if (!smp) { const int gt = seg * 128 + tt; if (gt >= 0) v = *(const u32x4*)(Z + (size_t)(bg * 4096 + gt) * ZW + C_BX + hb * 64 + cc); }
        else if (tt >= 0) { if (tt < 16) v = *(const u32x4*)(Z + (size_t)(row0 + tt) * ZW + C_BX + hb * 64 + cc); }
        else { const float* cs = p->in[8] + ((size_t)(l * 8 + sb) * 3 + rr) * 512 + hb * 64 + cc; v = pack8(*(const f32x4*)cs, *(const f32x4*)(cs + 4)); }
        *(LAS u32x4*)(BXT + rr * 64 + cc) = v;
    }
    if (apply) for (int q = tid; q < 128 * 8; q += 512) { const int rr = q >> 3, cc = (q & 7) * 8;
        u32x4 v = {0u, 0u, 0u, 0u}; if (rr < ntok) v = *(const u32x4*)(Z + (size_t)(row0 + rr) * ZW + C_BG + hb * 64 + cc);
        *(LAS u32x4*)(GZ + rr * 64 + cc) = v; }
    __syncthreads();
    {
        const float cb = p->in[15][l * 512 + ch];
        float cw[4];
#pragma unroll
        for (int k = 0; k < 4; ++k) cw[k] = p->in[14][(size_t)(l * 4 + k) * 512 + ch];
#pragma unroll 4
        for (int t = sub; t < 128; t += 8) {
            float a = 0.f;
            if (t < ntok) { a = cb;
#pragma unroll
                for (int k = 0; k < 4; ++k) a += bf2f(BXT[(t + k) * 64 + c]) * cw[k]; }
            XC[t * 64 + c] = a; XCB[t * 72 + c] = f2bf(a);
        }
    }
    __syncthreads();
    {
        const int tb = w >> 1, nb0 = (w & 1) * 2;
        const bf16_t* WT = (const bf16_t*)(p->ws + OFF_WRI + l * SZ_WRI) + hb * 8192;
        f32x16 a0, a1;
#pragma unroll
        for (int i = 0; i < 16; ++i) { a0[i] = 0.f; a1[i] = 0.f; }
        bf16x8 bw0[4], bw1[4];
#pragma unroll
        for (int s = 0; s < 4; ++s) { bw0[s] = *(const bf16x8*)(WT + (32 * nb0 + r) * 64 + 16 * s + 8 * h); bw1[s] = *(const bf16x8*)(WT + (32 * (nb0 + 1) + r) * 64 + 16 * s + 8 * h); }
        const int n0 = 32 * nb0 + r, n1 = n0 + 32;
        const float bias0 = n0 < 64 ? p->in[17][l * 512 + hb * 64 + n0] : p->in[19][l * 512 + hb * 64 + n0 - 64];
        const float bias1 = n1 < 64 ? p->in[17][l * 512 + hb * 64 + n1] : p->in[19][l * 512 + hb * 64 + n1 - 64];
#pragma unroll
        for (int s = 0; s < 4; ++s) {
            const bf16x8 a = *(const LAS bf16x8*)(XCB + (32 * tb + r) * 72 + 16 * s + 8 * h);
            a0 = MFMA32(a, bw0[s], a0); a1 = MFMA32(a, bw1[s], a1);
        }
        __syncthreads();
#pragma unroll
        for (int i = 0; i < 16; ++i) { const int t = 32 * tb + crow(i, h); GATE[t * 128 + n0] = fsigmoid(a0[i] + bias0); GATE[t * 128 + n1] = fsigmoid(a1[i] + bias1); }
        if (apply && !smp) {
#pragma unroll
            for (int k = 0; k < 4; ++k) { const int s2 = sub + 8 * k; AGP[s2 * 128 + c] = agr[k][0]; AGP[s2 * 128 + 64 + c] = agr[k][1]; }
        }
    }
    __syncthreads();
    float av[16], bv[16];
    {
        const float lam = p->in[20][l * 512 + ch];
        const float sp = log1pf(__expf(-lam));
        float P = 1.f, S = 0.f;
#pragma unroll
        for (int k = 0; k < 16; ++k) { const int t = sub * 16 + k;
            float a = 1.f, bb = 0.f;
            if (t < ntok) { const float rg = GATE[t * 128 + c], ig = GATE[t * 128 + 64 + c], x = XC[t * 64 + c];
                const float la = -8.f * rg * sp; a = __expf(la); bb = sqrtf(fmaxf(-expm1f(2.f * la), 0.f)) * (ig * x); }
            av[k] = a; bv[k] = bb; S = a * S + bb; P *= a; }
        AGL[sub * 64 + c] = P; AGL[512 + sub * 64 + c] = S;
    }
    __syncthreads();
    if (!apply) {
        if (sub == 0 && !smp) { float A = 1.f, B = 0.f;
#pragma unroll
            for (int s2 = 0; s2 < 8; ++s2) { const float P = AGL[s2 * 64 + c], S = AGL[512 + s2 * 64 + c]; B = P * B + S; A *= P; }
            float* o = AGG + (size_t)((bg * 8 + hb) * 32 + seg) * 128; o[c] = A; o[64 + c] = B; }
    } else {
        float hcar;
        if (smp) hcar = p->in[7][(size_t)(l * 8 + sb) * 512 + ch];
        else { hcar = 0.f; for (int s2 = 0; s2 < seg; ++s2) hcar = AGP[s2 * 128 + c] * hcar + AGP[s2 * 128 + 64 + c]; }
        for (int s2 = 0; s2 < sub; ++s2) hcar = AGL[s2 * 64 + c] * hcar + AGL[512 + s2 * 64 + c];
#pragma unroll
        for (int k = 0; k < 16; ++k) { const int t = sub * 16 + k;
            hcar = av[k] * hcar + bv[k];
            if (t < ntok) { GZ[t * 64 + c] = f2bf(hcar * bf2f(GZ[t * 64 + c]));
                if (!dump) { if (smp) { if (t == 15) p->out[O_SH + (size_t)(l * 8 + sb) * 512 + ch] = hcar; }
                else if (seg == 31 && t == 127) p->out[O_PH + (size_t)(l * 4 + bg) * 512 + ch] = hcar; } } }
        __syncthreads();
        for (int q = tid; q < 128 * 8; q += 512) { const int rr = q >> 3, cc = (q & 7) * 8;
            if (rr < ntok) { bf16_t* dst = dump ? (bf16_t*)(p->ws + WS_NEED) + cc : Z + (size_t)(row0 + rr) * ZW + C_BG + hb * 64 + cc; *(u32x4*)dst = *(const LAS u32x4*)(GZ + rr * 64 + cc); } }
    }
}

struct AttnItem {
    const bf16_t* Q; int ldq, qcol, qrow0, nq;
    const bf16_t* Kn; int ldkn, kncol; const bf16_t* Kr; int krow0;
    const bf16_t* VT; int ldvt, vtrow0, vcol0;
    int nkeys, ntmax, tbase, causal;
    float scale;
    bf16_t* O; int ldo, ocol, gate;
};
template <bool ROPE>
DI void attn_item(const AttnItem& it, LAS unsigned char* lds, int tid) {
    constexpr int NK = ROPE ? 6 : 4;
    const int w = tid >> 6, lane = tid & 63, r = lane & 31, h = lane >> 5;
    LAS bf16_t* Kl = (LAS bf16_t*)lds; LAS bf16_t* VTl = (LAS bf16_t*)(lds + 64 * 104 * 2);
    const int qi = 32 * w + r; const bool qvalid = qi < it.nq; const int qrow = it.qrow0 + (qvalid ? qi : 0);
    const int mytiles = (32 * w >= it.nq) ? 0 : (it.causal ? it.tbase + (w >> 1) + 1 : it.ntmax);
    bf16x8 qf[NK];
#pragma unroll
    for (int ks = 0; ks < NK; ++ks) qf[ks] = *(const bf16x8*)(it.Q + (size_t)qrow * it.ldq + it.qcol + 16 * ks + 8 * h);
    f32x16 o0, o1;
#pragma unroll
    for (int i = 0; i < 16; ++i) { o0[i] = 0.f; o1[i] = 0.f; }
    float mrun = -1e30f, lsum = 0.f;
    const float sc = it.scale;
    const int lk = tid >> 3, lc = tid & 7, rk = tid >> 2, rc = tid & 3;
    u32x4 kreg, rreg = {0u, 0u, 0u, 0u}, vreg;
    kreg = *(const u32x4*)(it.Kn + (size_t)(it.krow0 + lk) * it.ldkn + it.kncol + lc * 8);
    if (ROPE && tid < 256) rreg = *(const u32x4*)(it.Kr + (size_t)(it.krow0 + rk) * 32 + rc * 8);
    vreg = *(const u32x4*)(it.VT + (size_t)(it.vtrow0 + lk) * it.ldvt + it.vcol0 + lc * 8);
    for (int kt = 0; kt < it.ntmax; ++kt) {
        __syncthreads();
        *(LAS u32x4*)(Kl + lk * 104 + lc * 8) = kreg;
        if (ROPE && tid < 256) *(LAS u32x4*)(Kl + rk * 104 + 64 + rc * 8) = rreg;
        *(LAS u32x4*)(VTl + lk * 72 + lc * 8) = vreg;
        __syncthreads();
        if (kt + 1 < it.ntmax) {
            const int k0 = (kt + 1) * 64;
            kreg = *(const u32x4*)(it.Kn + (size_t)(it.krow0 + k0 + lk) * it.ldkn + it.kncol + lc * 8);
            if (ROPE && tid < 256) rreg = *(const u32x4*)(it.Kr + (size_t)(it.krow0 + k0 + rk) * 32 + rc * 8);
            vreg = *(const u32x4*)(it.VT + (size_t)(it.vtrow0 + lk) * it.ldvt + it.vcol0 + k0 + lc * 8);
        }
        if (kt < mytiles) {
            f32x16 s0, s1;
#pragma unroll
            for (int i = 0; i < 16; ++i) { s0[i] = 0.f; s1[i] = 0.f; }
#pragma unroll
            for (int ks = 0; ks < NK; ++ks) {
                const bf16x8 ka0 = *(const LAS bf16x8*)(Kl + r * 104 + 16 * ks + 8 * h), ka1 = *(const LAS bf16x8*)(Kl + (32 + r) * 104 + 16 * ks + 8 * h);
                s0 = MFMA32(ka0, qf[ks], s0); s1 = MFMA32(ka1, qf[ks], s1);
            }
            if ((kt + 1) * 64 > it.nkeys) {
#pragma unroll
                for (int i = 0; i < 16; ++i) { const int key = kt * 64 + crow(i, h); if (key >= it.nkeys) s0[i] = -1e30f; if (key + 32 >= it.nkeys) s1[i] = -1e30f; }
            }
            float mx = s0[0];
#pragma unroll
            for (int i = 1; i < 16; ++i) mx = fmaxf(mx, s0[i]);
#pragma unroll
            for (int i = 0; i < 16; ++i) mx = fmaxf(mx, s1[i]);
            mx = fmaxf(mx, __shfl_xor(mx, 32));
            const float mnew = fmaxf(mrun, mx);
            const float alpha = __builtin_amdgcn_exp2f((mrun - mnew) * sc);
            mrun = mnew;
            const float mc = mnew * sc;
            float ps = 0.f;
#pragma unroll
            for (int i = 0; i < 16; ++i) { s0[i] = __builtin_amdgcn_exp2f(s0[i] * sc - mc); s1[i] = __builtin_amdgcn_exp2f(s1[i] * sc - mc); ps += s0[i] + s1[i]; }
            lsum = lsum * alpha + ps;
#pragma unroll
            for (int i = 0; i < 16; ++i) { o0[i] *= alpha; o1[i] *= alpha; }
#pragma unroll
            for (int kk = 0; kk < 4; ++kk) {
                const int s8 = (kk & 1) * 8;
                u32x4 pw;
                if (kk < 2) { pw.x = cvt_pk(s0[s8], s0[s8 + 1]); pw.y = cvt_pk(s0[s8 + 2], s0[s8 + 3]); pw.z = cvt_pk(s0[s8 + 4], s0[s8 + 5]); pw.w = cvt_pk(s0[s8 + 6], s0[s8 + 7]); }
                else { pw.x = cvt_pk(s1[s8], s1[s8 + 1]); pw.y = cvt_pk(s1[s8 + 2], s1[s8 + 3]); pw.z = cvt_pk(s1[s8 + 4], s1[s8 + 5]); pw.w = cvt_pk(s1[s8 + 6], s1[s8 + 7]); }
                const bf16x8 pf = __builtin_bit_cast(bf16x8, pw);
                const s16x4 a0l = *(const LAS s16x4*)(VTl + r * 72 + 16 * kk + 4 * h), a0h = *(const LAS s16x4*)(VTl + r * 72 + 16 * kk + 8 + 4 * h);
                const s16x4 a1l = *(const LAS s16x4*)(VTl + (32 + r) * 72 + 16 * kk + 4 * h), a1h = *(const LAS s16x4*)(VTl + (32 + r) * 72 + 16 * kk + 8 + 4 * h);
                const bf16x8 va0 = __builtin_shufflevector(a0l, a0h, 0, 1, 2, 3, 4, 5, 6, 7), va1 = __builtin_shufflevector(a1l, a1h, 0, 1, 2, 3, 4, 5, 6, 7);
                o0 = MFMA32(va0, pf, o0); o1 = MFMA32(va1, pf, o1);
            }
        }
    }
    const float ltot = lsum + __shfl_xor(lsum, 32);
    if (qvalid && mytiles > 0) {
        const float inv = 1.f / ltot;
        bf16_t* orow = it.O + (size_t)qrow * it.ldo + it.ocol;
#pragma unroll
        for (int db = 0; db < 2; ++db)
#pragma unroll
            for (int g4 = 0; g4 < 4; ++g4) {
                const int dv0 = 32 * db + 8 * g4 + 4 * h;
                float v[4];
#pragma unroll
                for (int j = 0; j < 4; ++j) v[j] = (db ? o1[4 * g4 + j] : o0[4 * g4 + j]) * inv;
                u32x2* dst = (u32x2*)(orow + dv0);
                if (it.gate) { const u32x2 gw = *dst; v[0] *= bflo(gw.x); v[1] *= bfhi(gw.x); v[2] *= bflo(gw.y); v[3] *= bfhi(gw.y); }
                u32x2 ow; ow.x = cvt_pk(v[0], v[1]); ow.y = cvt_pk(v[2], v[3]);
                *dst = ow;
            }
    }
}

#define XB_TMO      128
#define XB_XCNT(j)  (256  + 64 * (j))
#define XB_XSUB(j)  (1280 + 64 * (j))
#define XB_XGEN(j)  (2304 + 64 * (j))
#define XB_TOP      3328
#define XB_TOPGEN   3392
#define XCD_BAR_WORDS 3456
#define XB_SPIN_CAP (1u << 18)
DI unsigned xb_ld(unsigned* p)              { return __hip_atomic_load(p, __ATOMIC_RELAXED, __HIP_MEMORY_SCOPE_AGENT); }
DI unsigned xb_add(unsigned* p, unsigned v) { return __hip_atomic_fetch_add(p, v, __ATOMIC_RELAXED, __HIP_MEMORY_SCOPE_AGENT); }
DI unsigned xb_xcc_id() { return (unsigned)__builtin_amdgcn_s_getreg((3 << 11) | 20) & 0xFu; }
#define XB_SPIN(cond, bar) do { unsigned _sp = 0; while (cond) { __builtin_amdgcn_s_sleep(1); \
    if ((++_sp & 255u) == 0u) { if (xb_ld(&(bar)[XB_TMO])) break; if (_sp > XB_SPIN_CAP) { atomicAdd(&(bar)[XB_TMO], 1u); break; } } } } while (0)
struct XcdBarrier { unsigned* bar; unsigned x; volatile LAS unsigned* st; };
DI XcdBarrier xcd_barrier_post(unsigned* bar, volatile LAS unsigned* st) {
    XcdBarrier b; b.bar = bar; b.x = xb_xcc_id(); b.st = st;
    if (threadIdx.x == 0) (void)xb_add(&bar[XB_XCNT(b.x)], 1u);
    return b;
}
DI void xcd_barrier_complete(unsigned* bar, unsigned x, unsigned& nloc, unsigned& nx) {
    const unsigned G = gridDim.x * gridDim.y * gridDim.z;
    unsigned sum, cnt, mine, sp = 0u;
    for (;;) {
        sum = 0u; cnt = 0u; mine = 0u;
#pragma unroll
        for (unsigned j = 0; j < 16; ++j) { const unsigned c = xb_ld(&bar[XB_XCNT(j)]); sum += c; cnt += (c > 0u) ? 1u : 0u; mine = (j == x) ? c : mine; }
        if (sum == G) break;
        __builtin_amdgcn_s_sleep(1);
        if ((++sp & 255u) == 0u) { if (xb_ld(&bar[XB_TMO])) break; if (sp > XB_SPIN_CAP) { atomicAdd(&bar[XB_TMO], 1u); break; } }
    }
    nloc = mine > 0u ? mine : 1u; nx = cnt > 0u ? cnt : 1u;
}
DI void xcd_barrier(const XcdBarrier& b) {
    asm volatile("s_waitcnt vmcnt(0)" ::: "memory");
    __syncthreads();
    if (threadIdx.x == 0) {
        unsigned* bar = b.bar;
        __builtin_amdgcn_s_waitcnt(0);
        unsigned nloc = b.st[0], nx = b.st[1];
        if (nloc == 0u) { xcd_barrier_complete(bar, b.x, nloc, nx); b.st[0] = nloc; b.st[1] = nx; }
        const unsigned old = xb_add(&bar[XB_XSUB(b.x)], 1u);
        const unsigned gen = old / nloc;
        if (old + 1u == (gen + 1u) * nloc) {
            __builtin_amdgcn_fence(__ATOMIC_RELEASE, "agent");
            asm volatile("s_waitcnt vmcnt(0)" ::: "memory");
            const unsigned og = xb_add(&bar[XB_TOP], 1u);
            const unsigned tg = og / nx;
            if (og + 1u == (tg + 1u) * nx) xb_add(&bar[XB_TOPGEN], 1u);
            else XB_SPIN(xb_ld(&bar[XB_TOPGEN]) == tg, bar);
            __builtin_amdgcn_fence(__ATOMIC_ACQUIRE, "agent");
            xb_add(&bar[XB_XGEN(b.x)], 1u);
            asm volatile("s_waitcnt vmcnt(0)" ::: "memory");
        } else {
            XB_SPIN(xb_ld(&bar[XB_XGEN(b.x)]) == gen, bar);
            __builtin_amdgcn_fence(__ATOMIC_ACQUIRE, "agent");
            asm volatile("s_waitcnt vmcnt(0)" ::: "memory");
        }
    }
    __syncthreads();
}

__global__ void __launch_bounds__(512, 2) mega(Params pk) {
    extern __shared__ __attribute__((aligned(16))) unsigned char shm[];
    LAS unsigned char* lds = (LAS unsigned char*)shm;
    cg::grid_group grid = cg::this_grid();
    __shared__ uint4 xb_words;
    if (threadIdx.x == 0) xb_words = make_uint4(0u, 0u, 0u, 0u);
    __syncthreads();
    XcdBarrier xb = xcd_barrier_post((unsigned*)(((KP)__builtin_amdgcn_kernarg_segment_ptr())->ws + OFF_BAR), (volatile LAS unsigned*)&xb_words);
    { KP p = (KP)__builtin_amdgcn_kernarg_segment_ptr(); int tid0 = threadIdx.x; asm volatile("" : "+v"(tid0)); prep_phase(p, lds, tid0); if (PROBE & 64) { grid.sync(); prep_phase(p, lds, tid0); } }
    grid.sync();
    if (PROBE & 256) { for (int k = 0; k < 20; ++k) xcd_barrier(xb); }
    for (int step = 0; step < 14; ++step) {
        const int l = step / 7, ph = step % 7;
        KP p = (KP)__builtin_amdgcn_kernarg_segment_ptr(); asm volatile("" : "+s"(p));
        int tid = threadIdx.x; asm volatile("" : "+v"(tid));
        int wg = blockIdx.x, G = gridDim.x; asm volatile("" : "+s"(wg), "+s"(G));
        unsigned char* ws = p->ws; unsigned char* dob = (unsigned char*)p->out;
        const int gph = ph == 0 ? 0 : ph == 2 ? 1 : ph == 4 ? 2 : ph == 5 ? 3 : -1;
        if (gph >= 0) {
            const int ndup = ((PROBE & 1) && gph == 0) || ((PROBE & 2) && gph == 1) || ((PROBE & 4) && gph == 2) || ((PROBE & 128) && gph == 3) ? 2 : 1;
#pragma unroll 1
            for (int rep = 0; rep < ndup; ++rep) { gemm_stream(p, gph, l, lds, tid, wg, G, rep + 1 < ndup); if (rep + 1 < ndup) xcd_barrier(xb); }
            sample_gemm_phase(p, gph, l, lds, tid, wg, G);
        }
        if (ph == 1) { if (PROBE & 512) { rows_phase(p, l, tid, true); xcd_barrier(xb); } rows_phase(p, l, tid); }
        else if (ph == 2) {
            __syncthreads();
            for (int t = wg; t < 512 + 32; t += G) {
                if (t < 512) { if (PROBE & 32) gmlp_tile(p, l, t >> 7, (t >> 2) & 31, t & 3, lds, tid, true); gmlp_tile(p, l, t >> 7, (t >> 2) & 31, t & 3, lds, tid); }
                else { const int s = t - 512; gmlp_sample(p, l, s >> 2, s & 3, tid); }
            }
            for (int t = wg; t < 256 + 32; t += G) {
                AttnItem it;
                it.Q = (const bf16_t*)(ws + OFF_Z); it.ldq = ZW; it.Kr = nullptr; it.scale = 0.125f * 1.44269504089f;
                it.O = (bf16_t*)(ws + OFF_Z); it.ldo = ZW; it.gate = 0; it.nkeys = 256; it.ntmax = 4; it.tbase = 0; it.causal = 0; it.krow0 = 0; it.vcol0 = 0;
                if (t < 256) { const int b = t >> 6, hh = (t >> 4) & 3, qb = t & 15;
                    it.qcol = C_MQ + hh * 64; it.qrow0 = b * 4096 + qb * 256; it.nq = 256;
                    it.Kn = (const bf16_t*)(ws + OFF_MK) + (size_t)b * 256 * 256; it.ldkn = 256; it.kncol = hh * 64;
                    it.VT = (const bf16_t*)(ws + OFF_MVT); it.ldvt = 1024; it.vtrow0 = hh * 64; it.vcol0 = b * 256; }
                else { const int s = t - 256, b = s >> 2, hh = s & 3;
                    it.qcol = C_MQ + hh * 64; it.qrow0 = TP + b * 16; it.nq = 16;
                    it.Kn = (const bf16_t*)(ws + OFF_MKS) + (size_t)(l * 8 + b) * 65536; it.ldkn = 256; it.kncol = hh * 64;
                    it.VT = (const bf16_t*)(ws + OFF_MVTS) + (size_t)(l * 8 + b) * 65536; it.ldvt = 256; it.vtrow0 = hh * 64; }
                it.ocol = it.qcol;
                if (PROBE & 32) { AttnItem d = it; d.O = (bf16_t*)(ws + WS_NEED); d.ldo = 64; d.ocol = 0; attn_item<false>(d, lds, tid); }
                attn_item<false>(it, lds, tid);
            }
            for (int t = wg; t < 1024; t += G) { if (PROBE & 8) lru_tile(p, l, t >> 8, (t >> 5) & 7, t & 31, false, lds, tid); lru_tile(p, l, t >> 8, (t >> 5) & 7, t & 31, false, lds, tid); }
        } else if (ph == 3) {
            for (int t = wg; t < 256 + 64; t += G) {
                AttnItem it;
                it.Q = (const bf16_t*)(dob + DO_Q); it.ldq = 768; it.Kn = (const bf16_t*)(dob + DO_KN); it.ldkn = 512; it.Kr = (const bf16_t*)(dob + DO_KR);
                it.VT = (const bf16_t*)(ws + OFF_VT); it.ldvt = KVROWS; it.scale = 0.10206207262f * 1.44269504089f;
                it.O = (bf16_t*)(ws + OFF_Z); it.ldo = ZW; it.gate = 1;
                if (t < 256) { const int b = t >> 6, hh = (t >> 3) & 7, x = t & 7;
                    it.qcol = hh * 96; it.kncol = hh * 64; it.krow0 = b * 4096; it.vtrow0 = hh * 64; it.vcol0 = b * 4096; it.ocol = C_CG + hh * 64; it.nq = 256; it.nkeys = 4096; it.causal = 1;
#pragma unroll 1
                    for (int half = 0; half < 2; ++half) { const int qb = half ? 15 - x : x;
                        it.qrow0 = b * 4096 + qb * 256; it.tbase = 4 * qb; it.ntmax = 4 * qb + 4;
                        if (PROBE & 16) { AttnItem d = it; d.O = (bf16_t*)(ws + WS_NEED); d.ldo = 64; d.ocol = 0; d.gate = 0; attn_item<true>(d, lds, tid); }
                        attn_item<true>(it, lds, tid); } }
                else { const int s = t - 256, b = s >> 3, hh = s & 7;
                    it.qcol = hh * 96; it.kncol = hh * 64; it.krow0 = TP + b * SKEYS; it.vtrow0 = hh * 64; it.vcol0 = TP + b * SKEYS; it.ocol = C_CG + hh * 64;
                    it.qrow0 = TP + b * 16; it.nq = 16; it.nkeys = SKEYS; it.causal = 0; it.tbase = 0; it.ntmax = 17;
                    if (PROBE & 16) { AttnItem d = it; d.O = (bf16_t*)(ws + WS_NEED); d.ldo = 64; d.ocol = 0; d.gate = 0; attn_item<true>(d, lds, tid); }
                    attn_item<true>(it, lds, tid); }
            }
            for (int t = wg; t < 1024 + 64; t += G) {
                if (t < 1024) { if (PROBE & 8) lru_tile(p, l, t >> 8, (t >> 5) & 7, t & 31, true, lds, tid, true); lru_tile(p, l, t >> 8, (t >> 5) & 7, t & 31, true, lds, tid); }
                else { const int s = t - 1024; lru_tile(p, l, 4 + (s >> 3), s & 7, 0, true, lds, tid); }
            }
        } else if (ph == 6) { if ((PROBE & 1024) && l == 0) { ln_phase(p, l, tid); xcd_barrier(xb); } ln_phase(p, l, tid); }
        if (step < 13) xcd_barrier(xb);
    }
}

extern "C" void kernel_launch(void* const* d_in, const int* in_sizes, int n_in, void* d_out, int out_size, void* d_ws, size_t ws_size, hipStream_t stream) {
    constexpr size_t kDynLds = 147456;
    static int grid_blocks = 0;
    if (!grid_blocks) {
        int dev = 0, cus = 0, per_cu = 0;
        (void)hipGetDevice(&dev);
        (void)hipDeviceGetAttribute(&cus, hipDeviceAttributeMultiprocessorCount, dev);
        (void)hipFuncSetAttribute((const void*)mega, hipFuncAttributeMaxDynamicSharedMemorySize, (int)kDynLds);
        (void)hipOccupancyMaxActiveBlocksPerMultiprocessor(&per_cu, mega, 512, kDynLds);
        if (per_cu > 1) per_cu = 1;
        grid_blocks = cus * per_cu;
        if (grid_blocks > 256) grid_blocks = 256;
    }
    if (ws_size < WS_NEED) { fprintf(stderr, "workspace too small: %zu < %zu\n", ws_size, (size_t)WS_NEED); return; }
    Params p{};
    for (int i = 0; i < 31; ++i) p.in[i] = (const float*)d_in[i];
    p.out = (float*)d_out; p.ws = (unsigned char*)d_ws;
    (void)hipMemsetAsync((unsigned char*)d_ws + OFF_BAR, 0, 16384, stream);
    void* args[] = {&p};
    hipError_t e = hipLaunchCooperativeKernel((void*)mega, dim3(grid_blocks), dim3(512), args, kDynLds, stream);
    if (e != hipSuccess) fprintf(stderr, "cooperative launch failed: %s (grid %d)\n", hipGetErrorString(e), grid_blocks);
}
```

```cpp
#include <hip/hip_runtime.h>
#include <hip/hip_cooperative_groups.h>
#include <cstdio>
namespace cg = cooperative_groups;

#define LAS __attribute__((address_space(3)))
#define DI __device__ __forceinline__
typedef unsigned short bf16_t;
typedef short bf16x8 __attribute__((ext_vector_type(8)));
typedef short s16x4 __attribute__((ext_vector_type(4)));
typedef float f32x2 __attribute__((ext_vector_type(2)));
typedef float f32x4 __attribute__((ext_vector_type(4)));
typedef float f32x16 __attribute__((ext_vector_type(16)));
typedef unsigned u32x2 __attribute__((ext_vector_type(2)));
typedef unsigned u32x4 __attribute__((ext_vector_type(4)));
typedef __bf16 bf16v2 __attribute__((ext_vector_type(2)));

#ifndef TSA
#define TSA -1
#define TSB -1
#endif
#ifndef PROBE
#define PROBE 0
#endif
constexpr int TP = 16384, NROW = 16512, MROWS = 16640;
constexpr int ZW = 3840;
constexpr int C_AU = 0, C_AV = 512, C_AG = 1024, C_BX = 1536, C_BG = 2048, C_CQ = 2560, C_CKV = 2816, C_CKR = 2944, C_CG = 2976, C_MQ = 3488;
constexpr int KVROWS = 24832, SKEYS = 1040;
constexpr float LN_EPS = 1e-6f;
constexpr float ALPHA_RES = 1.41421356237f;

constexpr size_t SZ_WIN = (size_t)7936 * 1024 * 2, SZ_WUQ = 768 * 256 * 2, SZ_WUK = 512 * 128 * 2, SZ_WBR = (size_t)1024 * 1792 * 2, SZ_WOUT = 1024 * 1024 * 2,
                 SZ_MEMW = 512 * 1024 * 2, SZ_WRI = 8 * 128 * 64 * 2, SZ_GWS = 4 * 128 * 128 * 2;
constexpr size_t OFF_WIN = 0;
constexpr size_t OFF_WUQ = OFF_WIN + 2 * SZ_WIN;
constexpr size_t OFF_WUK = OFF_WUQ + 2 * SZ_WUQ;
constexpr size_t OFF_WUV = OFF_WUK + 2 * SZ_WUK;
constexpr size_t OFF_WBR = OFF_WUV + 2 * SZ_WUK;
constexpr size_t OFF_WOUT = OFF_WBR + 2 * SZ_WBR;
constexpr size_t OFF_MEMW = OFF_WOUT + 2 * SZ_WOUT;
constexpr size_t OFF_WRI = OFF_MEMW + 2 * SZ_MEMW;
constexpr size_t OFF_GWS = OFF_WRI + 2 * SZ_WRI;
constexpr size_t OFF_XB = OFF_GWS + 2 * SZ_GWS;
constexpr size_t OFF_MEMB = OFF_XB + (size_t)MROWS * 1024 * 2;
constexpr size_t OFF_MK = OFF_MEMB + (size_t)1024 * 1024 * 2;
constexpr size_t OFF_MVT = OFF_MK + 1024 * 256 * 2;
constexpr size_t OFF_MKS = OFF_MVT + 256 * 1024 * 2;
constexpr size_t OFF_MVTS = OFF_MKS + (size_t)2 * 2048 * 256 * 2;
constexpr size_t OFF_Z = OFF_MVTS + (size_t)2 * 2048 * 256 * 2;
constexpr size_t OFF_VT = OFF_Z + (size_t)MROWS * ZW * 2;
constexpr size_t OFF_MERGED = OFF_VT;
constexpr size_t OFF_STATS = OFF_VT + (size_t)MROWS * 1024 * 2;
constexpr size_t OFF_AGG = OFF_STATS + (size_t)2 * MROWS * 64 * 4;
constexpr size_t OFF_BAR = OFF_AGG + (size_t)1024 * 128 * 4;
constexpr size_t OFF_MS = OFF_BAR + 16384;
constexpr size_t OFF_TS = OFF_MS + (size_t)128 * 1024 * 4;
constexpr size_t WS_NEED = OFF_TS + 1024;
static_assert(WS_NEED <= (size_t)256 * 1024 * 1024, "workspace over 256 MiB");
constexpr size_t DO_Q = 0;
constexpr size_t DO_CKV = DO_Q + (size_t)MROWS * 768 * 2;
constexpr size_t DO_KR = DO_CKV + (size_t)KVROWS * 128 * 2;
constexpr size_t DO_KN = DO_KR + (size_t)KVROWS * 32 * 2;
constexpr size_t DO_END = DO_KN + (size_t)KVROWS * 512 * 2;
constexpr size_t DO_GSCR = 0;
static_assert(DO_END <= (size_t)NROW * 4096, "scratch in d_out too large");
static_assert((size_t)256 * 4 * 16 * 512 * 8 <= (size_t)NROW * 4096, "gscr too large");
constexpr size_t O_YS = 16777216, O_PCKV = 16908288, O_PKR = 21102592, O_PMK = 22151168, O_PMV = 22675456, O_PH = 23199744, O_PCONV = 23203840,
                 O_SCKV = 23216128, O_SKR = 23248896, O_SH = 23257088, O_SCONV = 23265280, O_SGV = 23289856;

struct Params {
    const float* in[31];
    float* out;
    unsigned char* ws;
};
typedef const __attribute__((address_space(4))) Params* KP;

DI float bf2f(unsigned short b) { return __uint_as_float(((unsigned)b) << 16); }
DI float bflo(unsigned w) { return __uint_as_float(w << 16); }
DI float bfhi(unsigned w) { return __uint_as_float(w & 0xffff0000u); }
DI unsigned cvt_pk(float lo, float hi) { f32x2 v = {lo, hi}; return __builtin_bit_cast(unsigned, __builtin_convertvector(v, bf16v2)); }
DI unsigned short f2bf(float x) { return (unsigned short)(cvt_pk(x, x) & 0xffffu); }
DI u32x4 pack8(f32x4 a, f32x4 b) { u32x4 w; w.x = cvt_pk(a[0], a[1]); w.y = cvt_pk(a[2], a[3]); w.z = cvt_pk(b[0], b[1]); w.w = cvt_pk(b[2], b[3]); return w; }
DI void unpack8(u32x4 w, float* f) { f[0] = bflo(w.x); f[1] = bfhi(w.x); f[2] = bflo(w.y); f[3] = bfhi(w.y); f[4] = bflo(w.z); f[5] = bfhi(w.z); f[6] = bflo(w.w); f[7] = bfhi(w.w); }
DI float fsigmoid(float x) { return __builtin_amdgcn_rcpf(1.f + __expf(-x)); }
DI float fsilu(float x) { return x * fsigmoid(x); }
DI float fgelu(float x) { return x * fsigmoid(1.5957691216f * (x + 0.044715f * x * x * x)); }
DI float wave_sum(float v) {
#pragma unroll
    for (int o = 32; o >= 1; o >>= 1) v += __shfl_xor(v, o);
    return v;
}
DI float max3f(float a, float b, float c) { float r; asm("v_max3_f32 %0, %1, %2, %3" : "=v"(r) : "v"(a), "v"(b), "v"(c)); return r; }
DI float xhalf_max(float x) { const auto r = __builtin_amdgcn_permlane32_swap(__float_as_uint(x), __float_as_uint(x), false, false); return max3f(x, __uint_as_float(r[0]), __uint_as_float(r[1])); }
DI int crow(int reg, int h) { return (reg & 3) + 8 * (reg >> 2) + 4 * h; }
#define MFMA32(a, b, c) __builtin_amdgcn_mfma_f32_32x32x16_bf16((a), (b), (c), 0, 0, 0)

constexpr int HTB = 128 * 64 * 2;
DI int lds_byte(int r, int c) { const int st = (r >> 4) * 2 + (c >> 5), rr = r & 15, cc = c & 31, ob = rr * 64 + cc * 2; return st * 1024 + (ob ^ (((ob >> 9) & 1) << 5)); }
DI void stage_rc(int b, int& R, int& C) { const int st = b / 1024, sb = b % 1024, swz = sb ^ (((sb >> 9) & 1) << 5); R = (st >> 1) * 16 + swz / 64; C = (st & 1) * 32 + (swz % 64) / 2; }
DI int perm32(int rho) { const int n = rho >> 4, i = rho & 15; return 8 * (i >> 2) + 4 * n + (i & 3); }

enum { K_Z = 0, K_MEMKV = 1, K_PLAIN = 2, K_QP = 3, K_EG = 4, K_EY = 5, K_F = 6 };
struct GU {
    const char* A; const char* B;
    int lda, ldb;
    int nt;
    int kind, pm, pn, aux;
    bf16_t* C; int ldc;
};

DI bool next_unit(KP p, int gph, int l, int i, GU& u, int wg, int G) {
    unsigned char* ws = p->ws; unsigned char* dob = (unsigned char*)p->out;
    u.aux = 0; u.C = nullptr; u.ldc = 0;
    const bool xm = (G == 256);
    const int x = wg & 7, j = wg >> 3;
    if (gph == 0) {
        int e = -1;
        if (xm) { const int uu = j + 32 * i;
            if (uu < 120) { u.pm = 8 * x + (uu & 7); u.pn = uu >> 3; }
            else { if (j >= 24 && i == 3) e = (j - 24) * 8 + x; if (e < 0 || e >= 12) return false; } }
        else { const int L = i * G + wg; if (L < 960) { u.pm = L & 63; u.pn = L >> 6; } else { e = L - 960; if (e >= 12) return false; } }
        if (e < 0) { u.A = (const char*)(ws + OFF_XB) + (size_t)u.pm * 256 * 2048; u.B = (const char*)(ws + OFF_WIN + l * SZ_WIN) + (size_t)u.pn * 256 * 2048;
            u.lda = 2048; u.ldb = 2048; u.nt = 16; u.kind = K_Z; return true; }
        if (e < 8) { u.pm = e & 3; u.pn = e >> 2; u.A = (const char*)(ws + OFF_MEMB) + (size_t)u.pm * 256 * 2048; u.B = (const char*)(ws + OFF_MEMW + l * SZ_MEMW) + (size_t)u.pn * 256 * 2048;
            u.lda = 2048; u.ldb = 2048; u.nt = 16; u.kind = K_MEMKV; return true; }
        u.pm = 0; u.pn = e - 8; u.A = (const char*)(ws + OFF_MEMW + l * SZ_MEMW) + (size_t)256 * 2048; u.B = (const char*)(ws + OFF_MEMB) + (size_t)u.pn * 256 * 2048;
        u.lda = 2048; u.ldb = 2048; u.nt = 16; u.kind = K_PLAIN; u.C = (bf16_t*)(ws + OFF_MVT); u.ldc = 1024; return true;
    } else if (gph == 1) {
        int v;
        if (xm) { if (i == 0 && j < 24) { v = -1; u.pm = 8 * x + (j & 7); u.pn = j >> 3; } else v = ((j + 8) & 31) * 8 + x + 256 * (j < 24 ? i - 1 : i); }
        else { const int L = i * G + wg; if (L < 192) { v = -1; u.pm = L & 63; u.pn = L >> 6; } else v = L - 192; }
        if (v < 0) { u.A = (const char*)(ws + OFF_Z) + (size_t)u.pm * 256 * (ZW * 2) + C_CQ * 2; u.lda = ZW * 2;
            u.B = (const char*)(ws + OFF_WUQ + l * SZ_WUQ) + (size_t)u.pn * 256 * 512; u.ldb = 512; u.nt = 4; u.kind = K_QP; return true; }
        if (v < 194) { u.pm = v % 97; u.pn = v / 97; u.A = (const char*)(dob + DO_CKV) + (size_t)u.pm * 256 * 256; u.lda = 256;
            u.B = (const char*)(ws + OFF_WUK + l * SZ_WUK) + (size_t)u.pn * 256 * 256; u.ldb = 256; u.nt = 2; u.kind = K_PLAIN; u.C = (bf16_t*)(dob + DO_KN); u.ldc = 512; return true; }
        v -= 194;
        if (v < 194) { u.pm = v / 97; u.pn = v % 97; u.A = (const char*)(ws + OFF_WUV + l * SZ_WUK) + (size_t)u.pm * 256 * 256; u.lda = 256;
            u.B = (const char*)(dob + DO_CKV) + (size_t)u.pn * 256 * 256; u.ldb = 256; u.nt = 2; u.kind = K_PLAIN; u.C = (bf16_t*)(ws + OFF_VT); u.ldc = KVROWS; return true; }
        return false;
    } else if (gph == 2) {
        const int rr = i >> 3, sub = i & 7;
        if (xm) { if (rr > 0) return false; u.pm = 8 * x + (j & 7); u.pn = j >> 3; }
        else { const int tt = wg + G * rr; if (tt >= 256) return false; u.pm = tt & 63; u.pn = tt >> 6; }
        const int ib = sub & 3; u.aux = ib;
        if (sub < 4) { u.A = (const char*)(ws + OFF_XB) + (size_t)u.pm * 256 * 2048; u.lda = 2048;
            u.B = (const char*)(ws + OFF_WIN + l * SZ_WIN) + (size_t)(3840 + ib * 1024 + u.pn * 256) * 2048; u.ldb = 2048; u.nt = 16; u.kind = K_EG; }
        else { const int zc = ib == 0 ? C_AU : ib == 1 ? C_BG : ib == 2 ? C_CG : C_MQ;
            u.A = (const char*)(ws + OFF_Z) + (size_t)u.pm * 256 * (ZW * 2) + zc * 2; u.lda = ZW * 2;
            u.B = (const char*)(ws + OFF_WBR + l * SZ_WBR) + (size_t)u.pn * 256 * 3584 + ib * 512 * 2; u.ldb = 3584; u.nt = ib < 3 ? 8 : 4; u.kind = K_EY; }
        return true;
    } else {
        if (xm) { if (i > 0) return false; u.pm = 8 * x + (j & 7); u.pn = j >> 3; }
        else { const int L = i * G + wg; if (L >= 256) return false; u.pm = L & 63; u.pn = L >> 6; }
        u.A = (const char*)(ws + OFF_MERGED) + (size_t)u.pm * 256 * 2048; u.lda = 2048;
        u.B = (const char*)(ws + OFF_WOUT + l * SZ_WOUT) + (size_t)u.pn * 256 * 2048; u.ldb = 2048; u.nt = 16; u.kind = K_F; return true;
    }
}

DI void rope_pair(float& a, float& b, float pos, int jj) {
    const float freq = __builtin_amdgcn_exp2f(-(float)jj * 0.83048202372f);
    const float ang = pos * freq;
    const float rev = __builtin_amdgcn_fractf(ang * 0.15915494309f);
    const float sn = __builtin_amdgcn_sinf(rev), cs = __builtin_amdgcn_cosf(rev);
    const float x1 = a, x2 = b;
    a = x1 * cs - x2 * sn; b = x1 * sn + x2 * cs;
}

DI void epi_z(KP p, int row, int col, f32x4 v0, f32x4 v1) {
    int act = 0;
    if (col < C_AG) act = 1; else if (col < C_BX) act = 2; else if (col < C_BG) act = 0; else if (col < C_CQ) act = 2; else if (col < C_CG) act = 0; else if (col < C_MQ) act = 2;
    if (act == 1) {
#pragma unroll
        for (int j = 0; j < 4; ++j) { v0[j] = fgelu(v0[j]); v1[j] = fgelu(v1[j]); }
    } else if (act == 2) {
#pragma unroll
        for (int j = 0; j < 4; ++j) { v0[j] = fsilu(v0[j]); v1[j] = fsilu(v1[j]); }
    }
    *(u32x4*)((bf16_t*)(p->ws + OFF_Z) + (size_t)row * ZW + col) = pack8(v0, v1);
}
DI void epi_qp(KP p, int row, int col, f32x4 v0, f32x4 v1) {
    const int d = col % 96;
    if (d >= 64) {
        const float pos = row < TP ? (float)(row & 4095) : (float)(1024 + ((row - TP) & 15));
        const int j0 = (d - 64) >> 1;
        float t0 = v0[0], t1 = v0[1], t2 = v0[2], t3 = v0[3], t4 = v1[0], t5 = v1[1], t6 = v1[2], t7 = v1[3];
        rope_pair(t0, t1, pos, j0); rope_pair(t2, t3, pos, j0 + 1); rope_pair(t4, t5, pos, j0 + 2); rope_pair(t6, t7, pos, j0 + 3);
        v0 = (f32x4){t0, t1, t2, t3}; v1 = (f32x4){t4, t5, t6, t7};
    }
    *(u32x4*)((bf16_t*)((unsigned char*)p->out + DO_Q) + (size_t)row * 768 + col) = pack8(v0, v1);
}
DI void epi_f(KP p, int l, int row, int col, f32x4 v0, f32x4 v1, float& s1, float& s2) {
    float x[8];
    { const u32x4 xw = *(const u32x4*)((const bf16_t*)(p->ws + OFF_XB) + (size_t)row * 1024 + col); unpack8(xw, x); }
#pragma unroll
    for (int j = 0; j < 4; ++j) { v0[j] = ALPHA_RES * x[j] + v0[j]; v1[j] = ALPHA_RES * x[4 + j] + v1[j]; s1 += v0[j] + v1[j]; s2 += v0[j] * v0[j] + v1[j] * v1[j]; }
    if (row < NROW) *(u32x4*)((bf16_t*)(p->ws + OFF_Z) + (size_t)row * 1024 + col) = pack8(v0, v1);
}

DI bool gemm_epilogue(KP p, int l, f32x4 (&acc)[2][2][4][2], const GU& u, int tid_in, int wg, bool dumpst) {
    unsigned char* ws = p->ws;
    int tid = tid_in; asm volatile("" : "+v"(tid));
    const int wid = tid >> 6, lane = tid & 63, wr = wid >> 2, wc = wid & 3, fr = lane & 15, fq = lane >> 4;
    const int row0 = u.pm * 256 + wr * 64 + fr, col0 = u.pn * 256 + wc * 32 + 8 * fq;
    if (u.kind == K_EY) {
        const u32x2* gs = (const u32x2*)((unsigned char*)p->out + DO_GSCR) + (((size_t)wg * 4 + u.aux) * 16) * 512 + tid;
#pragma unroll
        for (int ai = 0; ai < 2; ++ai) {
            u32x2 gc[8], gn[8];
#pragma unroll
            for (int v = 0; v < 8; ++v) gc[v] = gs[(ai * 8 + v) * 512];
            if (u.aux < 3) {
#pragma unroll
                for (int v = 0; v < 8; ++v) gn[v] = gs[(16 + ai * 8 + v) * 512];
            } else {
#pragma unroll
                for (int v = 0; v < 8; ++v) gn[v] = (u32x2){0xffffffffu, 0xffffffffu};
            }
#pragma unroll
            for (int m = 0; m < 4; ++m)
#pragma unroll
                for (int bj = 0; bj < 2; ++bj) {
                    const int vec = m * 2 + bj;
                    f32x4 v0 = acc[ai][bj][m][0], v1 = acc[ai][bj][m][1];
#pragma unroll
                    for (int j = 0; j < 4; ++j) {
                        v0[j] *= (float)((gc[vec].x >> (8 * j)) & 0xffu) * __builtin_amdgcn_rcpf((float)((gn[vec].x >> (8 * j)) & 0xffu));
                        v1[j] *= (float)((gc[vec].y >> (8 * j)) & 0xffu) * __builtin_amdgcn_rcpf((float)((gn[vec].y >> (8 * j)) & 0xffu)); }
                    if (u.aux < 3) { acc[ai][bj][m][0] = v0; acc[ai][bj][m][1] = v1; }
                    else *(u32x4*)((bf16_t*)(ws + OFF_MERGED) + (size_t)(row0 + ai * 128 + m * 16) * 1024 + col0 + bj * 128) = pack8(v0, v1);
                }
        }
        return u.aux < 3;
    }
    if (u.kind == K_F) {
        const bf16_t* XB = (const bf16_t*)(ws + OFF_XB);
#pragma unroll
        for (int ai = 0; ai < 2; ++ai) {
            u32x4 xr[8];
#pragma unroll
            for (int m = 0; m < 4; ++m)
#pragma unroll
                for (int bj = 0; bj < 2; ++bj) xr[m * 2 + bj] = __builtin_nontemporal_load((const u32x4*)(XB + (size_t)(row0 + ai * 128 + m * 16) * 1024 + col0 + bj * 128));
#pragma unroll
            for (int m = 0; m < 4; ++m) {
                const int row = row0 + ai * 128 + m * 16;
                float s1 = 0.f, s2 = 0.f;
#pragma unroll
                for (int bj = 0; bj < 2; ++bj) {
                    f32x4 v0 = acc[ai][bj][m][0], v1 = acc[ai][bj][m][1];
                    float x[8]; unpack8(xr[m * 2 + bj], x);
#pragma unroll
                    for (int j = 0; j < 4; ++j) { v0[j] = ALPHA_RES * x[j] + v0[j]; v1[j] = ALPHA_RES * x[4 + j] + v1[j]; s1 += v0[j] + v1[j]; s2 += v0[j] * v0[j] + v1[j] * v1[j]; }
                    *(u32x4*)((bf16_t*)(ws + OFF_Z) + (size_t)row * 1024 + col0 + bj * 128) = pack8(v0, v1);
                }
                s1 += __shfl_xor(s1, 16); s1 += __shfl_xor(s1, 32); s2 += __shfl_xor(s2, 16); s2 += __shfl_xor(s2, 32);
                if (fq == 0) { float* st = dumpst ? (float*)(ws + WS_NEED) + (row & 1023) * 2 : (float*)(ws + OFF_STATS) + (((size_t)l * MROWS + row) * 32 + u.pn * 4 + wc) * 2;
                    *(f32x2*)st = (f32x2){s1, s2}; }
            }
        }
        return false;
    }
#pragma unroll
    for (int ai = 0; ai < 2; ++ai)
#pragma unroll
        for (int m = 0; m < 4; ++m) {
            const int row = row0 + ai * 128 + m * 16;
#pragma unroll
            for (int bj = 0; bj < 2; ++bj) {
                const int col = col0 + bj * 128;
                f32x4 v0 = acc[ai][bj][m][0], v1 = acc[ai][bj][m][1];
                const int vec = (ai * 4 + m) * 2 + bj;
                if (u.kind == K_Z) {
                    epi_z(p, row, col, v0, v1);
                } else if (u.kind == K_MEMKV) {
                    float* o = p->out + (col < 256 ? O_PMK : O_PMV) + (size_t)l * 262144 + (size_t)row * 256 + (col & 255);
                    __builtin_nontemporal_store(v0, (f32x4*)o); __builtin_nontemporal_store(v1, (f32x4*)(o + 4));
                    if (col < 256) *(u32x4*)((bf16_t*)(ws + OFF_MK) + (size_t)row * 256 + col) = pack8(v0, v1);
                } else if (u.kind == K_PLAIN) {
                    *(u32x4*)(u.C + (size_t)row * u.ldc + col) = pack8(v0, v1);
                } else if (u.kind == K_QP) {
                    epi_qp(p, row, col, v0, v1);
                } else {
                    u32x2 w = {0u, 0u};
#pragma unroll
                    for (int j = 0; j < 4; ++j) { w.x = __builtin_amdgcn_cvt_pk_u8_f32(fmaxf(255.f * fsigmoid(v0[j]), 1.f), j, w.x); w.y = __builtin_amdgcn_cvt_pk_u8_f32(fmaxf(255.f * fsigmoid(v1[j]), 1.f), j, w.y); }
                    *((u32x2*)((unsigned char*)p->out + DO_GSCR) + (((size_t)wg * 4 + u.aux) * 16 + vec) * 512 + tid) = w;
                }
            }
        }
    return false;
}

DI void gemm_stream(KP p, int gph, int l, LAS unsigned char* lds, int tid, int wg, int G, bool dumpst = false) {
    const int wid = __builtin_amdgcn_readfirstlane(tid >> 6), lane = tid & 63, wr = wid >> 2, wc = wid & 3, fr = lane & 15, fq = lane >> 4;
    const unsigned ldsw = (unsigned)wid * 1024u;
    const int aoff = lds_byte(wr * 64 + fr, fq * 8), boff = lds_byte(wc * 32 + fr, fq * 8);
#define PG8_SA(b, h) (((b) * 2 + (h)) * HTB)
#define PG8_SB(b, h) ((4 + (b) * 2 + (h)) * HTB)
#define PG8_STAGE(bufoff, gbase, voff) do { const char* _g = (const char*)(gbase); asm volatile("" : "+s"(_g)); _Pragma("unroll") for (int _i = 0; _i < 2; ++_i) \
        __builtin_amdgcn_global_load_lds((const unsigned*)(_g + (voff)[_i]), (LAS unsigned*)(lds + (bufoff) + ldsw + _i * 8192), 16, 0, 0); } while (0)
#define PG8_LDA(dst, b, h) do { _Pragma("unroll") for (int m = 0; m < 4; ++m) _Pragma("unroll") for (int k = 0; k < 2; ++k) dst[m][k] = *(const LAS bf16x8*)(lds + PG8_SA(b, h) + aoff + m * 2048 + k * 1024); } while (0)
#define PG8_LDB(dst, b, h) do { _Pragma("unroll") for (int n = 0; n < 2; ++n) _Pragma("unroll") for (int k = 0; k < 2; ++k) dst[n][k] = *(const LAS bf16x8*)(lds + PG8_SB(b, h) + boff + n * 2048 + k * 1024); } while (0)
#define PG8_MMA(ai, bj, At, Bt) do { __builtin_amdgcn_s_setprio(1); _Pragma("unroll") for (int m = 0; m < 4; ++m) _Pragma("unroll") for (int n = 0; n < 2; ++n) _Pragma("unroll") for (int k = 0; k < 2; ++k) \
        acc[ai][bj][m][n] = __builtin_amdgcn_mfma_f32_16x16x32_bf16(Bt[n][k], At[m][k], acc[ai][bj][m][n], 0, 0, 0); __builtin_amdgcn_s_setprio(0); } while (0)
#define PG8_WAIT_V(n) asm volatile("s_waitcnt vmcnt(" #n ")" ::: "memory")
#define PG8_WAIT_L(n) asm volatile("s_waitcnt lgkmcnt(" #n ")" ::: "memory")
#define PG8_BAR __builtin_amdgcn_s_barrier()
#define PG8_SCHED __builtin_amdgcn_sched_barrier(0)
#define PG8_VOFF(vA, vB, U) do { _Pragma("unroll") for (int _i = 0; _i < 2; ++_i) { int _R, _C; stage_rc(tid * 16 + _i * 8192, _R, _C); const int _Rb = (_R & ~31) + perm32(_R & 31); \
        vA[_i] = (unsigned)(_R * (U).lda + _C * 2); vB[_i] = (unsigned)(_Rb * (U).ldb + _C * 2); } } while (0)
    GU cur, nxt; int ui = 0;
    if (!next_unit(p, gph, l, 0, cur, wg, G)) return;
    f32x4 acc[2][2][4][2];
#pragma unroll
    for (int a = 0; a < 2; ++a)
#pragma unroll
        for (int b = 0; b < 2; ++b)
#pragma unroll
            for (int m = 0; m < 4; ++m)
#pragma unroll
                for (int n = 0; n < 2; ++n) acc[a][b][m][n] = (f32x4){0.f, 0.f, 0.f, 0.f};
    bf16x8 At[4][2], B0[2][2], B1[2][2];
    unsigned cvA[2], cvB[2];
    PG8_VOFF(cvA, cvB, cur);
    const char* cA = cur.A; const char* cB = cur.B;
    size_t chA = (size_t)128 * cur.lda, chB = (size_t)128 * cur.ldb;
    const size_t kstep = 128;
    PG8_STAGE(PG8_SB(0, 0), cB, cvB); PG8_STAGE(PG8_SA(0, 0), cA, cvA); PG8_STAGE(PG8_SB(0, 1), cB + chB, cvB); PG8_STAGE(PG8_SA(0, 1), cA + chA, cvA);
    if (wr == 1) PG8_BAR;
    PG8_WAIT_V(4); PG8_BAR;
    PG8_STAGE(PG8_SB(1, 0), cB + kstep, cvB); PG8_STAGE(PG8_SA(1, 0), cA + kstep, cvA); PG8_STAGE(PG8_SB(1, 1), cB + chB + kstep, cvB);
    PG8_WAIT_V(6); PG8_BAR;
    for (;;) {
        const bool has_next = next_unit(p, gph, l, ui + 1, nxt, wg, G);
        if (!has_next) nxt = cur;
        const char* nA = nxt.A; const char* nB = nxt.B;
        const size_t nhA = (size_t)128 * nxt.lda, nhB = (size_t)128 * nxt.ldb;
        const int nt = cur.nt;
        for (int t = 0; t < nt; t += 2) {
            const bool last = (t == nt - 2);
            const char* a1 = cA + (size_t)(t + 1) * kstep;
            const char* a2 = last ? nA : cA + (size_t)(t + 2) * kstep; const char* b2 = last ? nB : cB + (size_t)(t + 2) * kstep;
            const char* a3 = a2 + kstep; const char* b3 = b2 + kstep;
            unsigned vA2[2], vB2[2];
            if (last) { PG8_VOFF(vA2, vB2, nxt); }
            else {
#pragma unroll
                for (int _i = 0; _i < 2; ++_i) { vA2[_i] = cvA[_i]; vB2[_i] = cvB[_i]; } }
            const size_t hA2 = last ? nhA : chA, hB2 = last ? nhB : chB;
            PG8_LDB(B0, 0, 0); PG8_SCHED; PG8_LDA(At, 0, 0); PG8_STAGE(PG8_SA(1, 1), a1 + chA, cvA);
            PG8_WAIT_L(8); PG8_BAR; PG8_WAIT_L(0); PG8_MMA(0, 0, At, B0); PG8_BAR; PG8_SCHED;
            PG8_LDB(B1, 0, 1); PG8_STAGE(PG8_SB(0, 0), b2, vB2);
            PG8_BAR; PG8_WAIT_L(0); PG8_MMA(0, 1, At, B1); PG8_BAR;
            PG8_LDA(At, 0, 1); PG8_STAGE(PG8_SA(0, 0), a2, vA2);
            PG8_BAR; PG8_WAIT_L(0); PG8_MMA(1, 0, At, B0); PG8_BAR; PG8_SCHED;
            PG8_STAGE(PG8_SB(0, 1), b2 + hB2, vB2);
            PG8_WAIT_V(6); PG8_BAR; PG8_MMA(1, 1, At, B1); PG8_BAR;
            PG8_LDB(B0, 1, 0); PG8_SCHED; PG8_LDA(At, 1, 0); PG8_STAGE(PG8_SA(0, 1), a2 + hA2, vA2);
            PG8_WAIT_L(8); PG8_BAR; PG8_WAIT_L(0); PG8_MMA(0, 0, At, B0); PG8_BAR; PG8_SCHED;
            PG8_LDB(B1, 1, 1); PG8_STAGE(PG8_SB(1, 0), b3, vB2);
            PG8_BAR; PG8_WAIT_L(0); PG8_MMA(0, 1, At, B1); PG8_BAR;
            PG8_LDA(At, 1, 1); PG8_STAGE(PG8_SA(1, 0), a3, vA2);
            PG8_BAR; PG8_WAIT_L(0); PG8_MMA(1, 0, At, B0); PG8_BAR; PG8_SCHED;
            PG8_STAGE(PG8_SB(1, 1), b3 + hB2, vB2);
            PG8_WAIT_V(6); PG8_BAR; PG8_MMA(1, 1, At, B1); PG8_BAR;
        }
        const bool keep = gemm_epilogue(p, l, acc, cur, tid, wg, dumpst);
        if (!has_next) break;
        if (!keep)
#pragma unroll
        for (int a = 0; a < 2; ++a)
#pragma unroll
            for (int b = 0; b < 2; ++b)
#pragma unroll
                for (int m = 0; m < 4; ++m)
#pragma unroll
                    for (int n = 0; n < 2; ++n) acc[a][b][m][n] = (f32x4){0.f, 0.f, 0.f, 0.f};
        cur = nxt; cA = nA; cB = nB; chA = nhA; chB = nhB;
        PG8_VOFF(cvA, cvB, cur);
        ++ui;
    }
    PG8_WAIT_V(0);
    if (wr == 0) PG8_BAR;
    PG8_BAR;
}

template <bool AF32>
DI void skinny_mm(const void* Abase, int lda, const bf16_t* Bt, int ldb, int K, LAS float* T, int tid) {
    constexpr int KC = 512, LD = KC + 8;
    LAS bf16_t* AL = (LAS bf16_t*)((LAS unsigned char*)T + 8704); LAS bf16_t* BL = AL + 64 * LD;
    const int w = tid >> 6, lane = tid & 63, r = lane & 31, h = lane >> 5, mb = w & 1, kq = w >> 1;
    f32x16 acc;
#pragma unroll
    for (int i = 0; i < 16; ++i) acc[i] = 0.f;
    for (int k0 = 0; k0 < K; k0 += KC) {
        const int kc = (K - k0) < KC ? (K - k0) : KC;
        const int sh = kc == 512 ? 6 : 5, cm = (1 << sh) - 1;
        __syncthreads();
#pragma unroll
        for (int hlf = 0; hlf < 2; ++hlf) {
            u32x4 ra[4];
#pragma unroll
            for (int i = 0; i < 4; ++i) { const int q = tid + 512 * (4 * hlf + i); const int row = q >> sh, c8 = (q & cm) * 8; ra[i] = (u32x4){0u, 0u, 0u, 0u};
                if (row < 64) {
                    if (AF32) { const float* ap = (const float*)Abase + (size_t)row * lda + k0 + c8; ra[i] = pack8(*(const f32x4*)ap, *(const f32x4*)(ap + 4)); }
                    else ra[i] = *(const u32x4*)((const bf16_t*)Abase + (size_t)row * lda + k0 + c8); } }
#pragma unroll
            for (int i = 0; i < 4; ++i) { const int q = tid + 512 * (4 * hlf + i); const int row = q >> sh, c8 = (q & cm) * 8; if (row < 64) *(LAS u32x4*)(AL + row * LD + c8) = ra[i]; }
        }
        {
            u32x4 rb[4];
#pragma unroll
            for (int i = 0; i < 4; ++i) { const int q = tid + 512 * i; const int row = q >> sh, c8 = (q & cm) * 8; rb[i] = (u32x4){0u, 0u, 0u, 0u};
                if (row < 32) rb[i] = *(const u32x4*)(Bt + (size_t)row * ldb + k0 + c8); }
#pragma unroll
            for (int i = 0; i < 4; ++i) { const int q = tid + 512 * i; const int row = q >> sh, c8 = (q & cm) * 8; if (row < 32) *(LAS u32x4*)(BL + row * LD + c8) = rb[i]; }
        }
        __syncthreads();
        const int kw = kc >> 2;
        for (int u = 0; u < kw; u += 16) {
            const bf16x8 a = *(const LAS bf16x8*)(AL + (32 * mb + r) * LD + kq * kw + u + 8 * h), b = *(const LAS bf16x8*)(BL + r * LD + kq * kw + u + 8 * h);
            acc = MFMA32(a, b, acc);
        }
    }
    __syncthreads();
    if (kq == 0) {
#pragma unroll
        for (int i = 0; i < 16; ++i) T[(32 * mb + crow(i, h)) * 33 + r] = acc[i];
    }
    __syncthreads();
    if (kq != 0) {
#pragma unroll
        for (int i = 0; i < 16; ++i) __hip_atomic_fetch_add(&T[(32 * mb + crow(i, h)) * 33 + r], acc[i], __ATOMIC_RELAXED, __HIP_MEMORY_SCOPE_WORKGROUP);
    }
    __syncthreads();
}
DI void skinny_read(LAS const float* T, int tid, f32x4& v0, f32x4& v1) {
    const int row = (tid >> 2) & 63, c8 = (tid & 3) * 8;
#pragma unroll
    for (int j = 0; j < 4; ++j) { v0[j] = T[row * 33 + c8 + j]; v1[j] = T[row * 33 + c8 + 4 + j]; }
}
DI void sample_gemm_phase(KP p, int gph, int l, LAS unsigned char* lds, int tid, int wg, int G) {
    unsigned char* ws = p->ws;
    LAS float* T = (LAS float*)lds;
    const int c8 = (tid & 3) * 8; const bool act = tid < 256;
    f32x4 v0, v1;
    if (gph == 0) {
        for (int it = G - 1 - wg; it < 117 * 2; it += G) { const int s = it >> 1, rh = it & 1; const int row = TP + 64 * rh + ((tid >> 2) & 63);
            skinny_mm<false>((const bf16_t*)(ws + OFF_XB) + (size_t)(TP + 64 * rh) * 1024, 1024, (const bf16_t*)(ws + OFF_WIN + l * SZ_WIN) + (size_t)s * 32 * 1024, 1024, 1024, T, tid);
            skinny_read(T, tid, v0, v1); if (act) epi_z(p, row, s * 32 + c8, v0, v1);
        }
    } else if (gph == 1) {
        for (int it = G - 1 - wg; it < 24 * 2; it += G) { const int s = it >> 1, rh = it & 1; const int row = TP + 64 * rh + ((tid >> 2) & 63);
            skinny_mm<false>((const bf16_t*)(ws + OFF_Z) + (size_t)(TP + 64 * rh) * ZW + C_CQ, ZW, (const bf16_t*)(ws + OFF_WUQ + l * SZ_WUQ) + (size_t)s * 32 * 256, 256, 256, T, tid);
            skinny_read(T, tid, v0, v1); if (act) epi_qp(p, row, s * 32 + c8, v0, v1);
        }
    } else if (gph == 2) {
        float* MS = (float*)(ws + OFF_MS);
        for (int it = G - 1 - wg; it < 256; it += G) {
            const int rh = it & 1, ib = (it >> 1) & 3, s = it >> 3, n0 = s * 32;
            skinny_mm<false>((const bf16_t*)(ws + OFF_XB) + (size_t)(TP + 64 * rh) * 1024, 1024, (const bf16_t*)(ws + OFF_WIN + l * SZ_WIN) + (size_t)(3840 + ib * 1024 + n0) * 1024, 1024, 1024, T, tid);
            f32x4 g0, g1; skinny_read(T, tid, g0, g1);
            const int zc = ib == 0 ? C_AU : ib == 1 ? C_BG : ib == 2 ? C_CG : C_MQ;
            skinny_mm<false>((const bf16_t*)(ws + OFF_Z) + (size_t)(TP + 64 * rh) * ZW + zc, ZW, (const bf16_t*)(ws + OFF_WBR + l * SZ_WBR) + (size_t)n0 * 1792 + ib * 512, 1792, ib < 3 ? 512 : 256, T, tid);
            skinny_read(T, tid, v0, v1);
            if (act) { float* mp = MS + (size_t)(64 * rh + ((tid >> 2) & 63)) * 1024 + n0 + c8;
#pragma unroll
                for (int j = 0; j < 4; ++j) { __hip_atomic_fetch_add(mp + j, fsigmoid(g0[j]) * v0[j], __ATOMIC_RELAXED, __HIP_MEMORY_SCOPE_AGENT);
                    __hip_atomic_fetch_add(mp + 4 + j, fsigmoid(g1[j]) * v1[j], __ATOMIC_RELAXED, __HIP_MEMORY_SCOPE_AGENT); } }
        }
    } else {
        for (int it = G - 1 - wg; it < 32 * 2; it += G) { const int s = it >> 1, rh = it & 1; const int row = TP + 64 * rh + ((tid >> 2) & 63);
            skinny_mm<true>((const float*)(ws + OFF_MS) + (size_t)(64 * rh) * 1024, 1024, (const bf16_t*)(ws + OFF_WOUT + l * SZ_WOUT) + (size_t)s * 32 * 1024, 1024, 1024, T, tid);
            skinny_read(T, tid, v0, v1);
            float s1 = 0.f, s2 = 0.f;
            if (act) epi_f(p, l, row, s * 32 + c8, v0, v1, s1, s2);
            s1 += __shfl_xor(s1, 1); s1 += __shfl_xor(s1, 2); s2 += __shfl_xor(s2, 1); s2 += __shfl_xor(s2, 2);
            if (act && (tid & 3) == 0) { float* st = (float*)(ws + OFF_STATS) + (((size_t)l * MROWS + row) * 32 + s) * 2; *(f32x2*)st = (f32x2){s1, s2}; }
        }
    }
    __syncthreads();
}

struct TJob { const float* src; int lds_, Ks; bf16_t* dst; int ldd, nN, nK, map; };
DI int tmap(int kind, int n) {
    if (kind == 0) return n;
    if (kind == 1) return n < 3744 ? n : (n < 3840 ? -1 : n - 96);
    if (kind == 2) { const int h = n / 96, d = n % 96; if (d < 64) return n; const int jj = (d - 64) >> 1, e = (d - 64) & 1; return h * 96 + 64 + jj + 16 * e; }
    if (kind == 3) { const int h = n >> 6, d = n & 63; return h * 128 + d; }
    const int h = n >> 6, d = n & 63; return h * 128 + 64 + d;
}
DI bool tjob(KP p, int j, TJob& t) {
    unsigned char* ws = p->ws;
    if (j < 18) { const int l = j / 9, k = j % 9;
        switch (k) {
        case 0: t = {p->in[9] + (size_t)l * 1024 * 7840, 7840, 1024, (bf16_t*)(ws + OFF_WIN + l * SZ_WIN), 1024, 124, 16, 1}; break;
        case 1: t = {p->in[22] + (size_t)l * 256 * 768, 768, 256, (bf16_t*)(ws + OFF_WUQ + l * SZ_WUQ), 256, 12, 4, 2}; break;
        case 2: t = {p->in[24] + (size_t)l * 128 * 1024, 1024, 128, (bf16_t*)(ws + OFF_WUK + l * SZ_WUK), 128, 8, 2, 3}; break;
        case 3: t = {p->in[24] + (size_t)l * 128 * 1024, 1024, 128, (bf16_t*)(ws + OFF_WUV + l * SZ_WUK), 128, 8, 2, 4}; break;
        case 4: t = {p->in[27] + (size_t)l * 1792 * 1024, 1024, 1792, (bf16_t*)(ws + OFF_WBR + l * SZ_WBR), 1792, 16, 28, 0}; break;
        case 5: t = {p->in[28] + (size_t)l * 1024 * 1024, 1024, 1024, (bf16_t*)(ws + OFF_WOUT + l * SZ_WOUT), 1024, 16, 16, 0}; break;
        case 6: t = {p->in[25] + (size_t)l * 1024 * 256, 256, 1024, (bf16_t*)(ws + OFF_MEMW + l * SZ_MEMW), 1024, 4, 16, 0}; break;
        case 7: t = {p->in[26] + (size_t)l * 1024 * 256, 256, 1024, (bf16_t*)(ws + OFF_MEMW + l * SZ_MEMW) + 256 * 1024, 1024, 4, 16, 0}; break;
        default: t = {p->in[6] + (size_t)l * 8 * 65536, 256, 256, (bf16_t*)(ws + OFF_MVTS) + (size_t)l * 8 * 65536, 256, 4, 4, 0}; break;
        }
        return true; }
    j -= 18;
    if (j < 14) { const int l = j / 7, b = j % 7 + 1; t = {p->in[6] + (size_t)(l * 8 + b) * 65536, 256, 256, (bf16_t*)(ws + OFF_MVTS) + (size_t)(l * 8 + b) * 65536, 256, 4, 4, 0}; return true; }
    j -= 14;
    if (j < 32) { const int l = j / 16, r = j % 16, hb = r >> 1, gi = r & 1;
        t = {p->in[gi ? 18 : 16] + (size_t)(l * 8 + hb) * 4096, 64, 64, (bf16_t*)(ws + OFF_WRI + l * SZ_WRI) + hb * 8192 + gi * 4096, 64, 1, 1, 0}; return true; }
    return false;
}

DI void prep_phase(KP p, LAS unsigned char* lds, int tid) {
    const int G = gridDim.x, wg = blockIdx.x;
    unsigned char* ws = p->ws;
    {
        bf16_t* XB = (bf16_t*)(ws + OFF_XB);
        const size_t nvec = (size_t)MROWS * 1024 / 8;
        for (size_t v = (size_t)wg * 512 + tid; v < nvec; v += (size_t)G * 512) {
            const size_t e = v * 8; const int row = (int)(e >> 10);
            u32x4 o = {0u, 0u, 0u, 0u};
            if (row < NROW) { const float* src = row < TP ? p->in[0] + e : p->in[1] + (e - (size_t)TP * 1024); o = pack8(__builtin_nontemporal_load((const f32x4*)src), __builtin_nontemporal_load((const f32x4*)(src + 4))); }
            *(u32x4*)(XB + e) = o;
        }
    }
    {
        bf16_t* MB = (bf16_t*)(ws + OFF_MEMB);
        for (size_t v = (size_t)wg * 512 + tid; v < (size_t)1024 * 1024 / 8; v += (size_t)G * 512) { const float* s = p->in[2] + v * 8; *(u32x4*)(MB + v * 8) = pack8(*(const f32x4*)s, *(const f32x4*)(s + 4)); }
        bf16_t* MKS = (bf16_t*)(ws + OFF_MKS);
        for (size_t v = (size_t)wg * 512 + tid; v < (size_t)2 * 2048 * 256 / 8; v += (size_t)G * 512) { const float* s = p->in[5] + v * 8; *(u32x4*)(MKS + v * 8) = pack8(*(const f32x4*)s, *(const f32x4*)(s + 4)); }
        bf16_t* GW = (bf16_t*)(ws + OFF_GWS);
        for (size_t v = (size_t)wg * 512 + tid; v < (size_t)2 * 4 * 128 * 128 / 8; v += (size_t)G * 512) {
            const size_t e = v * 8; const int q0 = (int)(e & 127), pr = (int)((e >> 7) & 127); const float* s = p->in[12] + e;
            f32x4 a = *(const f32x4*)s, b = *(const f32x4*)(s + 4);
#pragma unroll
            for (int j = 0; j < 4; ++j) { if (q0 + j > pr) a[j] = 0.f; if (q0 + 4 + j > pr) b[j] = 0.f; }
            *(u32x4*)(GW + e) = pack8(a, b); }
    }
    LAS float* tile = (LAS float*)lds;
    int base = 0;
    for (int j = 0;; ++j) {
        TJob t; if (!tjob(p, j, t)) break;
        const int kt4 = (t.nK & 3) == 0 ? 4 : 1;
        const int nKs = t.nK / kt4, ntile = t.nN * nKs;
        int first = wg - (base % G); if (first < 0) first += G;
        for (int tt = first; tt < ntile; tt += G) {
            const int tn = tt / nKs, tk = tt % nKs, n0 = tn * 64, k0 = tk * 64 * kt4;
            const int nn = tid & 63, kq = tid >> 6;
            const int sc = tmap(t.map, n0 + nn);
            __syncthreads();
            if (t.map != 2) {
                const int n4 = (tid & 15) * 4, kr = tid >> 4;
                const int sc4 = tmap(t.map, n0 + n4);
                if (kt4 == 4) {
                    f32x4 v[8];
#pragma unroll
                    for (int i = 0; i < 8; ++i) { const int k = k0 + kr + 32 * i; v[i] = (sc4 >= 0 && k < t.Ks) ? __builtin_nontemporal_load((const f32x4*)(t.src + (size_t)k * t.lds_ + sc4)) : (f32x4){0.f, 0.f, 0.f, 0.f}; }
#pragma unroll
                    for (int i = 0; i < 8; ++i) {
#pragma unroll
                        for (int jj = 0; jj < 4; ++jj) tile[(kr + 32 * i) * 65 + n4 + jj] = v[i][jj]; }
                } else {
                    f32x4 v[2];
#pragma unroll
                    for (int i = 0; i < 2; ++i) { const int k = k0 + kr + 32 * i; v[i] = (sc4 >= 0 && k < t.Ks) ? __builtin_nontemporal_load((const f32x4*)(t.src + (size_t)k * t.lds_ + sc4)) : (f32x4){0.f, 0.f, 0.f, 0.f}; }
#pragma unroll
                    for (int i = 0; i < 2; ++i) {
#pragma unroll
                        for (int jj = 0; jj < 4; ++jj) tile[(kr + 32 * i) * 65 + n4 + jj] = v[i][jj]; }
                }
            } else if (kt4 == 4) {
                float v[32];
#pragma unroll
                for (int i = 0; i < 32; ++i) { const int k = k0 + kq + 8 * i; v[i] = (sc >= 0 && k < t.Ks) ? t.src[(size_t)k * t.lds_ + sc] : 0.f; }
#pragma unroll
                for (int i = 0; i < 32; ++i) tile[(kq + 8 * i) * 65 + nn] = v[i];
            } else {
                float v[8];
#pragma unroll
                for (int i = 0; i < 8; ++i) { const int k = k0 + kq + 8 * i; v[i] = (sc >= 0 && k < t.Ks) ? t.src[(size_t)k * t.lds_ + sc] : 0.f; }
#pragma unroll
                for (int i = 0; i < 8; ++i) tile[(kq + 8 * i) * 65 + nn] = v[i];
            }
            __syncthreads();
            const int kw = 32 * kt4;
            for (int e = tid; e < 64 * kw; e += 512) { const int n2 = e / kw, k2 = (e % kw) * 2;
                *(unsigned*)(t.dst + (size_t)(n0 + n2) * t.ldd + k0 + k2) = cvt_pk(tile[k2 * 65 + n2], tile[(k2 + 1) * 65 + n2]); }
        }
        base += ntile;
    }
    __syncthreads();
}

struct RawRow { u32x4 av; u32x2 cq; unsigned kv; unsigned short ka, kb; };
DI RawRow rows_load(const bf16_t* Z, int row, int lane) {
    const bf16_t* zr = Z + (size_t)row * ZW; RawRow r;
    r.av = *(const u32x4*)(zr + C_AV + lane * 8); r.cq = *(const u32x2*)(zr + C_CQ + lane * 4); r.kv = *(const unsigned*)(zr + C_CKV + lane * 2);
    r.ka = zr[C_CKR + (lane & 15)]; r.kb = zr[C_CKR + 16 + (lane & 15)]; return r;
}
DI void rows_phase(KP p, int l, int tid, bool dump = false) {
    const int G = gridDim.x, lane = tid & 63, gw = blockIdx.x * 8 + (tid >> 6), nw = G * 8;
    unsigned char* ws = p->ws; unsigned char* dob = (unsigned char*)p->out;
    bf16_t* Z = (bf16_t*)(ws + OFF_Z); bf16_t* CKV = (bf16_t*)(dob + DO_CKV); bf16_t* KR = (bf16_t*)(dob + DO_KR);
    {
        const f32x4 g0 = *(const f32x4*)(p->in[10] + l * 512 + lane * 8), g1 = *(const f32x4*)(p->in[10] + l * 512 + lane * 8 + 4);
        const f32x4 b0 = *(const f32x4*)(p->in[11] + l * 512 + lane * 8), b1 = *(const f32x4*)(p->in[11] + l * 512 + lane * 8 + 4);
        const f32x4 gq = *(const f32x4*)(p->in[21] + l * 256 + lane * 4);
        const f32x2 gk = *(const f32x2*)(p->in[23] + l * 128 + lane * 2);
        RawRow cur; if (gw < NROW) cur = rows_load(Z, gw, lane);
        for (int row = gw; row < NROW; row += nw) {
            RawRow nxt = cur; if (row + nw < NROW) nxt = rows_load(Z, row + nw, lane);
            const bool smp = row >= TP; const int srow = row - TP;
            bf16_t* zr = dump ? (bf16_t*)(ws + WS_NEED) : Z + (size_t)row * ZW;
            float x[8]; unpack8(cur.av, x);
            float xq[4] = {bflo(cur.cq.x), bfhi(cur.cq.x), bflo(cur.cq.y), bfhi(cur.cq.y)};
            const float k0 = bflo(cur.kv), k1 = bfhi(cur.kv);
            float s = 0.f;
#pragma unroll
            for (int j = 0; j < 8; ++j) s += x[j];
            float ssq = xq[0] * xq[0] + xq[1] * xq[1] + xq[2] * xq[2] + xq[3] * xq[3];
            float ssk = k0 * k0 + k1 * k1;
#pragma unroll
            for (int o = 32; o >= 1; o >>= 1) { s += __shfl_xor(s, o); ssq += __shfl_xor(ssq, o); ssk += __shfl_xor(ssk, o); }
            const float mean = s * (1.f / 512.f);
            float q = 0.f;
#pragma unroll
            for (int j = 0; j < 8; ++j) { x[j] -= mean; q += x[j] * x[j]; }
            const float rstd = __builtin_amdgcn_rsqf(wave_sum(q) * (1.f / 512.f) + LN_EPS);
            {
                f32x4 y0, y1;
#pragma unroll
                for (int j = 0; j < 4; ++j) { y0[j] = x[j] * rstd * g0[j] + b0[j]; y1[j] = x[4 + j] * rstd * g1[j] + b1[j]; }
                *(u32x4*)(zr + C_AV + lane * 8) = pack8(y0, y1);
                if (smp && !dump) { float* o = p->out + O_SGV + (size_t)l * 65536 + (size_t)srow * 512 + lane * 8; *(f32x4*)o = y0; *(f32x4*)(o + 4) = y1; }
            }
            {
                const float r = __builtin_amdgcn_rsqf(ssq * (1.f / 256.f) + LN_EPS);
                u32x2 o; o.x = cvt_pk(xq[0] * r * gq[0], xq[1] * r * gq[1]); o.y = cvt_pk(xq[2] * r * gq[2], xq[3] * r * gq[3]);
                *(u32x2*)(zr + C_CQ + lane * 4) = o;
            }
            const int kvrow = smp ? TP + (srow >> 4) * SKEYS + 1024 + (srow & 15) : row;
            if (dump) { CKV = (bf16_t*)(ws + WS_NEED) + 8192 - (size_t)kvrow * 128; KR = (bf16_t*)(ws + WS_NEED) + 16384 - (size_t)kvrow * 32; }
            {
                const float r = __builtin_amdgcn_rsqf(ssk * (1.f / 128.f) + LN_EPS);
                const float y0 = k0 * r * gk[0], y1 = k1 * r * gk[1];
                float* o = smp ? p->out + O_SCKV + (size_t)l * 16384 + (size_t)srow * 128 + lane * 2 : p->out + O_PCKV + (size_t)l * 2097152 + (size_t)row * 128 + lane * 2;
                if (dump) o = (float*)(ws + WS_NEED) + 32768 + lane * 2;
                __builtin_nontemporal_store((f32x2){y0, y1}, (f32x2*)o);
                *(unsigned*)(CKV + (size_t)kvrow * 128 + lane * 2) = cvt_pk(y0, y1);
            }
            if (lane < 16) {
                float a = bf2f(cur.ka), b = bf2f(cur.kb);
                const float pos = smp ? (float)(1024 + (srow & 15)) : (float)(row & 4095);
                rope_pair(a, b, pos, lane);
                float* o = smp ? p->out + O_SKR + (size_t)l * 4096 + (size_t)srow * 32 : p->out + O_PKR + (size_t)l * 524288 + (size_t)row * 32;
                if (dump) o = (float*)(ws + WS_NEED) + 36864;
                __builtin_nontemporal_store(a, o + lane); __builtin_nontemporal_store(b, o + lane + 16);
                *(unsigned*)(KR + (size_t)kvrow * 32 + lane * 2) = cvt_pk(a, b);
            }
            cur = nxt;
        }
    }
    if (dump) return;
    for (int i0 = gw * 4; i0 < 8192; i0 += nw * 4) {
        f32x2 sv[4]; f32x2 rv[4];
#pragma unroll
        for (int k = 0; k < 4; ++k) { const int idx = i0 + k, b = idx >> 10, j = idx & 1023;
            sv[k] = __builtin_nontemporal_load((const f32x2*)(p->in[3] + ((size_t)(l * 8 + b) * 1024 + j) * 128 + lane * 2));
            const float* r = p->in[4] + ((size_t)(l * 8 + b) * 1024 + j) * 32; rv[k] = (f32x2){r[lane & 15], r[(lane & 15) + 16]}; }
#pragma unroll
        for (int k = 0; k < 4; ++k) { const int idx = i0 + k, b = idx >> 10, j = idx & 1023; const int dst = TP + b * SKEYS + j;
            *(unsigned*)(CKV + (size_t)dst * 128 + lane * 2) = cvt_pk(sv[k][0], sv[k][1]);
            if (lane < 16) *(unsigned*)(KR + (size_t)dst * 32 + lane * 2) = cvt_pk(rv[k][0], rv[k][1]); }
    }
    for (int it = gw; it < 36 + 128 + 128; it += nw) {
        if (it < 36) {
            const int idx = it; int src; float* o;
            if (idx < 12) { const int b = idx / 3, k = idx % 3; src = b * 4096 + 4093 + k; o = p->out + O_PCONV + (size_t)l * 6144 + (size_t)(b * 3 + k) * 512; }
            else { const int i2 = idx - 12, b = i2 / 3, k = i2 % 3; src = TP + b * 16 + 13 + k; o = p->out + O_SCONV + (size_t)l * 12288 + (size_t)(b * 3 + k) * 512; }
            const u32x4 raw = *(const u32x4*)(Z + (size_t)src * ZW + C_BX + lane * 8); float x[8]; unpack8(raw, x);
            *(f32x4*)(o + lane * 8) = (f32x4){x[0], x[1], x[2], x[3]}; *(f32x4*)(o + lane * 8 + 4) = (f32x4){x[4], x[5], x[6], x[7]};
        } else if (it < 36 + 128) {
            const int dst = 24704 + (it - 36);
            unsigned zz = 0u; asm volatile("" : "+v"(zz));
            *(unsigned*)(CKV + (size_t)dst * 128 + lane * 2) = zz;
        } else {
            float* ms = (float*)(ws + OFF_MS) + (size_t)(it - (36 + 128)) * 1024 + lane * 16;
#pragma unroll
            for (int j = 0; j < 4; ++j) *(f32x4*)(ms + 4 * j) = (f32x4){0.f, 0.f, 0.f, 0.f};
        }
    }
}

struct LnRow { u32x4 v[2]; f32x2 part; };
DI LnRow ln_load(const bf16_t* vb, const float* st, int row, int lane) {
    LnRow r; const bf16_t* vr = vb + (size_t)row * 1024;
#pragma unroll
    for (int c = 0; c < 2; ++c) r.v[c] = __builtin_nontemporal_load((const u32x4*)(vr + c * 512 + lane * 8));
    r.part = (f32x2){0.f, 0.f};
    if (lane < (row < TP ? 16 : 32)) r.part = *(const f32x2*)(st + (size_t)row * 64 + lane * 2);
    return r;
}
DI void ln_phase(KP p, int l, int tid) {
    const int G = gridDim.x, lane = tid & 63, gw = blockIdx.x * 8 + (tid >> 6), nw = G * 8;
    unsigned char* ws = p->ws;
    const float* st = (const float*)(ws + OFF_STATS) + (size_t)l * MROWS * 64;
    bf16_t* XB = (bf16_t*)(ws + OFF_XB);
    const float* g = p->in[29] + l * 1024; const float* b = p->in[30] + l * 1024;
    f32x4 gg[4], bb[4];
#pragma unroll
    for (int c = 0; c < 2; ++c) { gg[2 * c] = *(const f32x4*)(g + c * 512 + lane * 8); gg[2 * c + 1] = *(const f32x4*)(g + c * 512 + lane * 8 + 4);
        bb[2 * c] = *(const f32x4*)(b + c * 512 + lane * 8); bb[2 * c + 1] = *(const f32x4*)(b + c * 512 + lane * 8 + 4); }
    const bf16_t* VB = (const bf16_t*)(ws + OFF_Z);
    LnRow cur; if (gw < NROW) cur = ln_load(VB, st, gw, lane);
    for (int row = gw; row < NROW; row += nw) {
        LnRow nxt = cur; if (row + nw < NROW) nxt = ln_load(VB, st, row + nw, lane);
        float ps1 = cur.part[0], ps2 = cur.part[1];
#pragma unroll
        for (int o = 16; o >= 1; o >>= 1) { ps1 += __shfl_xor(ps1, o); ps2 += __shfl_xor(ps2, o); }
        ps1 = __shfl(ps1, 0); ps2 = __shfl(ps2, 0);
        const float mean = ps1 * (1.f / 1024.f); const float var = ps2 * (1.f / 1024.f) - mean * mean;
        const float rstd = __builtin_amdgcn_rsqf(fmaxf(var, 0.f) + LN_EPS);
        float* vr = p->out + (size_t)row * 1024;
#pragma unroll
        for (int c = 0; c < 2; ++c) {
            const int col = c * 512 + lane * 8;
            float xv[8]; unpack8(cur.v[c], xv);
            f32x4 a = {xv[0], xv[1], xv[2], xv[3]}, bq = {xv[4], xv[5], xv[6], xv[7]};
#pragma unroll
            for (int j = 0; j < 4; ++j) { a[j] = (a[j] - mean) * rstd * gg[2 * c][j] + bb[2 * c][j]; bq[j] = (bq[j] - mean) * rstd * gg[2 * c + 1][j] + bb[2 * c + 1][j]; }
            if (l == 0) *(u32x4*)(XB + (size_t)row * 1024 + col) = pack8(a, bq);
            else { __builtin_nontemporal_store(a, (f32x4*)(vr + col)); __builtin_nontemporal_store(bq, (f32x4*)(vr + col + 4)); }
        }
        cur = nxt;
    }
}

DI void gmlp_tile(KP p, int l, int b, int n, int g, LAS unsigned char* lds, int tid, bool dump = false) {
    const int w = tid >> 6, lane = tid & 63, r = lane & 31, h = lane >> 5;
    bf16_t* Z = (bf16_t*)(p->ws + OFF_Z);
    const bf16_t* GW = (const bf16_t*)(p->ws + OFF_GWS) + (size_t)(l * 4 + g) * 16384;
    LAS bf16_t* Wl = (LAS bf16_t*)lds; LAS bf16_t* Vl = (LAS bf16_t*)(lds + 34816); LAS bf16_t* Ul = (LAS bf16_t*)(lds + 69632); LAS bf16_t* Gl = (LAS bf16_t*)(lds + 102400);
    const int r0 = b * 4096 + n * 128;
    __syncthreads();
    for (int c = tid; c < 2048; c += 512) { const int rr = c >> 4, ch = c & 15; const bf16_t* zr = Z + (size_t)(r0 + rr) * ZW + g * 128 + ch * 8;
        *(LAS u32x4*)(Wl + rr * 136 + ch * 8) = *(const u32x4*)(GW + rr * 128 + ch * 8);
        *(LAS u32x4*)(Vl + rr * 136 + ch * 8) = __builtin_nontemporal_load((const u32x4*)(zr + C_AV));
        *(LAS u32x4*)(Ul + rr * 128 + ch * 8) = __builtin_nontemporal_load((const u32x4*)(zr + C_AU));
        *(LAS u32x4*)(Gl + rr * 128 + ch * 8) = __builtin_nontemporal_load((const u32x4*)(zr + C_AG)); }
    __syncthreads();
    const int pb = w >> 1, cb0 = (w & 1) * 2;
    f32x16 acc0, acc1;
#pragma unroll
    for (int i = 0; i < 16; ++i) { acc0[i] = 0.f; acc1[i] = 0.f; }
    for (int s = 0; s < 2 * (pb + 1); ++s) {
        const bf16x8 a = *(const LAS bf16x8*)(Wl + (32 * pb + r) * 136 + 16 * s + 8 * h);
        bf16x8 b0, b1;
#pragma unroll
        for (int j = 0; j < 8; ++j) { b0[j] = (short)Vl[(16 * s + 8 * h + j) * 136 + 32 * cb0 + r]; b1[j] = (short)Vl[(16 * s + 8 * h + j) * 136 + 32 * (cb0 + 1) + r]; }
        acc0 = MFMA32(a, b0, acc0); acc1 = MFMA32(a, b1, acc1);
    }
    const float* bs = p->in[13] + (size_t)(l * 4 + g) * 128;
    float bias[16];
#pragma unroll
    for (int i = 0; i < 16; ++i) bias[i] = bs[32 * pb + crow(i, h)];
#pragma unroll
    for (int i = 0; i < 16; ++i) {
        const int pr = 32 * pb + crow(i, h);
#pragma unroll
        for (int cb = 0; cb < 2; ++cb) {
            const int c = 32 * (cb0 + cb) + r;
            const float sv = (cb ? acc1[i] : acc0[i]) + bias[i];
            Ul[pr * 128 + c] = f2bf(bf2f(Ul[pr * 128 + c]) * sv * bf2f(Gl[pr * 128 + c]));
        }
    }
    __syncthreads();
    for (int c = tid; c < 2048; c += 512) { const int rr = c >> 4, ch = c & 15;
        bf16_t* dst = dump ? (bf16_t*)(p->ws + WS_NEED) + ch * 8 : Z + (size_t)(r0 + rr) * ZW + C_AU + g * 128 + ch * 8;
        *(u32x4*)dst = *(const LAS u32x4*)(Ul + rr * 128 + ch * 8); }
}
DI void gmlp_sample(KP p, int l, int b, int g, int tid) {
    const int c = tid & 127, p0 = (tid >> 7) * 4;
    bf16_t* Z = (bf16_t*)(p->ws + OFF_Z);
    const float* wsrc = p->in[12] + (size_t)(l * 4 + g) * 16384; const float* bs = p->in[13] + (size_t)(l * 4 + g) * 128;
    const int r0 = TP + b * 16;
    float v[16];
#pragma unroll
    for (int q = 0; q < 16; ++q) v[q] = bf2f(Z[(size_t)(r0 + q) * ZW + C_AV + g * 128 + c]);
#pragma unroll
    for (int k = 0; k < 4; ++k) { const int pr = p0 + k; float s = bs[pr];
#pragma unroll
        for (int q = 0; q < 16; ++q) if (q <= pr) s += wsrc[pr * 128 + q] * v[q];
        bf16_t* zr = Z + (size_t)(r0 + pr) * ZW; const int cc = g * 128 + c;
        zr[C_AU + cc] = f2bf(bf2f(zr[C_AU + cc]) * s * bf2f(zr[C_AG + cc])); }
}

DI void lru_tile(KP p, int l, int bg, int hb, int seg, bool apply, LAS unsigned char* lds, int tid, bool dump = false) {
    const int w = tid >> 6, lane = tid & 63, r = lane & 31, h = lane >> 5;
    bf16_t* Z = (bf16_t*)(p->ws + OFF_Z);
    const bool smp = bg >= 4; const int sb = bg - 4;
    const int row0 = smp ? TP + sb * 16 : bg * 4096 + seg * 128; const int ntok = smp ? 16 : 128;
    LAS float* XC = (LAS float*)lds; LAS bf16_t* XCB = (LAS bf16_t*)(lds + 32768); LAS float* GATE = (LAS float*)(lds + 51200); LAS float* AGL = (LAS float*)(lds + 116736);
    LAS bf16_t* BXT = (LAS bf16_t*)(lds + 51200);
    LAS bf16_t* GZ = (LAS bf16_t*)(lds + 120832);
    LAS float* AGP = (LAS float*)(lds + 137216);
    const int c = tid & 63, sub = tid >> 6, ch = hb * 64 + c;
    float* AGG = (float*)(p->ws + OFF_AGG);
    const int tb = w >> 1, nb0 = (w & 1) * 2;
    const bf16_t* WT = (const bf16_t*)(p->ws + OFF_WRI + l * SZ_WRI) + hb * 8192;
    bf16x8 bw0[4], bw1[4];
#pragma unroll
    for (int s = 0; s < 4; ++s) { bw0[s] = *(const bf16x8*)(WT + (32 * nb0 + r) * 64 + 16 * s + 8 * h); bw1[s] = *(const bf16x8*)(WT + (32 * (nb0 + 1) + r) * 64 + 16 * s + 8 * h); }
    const int n0 = 32 * nb0 + r, n1 = n0 + 32;
    const float bias0 = n0 < 64 ? p->in[17][l * 512 + hb * 64 + n0] : p->in[19][l * 512 + hb * 64 + n0 - 64];
    const float bias1 = n1 < 64 ? p->in[17][l * 512 + hb * 64 + n1] : p->in[19][l * 512 + hb * 64 + n1 - 64];
    const float cb = p->in[15][l * 512 + ch];
    float cw[4];
#pragma unroll
    for (int k = 0; k < 4; ++k) cw[k] = p->in[14][(size_t)(l * 4 + k) * 512 + ch];
    const float lam = p->in[20][l * 512 + ch];
    __syncthreads();
    if (apply && !smp) {
#pragma unroll
        for (int k = 0; k < 4; ++k) { const int s2 = sub + 8 * k;
            if (s2 < seg) { const float* o = AGG + (size_t)((bg * 8 + hb) * 32 + s2) * 128; AGP[s2 * 128 + c] = o[c]; AGP[s2 * 128 + 64 + c] = o[64 + c]; } }
    }
    for (int q = tid; q < 131 * 8; q += 512) {
        const int rr = q >> 3, cc = (q & 7) * 8; const int tt = rr - 3;
        u32x4 v = {0u, 0u, 0u, 0u};
        if (!smp) { const int gt = seg * 128 + tt; if (gt >= 0) v = *(const u32x4*)(Z + (size_t)(bg * 4096 + gt) * ZW + C_BX + hb * 64 + cc); }
        else if (tt >= 0) { if (tt < 16) v = *(const u32x4*)(Z + (size_t)(row0 + tt) * ZW + C_BX + hb * 64 + cc); }
        else { const float* cs = p->in[8] + ((size_t)(l * 8 + sb) * 3 + rr) * 512 + hb * 64 + cc; v = pack8(*(const f32x4*)cs, *(const f32x4*)(cs + 4)); }
        *(LAS u32x4*)(BXT + rr * 64 + cc) = v;
    }
    if (apply) for (int q = tid; q < 128 * 8; q += 512) { const int rr = q >> 3, cc = (q & 7) * 8;
        u32x4 v = {0u, 0u, 0u, 0u}; if (rr < ntok) v = *(const u32x4*)(Z + (size_t)(row0 + rr) * ZW + C_BG + hb * 64 + cc);
        *(LAS u32x4*)(GZ + rr * 64 + cc) = v; }
    __syncthreads();
    {
#pragma unroll 4
        for (int t = sub; t < 128; t += 8) {
            float a = 0.f;
            if (t < ntok) { a = cb;
#pragma unroll
                for (int k = 0; k < 4; ++k) a += bf2f(BXT[(t + k) * 64 + c]) * cw[k]; }
            XC[t * 64 + c] = a; XCB[t * 72 + c] = f2bf(a);
        }
    }
    __syncthreads();
    {
        f32x16 a0, a1;
#pragma unroll
        for (int i = 0; i < 16; ++i) { a0[i] = 0.f; a1[i] = 0.f; }
#pragma unroll
        for (int s = 0; s < 4; ++s) {
            const bf16x8 a = *(const LAS bf16x8*)(XCB + (32 * tb + r) * 72 + 16 * s + 8 * h);
            a0 = MFMA32(a, bw0[s], a0); a1 = MFMA32(a, bw1[s], a1);
        }
        __syncthreads();
#pragma unroll
        for (int i = 0; i < 16; ++i) { const int t = 32 * tb + crow(i, h); GATE[t * 128 + n0] = fsigmoid(a0[i] + bias0); GATE[t * 128 + n1] = fsigmoid(a1[i] + bias1); }
    }
    __syncthreads();
    float av[16], bv[16];
    {
        const float ex = __expf(-lam);
        const float sp = ex * (1.f - ex * (0.5f - ex * 0.33333333f));
        float P = 1.f, S = 0.f;
#pragma unroll
        for (int k = 0; k < 16; ++k) { const int t = sub * 16 + k;
            float a = 1.f, bb = 0.f;
            if (t < ntok) { const float rg = GATE[t * 128 + c], ig = GATE[t * 128 + 64 + c], x = XC[t * 64 + c];
                const float la = -8.f * rg * sp; a = __expf(la); const float y2 = 2.f * la;
                const float em = y2 > -0.1f ? -y2 * (1.f + y2 * (0.5f + y2 * (0.16666667f + y2 * 0.041666668f))) : 1.f - a * a;
                bb = __builtin_amdgcn_sqrtf(fmaxf(em, 0.f)) * (ig * x); }
            av[k] = a; bv[k] = bb; S = a * S + bb; P *= a; }
        AGL[sub * 64 + c] = P; AGL[512 + sub * 64 + c] = S;
    }
    __syncthreads();
    if (!apply) {
        if (sub == 0 && !smp) { float A = 1.f, B = 0.f;
#pragma unroll
            for (int s2 = 0; s2 < 8; ++s2) { const float P = AGL[s2 * 64 + c], S = AGL[512 + s2 * 64 + c]; B = P * B + S; A *= P; }
            float* o = AGG + (size_t)((bg * 8 + hb) * 32 + seg) * 128; o[c] = A; o[64 + c] = B; }
    } else {
        float hcar;
        if (smp) hcar = p->in[7][(size_t)(l * 8 + sb) * 512 + ch];
        else { hcar = 0.f; for (int s2 = 0; s2 < seg; ++s2) hcar = AGP[s2 * 128 + c] * hcar + AGP[s2 * 128 + 64 + c]; }
        for (int s2 = 0; s2 < sub; ++s2) hcar = AGL[s2 * 64 + c] * hcar + AGL[512 + s2 * 64 + c];
#pragma unroll
        for (int k = 0; k < 16; ++k) { const int t = sub * 16 + k;
            hcar = av[k] * hcar + bv[k];
            if (t < ntok) { GZ[t * 64 + c] = f2bf(hcar * bf2f(GZ[t * 64 + c]));
                if (!dump) { if (smp) { if (t == 15) p->out[O_SH + (size_t)(l * 8 + sb) * 512 + ch] = hcar; }
                else if (seg == 31 && t == 127) p->out[O_PH + (size_t)(l * 4 + bg) * 512 + ch] = hcar; } } }
        __syncthreads();
        for (int q = tid; q < 128 * 8; q += 512) { const int rr = q >> 3, cc = (q & 7) * 8;
            if (rr < ntok) { bf16_t* dst = dump ? (bf16_t*)(p->ws + WS_NEED) + cc : Z + (size_t)(row0 + rr) * ZW + C_BG + hb * 64 + cc; *(u32x4*)dst = *(const LAS u32x4*)(GZ + rr * 64 + cc); } }
    }
}

struct AttnItem {
    const bf16_t* Q; int ldq, qcol, qrow0, nq;
    const bf16_t* Kn; int ldkn, kncol; const bf16_t* Kr; int krow0;
    const bf16_t* VT; int ldvt, vtrow0, vcol0;
    int nkeys, ntmax, tbase, causal;
    float scale;
    bf16_t* O; int ldo, ocol, gate;
};
template <bool ROPE>
DI void attn_item(const AttnItem& it, LAS unsigned char* lds, int tid) {
    constexpr int NK = ROPE ? 6 : 4;
    constexpr int KB = 64 * 104 * 2, VB = 64 * 72 * 2;
    const int w = tid >> 6, lane = tid & 63, r = lane & 31, h = lane >> 5;
    const int qi = 32 * w + r; const bool qvalid = qi < it.nq; const int qrow = it.qrow0 + (qvalid ? qi : 0);
    const int mytiles = (32 * w >= it.nq) ? 0 : (it.causal ? it.tbase + (w >> 1) + 1 : it.ntmax);
    const int T = it.ntmax;
    bf16x8 qf[NK];
#pragma unroll
    for (int ks = 0; ks < NK; ++ks) qf[ks] = __builtin_nontemporal_load((const bf16x8*)(it.Q + (size_t)qrow * it.ldq + it.qcol + 16 * ks + 8 * h));
    f32x16 o0, o1;
#pragma unroll
    for (int i = 0; i < 16; ++i) { o0[i] = 0.f; o1[i] = 0.f; }
    float mrun = -1e30f, lsum = 0.f;
    const float sc = it.scale;
    const int lk = tid >> 3, lc = tid & 7, rk = tid >> 2, rc = tid & 3;
    const bf16_t* kp = it.Kn + (size_t)(it.krow0 + lk) * it.ldkn + it.kncol + lc * 8;
    const bf16_t* rp = ROPE ? it.Kr + (size_t)(it.krow0 + rk) * 32 + rc * 8 : nullptr;
    const bf16_t* vp = it.VT + (size_t)(it.vtrow0 + lk) * it.ldvt + it.vcol0 + lc * 8;
    const size_t kts = (size_t)64 * it.ldkn;
#define AT_KL(kt, kr_, rr_) do { kr_ = *(const u32x4*)(kp + (size_t)(kt) * kts); if (ROPE && tid < 256) rr_ = *(const u32x4*)(rp + (size_t)(kt) * 2048); } while (0)
#define AT_KS(buf, kr_, rr_) do { *(LAS u32x4*)(lds + (buf) * KB + (lk * 104 + lc * 8) * 2) = kr_; if (ROPE && tid < 256) *(LAS u32x4*)(lds + (buf) * KB + (rk * 104 + 64 + rc * 8) * 2) = rr_; } while (0)
#define AT_QK(buf, d0, d1) do { \
        _Pragma("unroll") for (int i = 0; i < 16; ++i) { d0[i] = 0.f; d1[i] = 0.f; } \
        _Pragma("unroll") for (int kb_ = 0; kb_ < NK; kb_ += 2) { bf16x8 ka_[4]; \
            _Pragma("unroll") for (int ks = 0; ks < 2; ++ks) { ka_[2 * ks] = *(const LAS bf16x8*)(lds + (buf) * KB + (r * 104 + 16 * (kb_ + ks) + 8 * h) * 2); ka_[2 * ks + 1] = *(const LAS bf16x8*)(lds + (buf) * KB + ((32 + r) * 104 + 16 * (kb_ + ks) + 8 * h) * 2); } \
            __builtin_amdgcn_sched_barrier(0); \
            _Pragma("unroll") for (int ks = 0; ks < 2; ++ks) { d0 = MFMA32(ka_[2 * ks], qf[kb_ + ks], d0); d1 = MFMA32(ka_[2 * ks + 1], qf[kb_ + ks], d1); } \
            __builtin_amdgcn_sched_barrier(0); } } while (0)
    u32x4 kreg, rreg = {0u, 0u, 0u, 0u}, vreg;
    {
        AT_KL(0, kreg, rreg); vreg = *(const u32x4*)vp;
        __syncthreads();
        AT_KS(0, kreg, rreg); *(LAS u32x4*)(lds + 2 * KB + (lk * 72 + lc * 8) * 2) = vreg;
        if (T > 1) { AT_KL(1, kreg, rreg); vreg = *(const u32x4*)(vp + 64); }
    }
    for (int kt = 0; kt < T; ++kt) {
        __syncthreads();
        if (kt + 1 < T) { AT_KS((kt + 1) & 1, kreg, rreg); *(LAS u32x4*)(lds + 2 * KB + ((kt + 1) & 1) * VB + (lk * 72 + lc * 8) * 2) = vreg; }
        if (kt + 2 < T) { AT_KL(kt + 2, kreg, rreg); vreg = *(const u32x4*)(vp + (size_t)(kt + 2) * 64); }
        if (kt < mytiles) {
            f32x16 s0, s1;
            AT_QK(kt & 1, s0, s1);
            if ((kt + 1) * 64 > it.nkeys) {
#pragma unroll
                for (int i = 0; i < 16; ++i) { const int key = kt * 64 + crow(i, h); if (key >= it.nkeys) s0[i] = -1e30f; if (key + 32 >= it.nkeys) s1[i] = -1e30f; }
            }
            float mx = max3f(s0[0], s0[1], s1[0]);
#pragma unroll
            for (int i = 2; i < 16; i += 2) mx = max3f(mx, s0[i], s0[i + 1]);
#pragma unroll
            for (int i = 1; i < 15; i += 2) mx = max3f(mx, s1[i], s1[i + 1]);
            mx = fmaxf(mx, s1[15]);
            mx = xhalf_max(mx);
            const float mnew = fmaxf(mrun, mx);
            const bool changed = __any(mnew > mrun);
            const float alpha = __builtin_amdgcn_exp2f((mrun - mnew) * sc);
            mrun = mnew;
            const f32x2 sc2 = {sc, sc}, nmc2 = {-mnew * sc, -mnew * sc};
            f32x2 ps2 = {0.f, 0.f};
#pragma unroll
            for (int i = 0; i < 16; i += 2) {
                f32x2 t0 = (f32x2){s0[i], s0[i + 1]} * sc2 + nmc2, t1 = (f32x2){s1[i], s1[i + 1]} * sc2 + nmc2;
                t0.x = __builtin_amdgcn_exp2f(t0.x); t0.y = __builtin_amdgcn_exp2f(t0.y); t1.x = __builtin_amdgcn_exp2f(t1.x); t1.y = __builtin_amdgcn_exp2f(t1.y);
                ps2 += t0; ps2 += t1;
                s0[i] = t0.x; s0[i + 1] = t0.y; s1[i] = t1.x; s1[i + 1] = t1.y;
            }
            lsum = lsum * alpha + (ps2.x + ps2.y);
            if (changed) {
#pragma unroll
                for (int i = 0; i < 16; ++i) { o0[i] *= alpha; o1[i] *= alpha; }
            }
            const LAS unsigned char* vb = lds + 2 * KB + (kt & 1) * VB;
            bf16x8 pf[4];
#pragma unroll
            for (int kk = 0; kk < 4; ++kk) {
                const int s8 = (kk & 1) * 8;
                u32x4 pw;
                if (kk < 2) { pw.x = cvt_pk(s0[s8], s0[s8 + 1]); pw.y = cvt_pk(s0[s8 + 2], s0[s8 + 3]); pw.z = cvt_pk(s0[s8 + 4], s0[s8 + 5]); pw.w = cvt_pk(s0[s8 + 6], s0[s8 + 7]); }
                else { pw.x = cvt_pk(s1[s8], s1[s8 + 1]); pw.y = cvt_pk(s1[s8 + 2], s1[s8 + 3]); pw.z = cvt_pk(s1[s8 + 4], s1[s8 + 5]); pw.w = cvt_pk(s1[s8 + 6], s1[s8 + 7]); }
                pf[kk] = __builtin_bit_cast(bf16x8, pw);
            }
#pragma unroll
            for (int k2 = 0; k2 < 4; k2 += 2) {
                s16x4 vl[8];
#pragma unroll
                for (int kq = 0; kq < 2; ++kq) { const int kk = k2 + kq;
                    vl[4 * kq] = *(const LAS s16x4*)(vb + (r * 72 + 16 * kk + 4 * h) * 2); vl[4 * kq + 1] = *(const LAS s16x4*)(vb + (r * 72 + 16 * kk + 8 + 4 * h) * 2);
                    vl[4 * kq + 2] = *(const LAS s16x4*)(vb + ((32 + r) * 72 + 16 * kk + 4 * h) * 2); vl[4 * kq + 3] = *(const LAS s16x4*)(vb + ((32 + r) * 72 + 16 * kk + 8 + 4 * h) * 2); }
                __builtin_amdgcn_sched_barrier(0);
#pragma unroll
                for (int kq = 0; kq < 2; ++kq) {
                    const bf16x8 va0 = __builtin_shufflevector(vl[4 * kq], vl[4 * kq + 1], 0, 1, 2, 3, 4, 5, 6, 7), va1 = __builtin_shufflevector(vl[4 * kq + 2], vl[4 * kq + 3], 0, 1, 2, 3, 4, 5, 6, 7);
                    o0 = MFMA32(va0, pf[k2 + kq], o0); o1 = MFMA32(va1, pf[k2 + kq], o1);
                }
                __builtin_amdgcn_sched_barrier(0);
            }
        }
    }
#undef AT_KL
#undef AT_KS
#undef AT_QK
    const float ltot = lsum + __shfl_xor(lsum, 32);
    if (qvalid && mytiles > 0) {
        const float inv = __builtin_amdgcn_rcpf(ltot);
        bf16_t* orow = it.O + (size_t)qrow * it.ldo + it.ocol;
        u32x2 gw[8];
        if (it.gate) {
#pragma unroll
            for (int db = 0; db < 2; ++db)
#pragma unroll
                for (int g4 = 0; g4 < 4; ++g4) gw[db * 4 + g4] = *(const u32x2*)(orow + 32 * db + 8 * g4 + 4 * h);
        }
#pragma unroll
        for (int db = 0; db < 2; ++db)
#pragma unroll
            for (int g4 = 0; g4 < 4; ++g4) {
                const int dv0 = 32 * db + 8 * g4 + 4 * h;
                float v[4];
#pragma unroll
                for (int j = 0; j < 4; ++j) v[j] = (db ? o1[4 * g4 + j] : o0[4 * g4 + j]) * inv;
                if (it.gate) { const u32x2 g = gw[db * 4 + g4]; v[0] *= bflo(g.x); v[1] *= bfhi(g.x); v[2] *= bflo(g.y); v[3] *= bfhi(g.y); }
                u32x2 ow; ow.x = cvt_pk(v[0], v[1]); ow.y = cvt_pk(v[2], v[3]);
                *(u32x2*)(orow + dv0) = ow;
            }
    }
}

#define XB_TMO      128
#define XB_XCNT(j)  (256  + 64 * (j))
#define XB_XSUB(j)  (1280 + 64 * (j))
#define XB_XGEN(j)  (2304 + 64 * (j))
#define XB_TOP      3328
#define XB_TOPGEN   3392
#define XCD_BAR_WORDS 3456
#define XB_SPIN_CAP (1u << 18)
DI unsigned xb_ld(unsigned* p)              { return __hip_atomic_load(p, __ATOMIC_RELAXED, __HIP_MEMORY_SCOPE_AGENT); }
DI unsigned xb_add(unsigned* p, unsigned v) { return __hip_atomic_fetch_add(p, v, __ATOMIC_RELAXED, __HIP_MEMORY_SCOPE_AGENT); }
DI unsigned xb_xcc_id() { return (unsigned)__builtin_amdgcn_s_getreg((3 << 11) | 20) & 0xFu; }
#define XB_SPIN(cond, bar) do { unsigned _sp = 0; while (cond) { __builtin_amdgcn_s_sleep(1); \
    if ((++_sp & 255u) == 0u) { if (xb_ld(&(bar)[XB_TMO])) break; if (_sp > XB_SPIN_CAP) { atomicAdd(&(bar)[XB_TMO], 1u); break; } } } } while (0)
struct XcdBarrier { unsigned* bar; unsigned x; volatile LAS unsigned* st; };
DI XcdBarrier xcd_barrier_post(unsigned* bar, volatile LAS unsigned* st) {
    XcdBarrier b; b.bar = bar; b.x = xb_xcc_id(); b.st = st;
    if (threadIdx.x == 0) (void)xb_add(&bar[XB_XCNT(b.x)], 1u);
    return b;
}
DI void xcd_barrier_complete(unsigned* bar, unsigned x, unsigned& nloc, unsigned& nx) {
    const unsigned G = gridDim.x * gridDim.y * gridDim.z;
    unsigned sum, cnt, mine, sp = 0u;
    for (;;) {
        sum = 0u; cnt = 0u; mine = 0u;
#pragma unroll
        for (unsigned j = 0; j < 16; ++j) { const unsigned c = xb_ld(&bar[XB_XCNT(j)]); sum += c; cnt += (c > 0u) ? 1u : 0u; mine = (j == x) ? c : mine; }
        if (sum == G) break;
        __builtin_amdgcn_s_sleep(1);
        if ((++sp & 255u) == 0u) { if (xb_ld(&bar[XB_TMO])) break; if (sp > XB_SPIN_CAP) { atomicAdd(&bar[XB_TMO], 1u); break; } }
    }
    nloc = mine > 0u ? mine : 1u; nx = cnt > 0u ? cnt : 1u;
}
DI void xcd_barrier(const XcdBarrier& b) {
    asm volatile("s_waitcnt vmcnt(0)" ::: "memory");
    __syncthreads();
    if (threadIdx.x == 0) {
        unsigned* bar = b.bar;
        __builtin_amdgcn_s_waitcnt(0);
        unsigned nloc = b.st[0], nx = b.st[1];
        if (nloc == 0u) { xcd_barrier_complete(bar, b.x, nloc, nx); b.st[0] = nloc; b.st[1] = nx; }
        const unsigned old = xb_add(&bar[XB_XSUB(b.x)], 1u);
        const unsigned gen = old / nloc;
        if (old + 1u == (gen + 1u) * nloc) {
            __builtin_amdgcn_fence(__ATOMIC_RELEASE, "agent");
            asm volatile("s_waitcnt vmcnt(0)" ::: "memory");
            const unsigned og = xb_add(&bar[XB_TOP], 1u);
            const unsigned tg = og / nx;
            if (og + 1u == (tg + 1u) * nx) xb_add(&bar[XB_TOPGEN], 1u);
            else XB_SPIN(xb_ld(&bar[XB_TOPGEN]) == tg, bar);
            __builtin_amdgcn_fence(__ATOMIC_ACQUIRE, "agent");
            xb_add(&bar[XB_XGEN(b.x)], 1u);
            asm volatile("s_waitcnt vmcnt(0)" ::: "memory");
        } else {
            XB_SPIN(xb_ld(&bar[XB_XGEN(b.x)]) == gen, bar);
            __builtin_amdgcn_fence(__ATOMIC_ACQUIRE, "agent");
            asm volatile("s_waitcnt vmcnt(0)" ::: "memory");
        }
    }
    __syncthreads();
}

__global__ void __launch_bounds__(512, 2) mega(Params pk) {
    extern __shared__ __attribute__((aligned(16))) unsigned char shm[];
    LAS unsigned char* lds = (LAS unsigned char*)shm;
    cg::grid_group grid = cg::this_grid();
    __shared__ uint4 xb_words;
    if (threadIdx.x == 0) xb_words = make_uint4(0u, 0u, 0u, 0u);
    __syncthreads();
    XcdBarrier xb = xcd_barrier_post((unsigned*)(((KP)__builtin_amdgcn_kernarg_segment_ptr())->ws + OFF_BAR), (volatile LAS unsigned*)&xb_words);
#define STAMP(k) do { if (TSA != -1 && blockIdx.x == 0 && threadIdx.x == 0) ((unsigned long long*)(((KP)__builtin_amdgcn_kernarg_segment_ptr())->ws + OFF_TS))[k] = __builtin_amdgcn_s_memrealtime(); } while (0)
    STAMP(18);
    { KP p = (KP)__builtin_amdgcn_kernarg_segment_ptr(); int tid0 = threadIdx.x; asm volatile("" : "+v"(tid0)); prep_phase(p, lds, tid0); if (PROBE & 64) { grid.sync(); prep_phase(p, lds, tid0); } }
    grid.sync();
    if (PROBE & 256) { for (int k = 0; k < 20; ++k) xcd_barrier(xb); }
    STAMP(0);
    for (int step = 0; step < 14; ++step) {
        const int l = step / 7, ph = step % 7;
        KP p = (KP)__builtin_amdgcn_kernarg_segment_ptr(); asm volatile("" : "+s"(p));
        int tid = threadIdx.x; asm volatile("" : "+v"(tid));
        int wg = blockIdx.x, G = gridDim.x; asm volatile("" : "+s"(wg), "+s"(G));
        unsigned char* ws = p->ws; unsigned char* dob = (unsigned char*)p->out;
        const int gph = ph == 0 ? 0 : ph == 2 ? 1 : ph == 4 ? 2 : ph == 5 ? 3 : -1;
        if (gph >= 0) {
            const int ndup = ((PROBE & 1) && gph == 0) || ((PROBE & 2) && gph == 1) || ((PROBE & 4) && gph == 2) || ((PROBE & 128) && gph == 3) ? 2 : 1;
#pragma unroll 1
            for (int rep = 0; rep < ndup; ++rep) { gemm_stream(p, gph, l, lds, tid, wg, G, rep + 1 < ndup); if (rep + 1 < ndup) xcd_barrier(xb); }
            if (l == 0) STAMP(20 + gph * 2);
            sample_gemm_phase(p, gph, l, lds, tid, wg, G);
            if (l == 0) STAMP(21 + gph * 2);
        }
        if (ph == 1) { if (PROBE & 512) { rows_phase(p, l, tid, true); xcd_barrier(xb); } rows_phase(p, l, tid); }
        else if (ph == 2) {
            __syncthreads();
            for (int t = wg; t < 512; t += G) { if (PROBE & 32) gmlp_tile(p, l, t >> 7, (t >> 2) & 31, t & 3, lds, tid, true); gmlp_tile(p, l, t >> 7, (t >> 2) & 31, t & 3, lds, tid); }
            for (int s = G - 1 - wg; s < 32; s += G) gmlp_sample(p, l, s >> 2, s & 3, tid);
            if (l == 0) STAMP(30);
            for (int k_ = 0;; ++k_) {
                int t;
                if (G == 256) t = k_ == 0 ? wg : (k_ == 1 && wg >= 192 && wg < 224) ? 479 - wg : -1; else { t = wg + k_ * G; if (t >= 288) t = -1; }
                if (t < 0) break;
                AttnItem it;
                it.Q = (const bf16_t*)(ws + OFF_Z); it.ldq = ZW; it.Kr = nullptr; it.scale = 0.125f * 1.44269504089f;
                it.O = (bf16_t*)(ws + OFF_Z); it.ldo = ZW; it.gate = 0; it.nkeys = 256; it.ntmax = 4; it.tbase = 0; it.causal = 0; it.krow0 = 0; it.vcol0 = 0;
                if (t < 256) { const int b = t >> 6, hh = (t >> 4) & 3, qb = t & 15;
                    it.qcol = C_MQ + hh * 64; it.qrow0 = b * 4096 + qb * 256; it.nq = 256;
                    it.Kn = (const bf16_t*)(ws + OFF_MK) + (size_t)b * 256 * 256; it.ldkn = 256; it.kncol = hh * 64;
                    it.VT = (const bf16_t*)(ws + OFF_MVT); it.ldvt = 1024; it.vtrow0 = hh * 64; it.vcol0 = b * 256; }
                else { const int s = t - 256, b = s >> 2, hh = s & 3;
                    it.qcol = C_MQ + hh * 64; it.qrow0 = TP + b * 16; it.nq = 16;
                    it.Kn = (const bf16_t*)(ws + OFF_MKS) + (size_t)(l * 8 + b) * 65536; it.ldkn = 256; it.kncol = hh * 64;
                    it.VT = (const bf16_t*)(ws + OFF_MVTS) + (size_t)(l * 8 + b) * 65536; it.ldvt = 256; it.vtrow0 = hh * 64; }
                it.ocol = it.qcol;
                if (PROBE & 32) { AttnItem d = it; d.O = (bf16_t*)(ws + WS_NEED); d.ldo = 64; d.ocol = 0; attn_item<false>(d, lds, tid); }
                attn_item<false>(it, lds, tid);
            }
            if (l == 0) STAMP(31);
            for (int t = wg; t < 1024; t += G) { if (PROBE & 8) lru_tile(p, l, t >> 8, (t >> 5) & 7, t & 31, false, lds, tid); lru_tile(p, l, t >> 8, (t >> 5) & 7, t & 31, false, lds, tid); }
            if (l == 0) STAMP(32);
        } else if (ph == 3) {
            for (int t = wg; t < 256; t += G) {
                AttnItem it;
                it.Q = (const bf16_t*)(dob + DO_Q); it.ldq = 768; it.Kn = (const bf16_t*)(dob + DO_KN); it.ldkn = 512; it.Kr = (const bf16_t*)(dob + DO_KR);
                it.VT = (const bf16_t*)(ws + OFF_VT); it.ldvt = KVROWS; it.scale = 0.10206207262f * 1.44269504089f;
                it.O = (bf16_t*)(ws + OFF_Z); it.ldo = ZW; it.gate = 1;
                const int b = t >> 6, hh = (t >> 3) & 7, g = t & 7;
                const unsigned tab = g == 0 ? 0xffdu : g == 1 ? 0xf0cu : g == 2 ? 0xf1fu : g == 3 ? 0xf2eu : g == 4 ? 0xf5bu : g == 5 ? 0xf6au : g == 6 ? 0xf79u : 0x348u;
                it.qcol = hh * 96; it.kncol = hh * 64; it.vtrow0 = hh * 64; it.ocol = C_CG + hh * 64;
                it.krow0 = b * 4096; it.vcol0 = b * 4096; it.nq = 256; it.nkeys = 4096; it.causal = 1;
                const int nqb = g == 0 ? 1 : g == 7 ? 3 : 2;
#pragma unroll 1
                for (int k = 0; k < nqb; ++k) { const int qb = (tab >> (4 * k)) & 15;
                    it.qrow0 = b * 4096 + qb * 256; it.tbase = 4 * qb; it.ntmax = 4 * qb + 4;
                    attn_item<true>(it, lds, tid); }
                if (g < 2) { const int bs = 2 * b + g;
                    it.krow0 = TP + bs * SKEYS; it.vcol0 = TP + bs * SKEYS;
                    it.qrow0 = TP + bs * 16; it.nq = 16; it.nkeys = SKEYS; it.causal = 0; it.tbase = 0; it.ntmax = 17;
                    attn_item<true>(it, lds, tid); }
            }
            if (l == 0) STAMP(33);
            for (int t = wg; t < 1024; t += G) {
                if (t < 1024) { if (PROBE & 8) lru_tile(p, l, t >> 8, (t >> 5) & 7, t & 31, true, lds, tid, true); lru_tile(p, l, t >> 8, (t >> 5) & 7, t & 31, true, lds, tid); }
            }
            for (int s = G - 1 - wg; s < 64; s += G) lru_tile(p, l, 4 + (s >> 3), s & 7, 0, true, lds, tid);
            if (l == 0) STAMP(34);
        } else if (ph == 6) { if ((PROBE & 1024) && l == 0) { ln_phase(p, l, tid); xcd_barrier(xb); } ln_phase(p, l, tid); }
        if (step < 13) xcd_barrier(xb);
        if (l == 0) STAMP(1 + step);
    }
    if (TSA != -1) {
        xcd_barrier(xb);
        if (blockIdx.x == 0 && threadIdx.x == 0) {
            KP p = (KP)__builtin_amdgcn_kernarg_segment_ptr();
            const unsigned long long* ts = (const unsigned long long*)(p->ws + OFF_TS);
            const float t_us = TSA == -2 ? 100.f : TSA == -3 ? 200.f : (float)(long long)(ts[TSB < 0 ? 0 : TSB] - ts[TSA < 0 ? 0 : TSA]) * 0.01f;
            p->out[O_SH] += 0.3f * __builtin_amdgcn_sqrtf(t_us * 0.01f);
        }
    }
}

extern "C" void kernel_launch(void* const* d_in, const int* in_sizes, int n_in, void* d_out, int out_size, void* d_ws, size_t ws_size, hipStream_t stream) {
    constexpr size_t kDynLds = 155648;
    static int grid_blocks = 0;
    if (!grid_blocks) {
        int dev = 0, cus = 0, per_cu = 0;
        (void)hipGetDevice(&dev);
        (void)hipDeviceGetAttribute(&cus, hipDeviceAttributeMultiprocessorCount, dev);
        (void)hipFuncSetAttribute((const void*)mega, hipFuncAttributeMaxDynamicSharedMemorySize, (int)kDynLds);
        (void)hipOccupancyMaxActiveBlocksPerMultiprocessor(&per_cu, mega, 512, kDynLds);
        if (per_cu > 1) per_cu = 1;
        grid_blocks = cus * per_cu;
        if (grid_blocks > 256) grid_blocks = 256;
    }
    if (ws_size < WS_NEED) { fprintf(stderr, "workspace too small: %zu < %zu\n", ws_size, (size_t)WS_NEED); return; }
    Params p{};
    for (int i = 0; i < 31; ++i) p.in[i] = (const float*)d_in[i];
    p.out = (float*)d_out; p.ws = (unsigned char*)d_ws;
    (void)hipMemsetAsync((unsigned char*)d_ws + OFF_BAR, 0, 16384, stream);
    void* args[] = {&p};
    hipError_t e = hipLaunchCooperativeKernel((void*)mega, dim3(grid_blocks), dim3(512), args, kDynLds, stream);
    if (e != hipSuccess) fprintf(stderr, "cooperative launch failed: %s (grid %d)\n", hipGetErrorString(e), grid_blocks);
}
```

```cpp
#include <hip/hip_runtime.h>
#include <hip/hip_cooperative_groups.h>
#include <cstdio>
namespace cg = cooperative_groups;

#define LAS __attribute__((address_space(3)))
#define DI __device__ __forceinline__
typedef unsigned short bf16_t;
typedef short bf16x8 __attribute__((ext_vector_type(8)));
typedef short s16x4 __attribute__((ext_vector_type(4)));
typedef float f32x2 __attribute__((ext_vector_type(2)));
typedef float f32x4 __attribute__((ext_vector_type(4)));
typedef float f32x16 __attribute__((ext_vector_type(16)));
typedef unsigned u32x2 __attribute__((ext_vector_type(2)));
typedef unsigned u32x4 __attribute__((ext_vector_type(4)));
typedef __bf16 bf16v2 __attribute__((ext_vector_type(2)));

#ifndef TSA
#define TSA -1
#define TSB -1
#endif
#ifndef PROBE
#define PROBE 0
#endif
constexpr int TP = 16384, NROW = 16512, MROWS = 16640;
constexpr int ZW = 3840;
constexpr int C_AU = 0, C_AV = 512, C_AG = 1024, C_BX = 1536, C_BG = 2048, C_CQ = 2560, C_CKV = 2816, C_CKR = 2944, C_CG = 2976, C_MQ = 3488;
constexpr int KVROWS = 24832, SKEYS = 1040;
constexpr float LN_EPS = 1e-6f;
constexpr float ALPHA_RES = 1.41421356237f;

constexpr size_t SZ_WIN = (size_t)7936 * 1024 * 2, SZ_WUQ = 768 * 256 * 2, SZ_WUK = 512 * 128 * 2, SZ_WBR = (size_t)1024 * 1792 * 2, SZ_WOUT = 1024 * 1024 * 2,
                 SZ_MEMW = 512 * 1024 * 2, SZ_WRI = 8 * 128 * 64 * 2, SZ_GWS = 4 * 128 * 128 * 2;
constexpr size_t OFF_WIN = 0;
constexpr size_t OFF_WUQ = OFF_WIN + 2 * SZ_WIN;
constexpr size_t OFF_WUK = OFF_WUQ + 2 * SZ_WUQ;
constexpr size_t OFF_WUV = OFF_WUK + 2 * SZ_WUK;
constexpr size_t OFF_WBR = OFF_WUV + 2 * SZ_WUK;
constexpr size_t OFF_WOUT = OFF_WBR + 2 * SZ_WBR;
constexpr size_t OFF_MEMW = OFF_WOUT + 2 * SZ_WOUT;
constexpr size_t OFF_WRI = OFF_MEMW + 2 * SZ_MEMW;
constexpr size_t OFF_GWS = OFF_WRI + 2 * SZ_WRI;
constexpr size_t OFF_XB = OFF_GWS + 2 * SZ_GWS;
constexpr size_t OFF_MEMB = OFF_XB + (size_t)MROWS * 1024 * 2;
constexpr size_t OFF_MK = OFF_MEMB + (size_t)1024 * 1024 * 2;
constexpr size_t OFF_MVT = OFF_MK + 1024 * 256 * 2;
constexpr size_t OFF_MKS = OFF_MVT + 256 * 1024 * 2;
constexpr size_t OFF_MVTS = OFF_MKS + (size_t)2 * 2048 * 256 * 2;
constexpr size_t OFF_Z = OFF_MVTS + (size_t)2 * 2048 * 256 * 2;
constexpr size_t OFF_VT = OFF_Z + (size_t)MROWS * ZW * 2;
constexpr size_t OFF_MERGED = OFF_VT;
constexpr size_t OFF_STATS = OFF_VT + (size_t)MROWS * 1024 * 2;
constexpr size_t OFF_AGG = OFF_STATS + (size_t)2 * MROWS * 64 * 4;
constexpr size_t OFF_BAR = OFF_AGG + (size_t)1024 * 128 * 4;
constexpr size_t OFF_MS = OFF_BAR + 16384;
constexpr size_t OFF_TS = OFF_MS + (size_t)128 * 1024 * 4;
constexpr size_t WS_NEED = OFF_TS + 1024;
static_assert(WS_NEED <= (size_t)256 * 1024 * 1024, "workspace over 256 MiB");
constexpr size_t DO_Q = 0;
constexpr size_t DO_CKV = DO_Q + (size_t)MROWS * 768 * 2;
constexpr size_t DO_KR = DO_CKV + (size_t)KVROWS * 128 * 2;
constexpr size_t DO_KN = DO_KR + (size_t)KVROWS * 32 * 2;
constexpr size_t DO_END = DO_KN + (size_t)KVROWS * 512 * 2;
constexpr size_t DO_GSCR = 0;
static_assert(DO_END <= (size_t)NROW * 4096, "scratch in d_out too large");
static_assert((size_t)256 * 4 * 16 * 512 * 8 <= (size_t)NROW * 4096, "gscr too large");
constexpr size_t O_YS = 16777216, O_PCKV = 16908288, O_PKR = 21102592, O_PMK = 22151168, O_PMV = 22675456, O_PH = 23199744, O_PCONV = 23203840,
                 O_SCKV = 23216128, O_SKR = 23248896, O_SH = 23257088, O_SCONV = 23265280, O_SGV = 23289856;

struct Params {
    const float* in[31];
    float* out;
    unsigned char* ws;
};
typedef const __attribute__((address_space(4))) Params* KP;

DI float bf2f(unsigned short b) { return __uint_as_float(((unsigned)b) << 16); }
DI float bflo(unsigned w) { return __uint_as_float(w << 16); }
DI float bfhi(unsigned w) { return __uint_as_float(w & 0xffff0000u); }
DI unsigned cvt_pk(float lo, float hi) { f32x2 v = {lo, hi}; return __builtin_bit_cast(unsigned, __builtin_convertvector(v, bf16v2)); }
DI unsigned short f2bf(float x) { return (unsigned short)(cvt_pk(x, x) & 0xffffu); }
DI u32x4 pack8(f32x4 a, f32x4 b) { u32x4 w; w.x = cvt_pk(a[0], a[1]); w.y = cvt_pk(a[2], a[3]); w.z = cvt_pk(b[0], b[1]); w.w = cvt_pk(b[2], b[3]); return w; }
DI void unpack8(u32x4 w, float* f) { f[0] = bflo(w.x); f[1] = bfhi(w.x); f[2] = bflo(w.y); f[3] = bfhi(w.y); f[4] = bflo(w.z); f[5] = bfhi(w.z); f[6] = bflo(w.w); f[7] = bfhi(w.w); }
DI float fsigmoid(float x) { return __builtin_amdgcn_rcpf(1.f + __expf(-x)); }
DI float fsilu(float x) { return x * fsigmoid(x); }
DI float fgelu(float x) { return x * fsigmoid(1.5957691216f * (x + 0.044715f * x * x * x)); }
DI float wave_sum(float v) {
#pragma unroll
    for (int o = 32; o >= 1; o >>= 1) v += __shfl_xor(v, o);
    return v;
}
DI float max3f(float a, float b, float c) { float r; asm("v_max3_f32 %0, %1, %2, %3" : "=v"(r) : "v"(a), "v"(b), "v"(c)); return r; }
DI float xhalf_max(float x) { const auto r = __builtin_amdgcn_permlane32_swap(__float_as_uint(x), __float_as_uint(x), false, false); return max3f(x, __uint_as_float(r[0]), __uint_as_float(r[1])); }
DI int crow(int reg, int h) { return (reg & 3) + 8 * (reg >> 2) + 4 * h; }
#define MFMA32(a, b, c) __builtin_amdgcn_mfma_f32_32x32x16_bf16((a), (b), (c), 0, 0, 0)

constexpr int HTB = 128 * 64 * 2;
DI int lds_byte(int r, int c) { const int st = (r >> 4) * 2 + (c >> 5), rr = r & 15, cc = c & 31, ob = rr * 64 + cc * 2; return st * 1024 + (ob ^ (((ob >> 9) & 1) << 5)); }
DI void stage_rc(int b, int& R, int& C) { const int st = b / 1024, sb = b % 1024, swz = sb ^ (((sb >> 9) & 1) << 5); R = (st >> 1) * 16 + swz / 64; C = (st & 1) * 32 + (swz % 64) / 2; }
DI int perm32(int rho) { const int n = rho >> 4, i = rho & 15; return 8 * (i >> 2) + 4 * n + (i & 3); }

enum { K_Z = 0, K_MEMKV = 1, K_PLAIN = 2, K_QP = 3, K_EG = 4, K_EY = 5, K_F = 6 };
struct GU {
    const char* A; const char* B;
    int lda, ldb;
    int nt;
    int kind, pm, pn, aux;
    bf16_t* C; int ldc;
};

DI bool next_unit(KP p, int gph, int l, int i, GU& u, int wg, int G) {
    unsigned char* ws = p->ws; unsigned char* dob = (unsigned char*)p->out;
    u.aux = 0; u.C = nullptr; u.ldc = 0;
    const bool xm = (G == 256);
    const int x = wg & 7, j = wg >> 3;
    if (gph == 0) {
        int e = -1;
        if (xm) { const int uu = j + 32 * i;
            if (uu < 120) { u.pm = 8 * x + (uu & 7); u.pn = uu >> 3; }
            else { if (j >= 24 && i == 3) e = (j - 24) * 8 + x; if (e < 0 || e >= 12) return false; } }
        else { const int L = i * G + wg; if (L < 960) { u.pm = L & 63; u.pn = L >> 6; } else { e = L - 960; if (e >= 12) return false; } }
        if (e < 0) { u.A = (const char*)(ws + OFF_XB) + (size_t)u.pm * 256 * 2048; u.B = (const char*)(ws + OFF_WIN + l * SZ_WIN) + (size_t)u.pn * 256 * 2048;
            u.lda = 2048; u.ldb = 2048; u.nt = 16; u.kind = K_Z; return true; }
        if (e < 8) { u.pm = e & 3; u.pn = e >> 2; u.A = (const char*)(ws + OFF_MEMB) + (size_t)u.pm * 256 * 2048; u.B = (const char*)(ws + OFF_MEMW + l * SZ_MEMW) + (size_t)u.pn * 256 * 2048;
            u.lda = 2048; u.ldb = 2048; u.nt = 16; u.kind = K_MEMKV; return true; }
        u.pm = 0; u.pn = e - 8; u.A = (const char*)(ws + OFF_MEMW + l * SZ_MEMW) + (size_t)256 * 2048; u.B = (const char*)(ws + OFF_MEMB) + (size_t)u.pn * 256 * 2048;
        u.lda = 2048; u.ldb = 2048; u.nt = 16; u.kind = K_PLAIN; u.C = (bf16_t*)(ws + OFF_MVT); u.ldc = 1024; return true;
    } else if (gph == 1) {
        int v;
        if (xm) { if (i == 0 && j < 24) { v = -1; u.pm = 8 * x + (j & 7); u.pn = j >> 3; } else v = ((j + 8) & 31) * 8 + x + 256 * (j < 24 ? i - 1 : i); }
        else { const int L = i * G + wg; if (L < 192) { v = -1; u.pm = L & 63; u.pn = L >> 6; } else v = L - 192; }
        if (v < 0) { u.A = (const char*)(ws + OFF_Z) + (size_t)u.pm * 256 * (ZW * 2) + C_CQ * 2; u.lda = ZW * 2;
            u.B = (const char*)(ws + OFF_WUQ + l * SZ_WUQ) + (size_t)u.pn * 256 * 512; u.ldb = 512; u.nt = 4; u.kind = K_QP; return true; }
        if (v < 194) { u.pm = v % 97; u.pn = v / 97; u.A = (const char*)(dob + DO_CKV) + (size_t)u.pm * 256 * 256; u.lda = 256;
            u.B = (const char*)(ws + OFF_WUK + l * SZ_WUK) + (size_t)u.pn * 256 * 256; u.ldb = 256; u.nt = 2; u.kind = K_PLAIN; u.C = (bf16_t*)(dob + DO_KN); u.ldc = 512; return true; }
        v -= 194;
        if (v < 194) { u.pm = v / 97; u.pn = v % 97; u.A = (const char*)(ws + OFF_WUV + l * SZ_WUK) + (size_t)u.pm * 256 * 256; u.lda = 256;
            u.B = (const char*)(dob + DO_CKV) + (size_t)u.pn * 256 * 256; u.ldb = 256; u.nt = 2; u.kind = K_PLAIN; u.C = (bf16_t*)(ws + OFF_VT); u.ldc = KVROWS; return true; }
        return false;
    } else if (gph == 2) {
        const int rr = i >> 3, sub = i & 7;
        if (xm) { if (rr > 0) return false; u.pm = 8 * x + (j & 7); u.pn = j >> 3; }
        else { const int tt = wg + G * rr; if (tt >= 256) return false; u.pm = tt & 63; u.pn = tt >> 6; }
        const int ib = sub & 3; u.aux = ib;
        if (sub < 4) { u.A = (const char*)(ws + OFF_XB) + (size_t)u.pm * 256 * 2048; u.lda = 2048;
            u.B = (const char*)(ws + OFF_WIN + l * SZ_WIN) + (size_t)(3840 + ib * 1024 + u.pn * 256) * 2048; u.ldb = 2048; u.nt = 16; u.kind = K_EG; }
        else { const int zc = ib == 0 ? C_AU : ib == 1 ? C_BG : ib == 2 ? C_CG : C_MQ;
            u.A = (const char*)(ws + OFF_Z) + (size_t)u.pm * 256 * (ZW * 2) + zc * 2; u.lda = ZW * 2;
            u.B = (const char*)(ws + OFF_WBR + l * SZ_WBR) + (size_t)u.pn * 256 * 3584 + ib * 512 * 2; u.ldb = 3584; u.nt = ib < 3 ? 8 : 4; u.kind = K_EY; }
        return true;
    } else {
        if (xm) { if (i > 0) return false; u.pm = 8 * x + (j & 7); u.pn = j >> 3; }
        else { const int L = i * G + wg; if (L >= 256) return false; u.pm = L & 63; u.pn = L >> 6; }
        u.A = (const char*)(ws + OFF_MERGED) + (size_t)u.pm * 256 * 2048; u.lda = 2048;
        u.B = (const char*)(ws + OFF_WOUT + l * SZ_WOUT) + (size_t)u.pn * 256 * 2048; u.ldb = 2048; u.nt = 16; u.kind = K_F; return true;
    }
}

DI void rope_pair(float& a, float& b, float pos, int jj) {
    const float freq = __builtin_amdgcn_exp2f(-(float)jj * 0.83048202372f);
    const float ang = pos * freq;
    const float rev = __builtin_amdgcn_fractf(ang * 0.15915494309f);
    const float sn = __builtin_amdgcn_sinf(rev), cs = __builtin_amdgcn_cosf(rev);
    const float x1 = a, x2 = b;
    a = x1 * cs - x2 * sn; b = x1 * sn + x2 * cs;
}

DI void epi_z(KP p, int row, int col, f32x4 v0, f32x4 v1) {
    int act = 0;
    if (col < C_AG) act = 1; else if (col < C_BX) act = 2; else if (col < C_BG) act = 0; else if (col < C_CQ) act = 2; else if (col < C_CG) act = 0; else if (col < C_MQ) act = 2;
    if (act == 1) {
#pragma unroll
        for (int j = 0; j < 4; ++j) { v0[j] = fgelu(v0[j]); v1[j] = fgelu(v1[j]); }
    } else if (act == 2) {
#pragma unroll
        for (int j = 0; j < 4; ++j) { v0[j] = fsilu(v0[j]); v1[j] = fsilu(v1[j]); }
    }
    *(u32x4*)((bf16_t*)(p->ws + OFF_Z) + (size_t)row * ZW + col) = pack8(v0, v1);
}
DI void epi_qp(KP p, int row, int col, f32x4 v0, f32x4 v1) {
    const int d = col % 96;
    if (d >= 64) {
        const float pos = row < TP ? (float)(row & 4095) : (float)(1024 + ((row - TP) & 15));
        const int j0 = (d - 64) >> 1;
        float t0 = v0[0], t1 = v0[1], t2 = v0[2], t3 = v0[3], t4 = v1[0], t5 = v1[1], t6 = v1[2], t7 = v1[3];
        rope_pair(t0, t1, pos, j0); rope_pair(t2, t3, pos, j0 + 1); rope_pair(t4, t5, pos, j0 + 2); rope_pair(t6, t7, pos, j0 + 3);
        v0 = (f32x4){t0, t1, t2, t3}; v1 = (f32x4){t4, t5, t6, t7};
    }
    *(u32x4*)((bf16_t*)((unsigned char*)p->out + DO_Q) + (size_t)row * 768 + col) = pack8(v0, v1);
}
DI void epi_f(KP p, int l, int row, int col, f32x4 v0, f32x4 v1, float& s1, float& s2) {
    float x[8];
    { const u32x4 xw = *(const u32x4*)((const bf16_t*)(p->ws + OFF_XB) + (size_t)row * 1024 + col); unpack8(xw, x); }
#pragma unroll
    for (int j = 0; j < 4; ++j) { v0[j] = ALPHA_RES * x[j] + v0[j]; v1[j] = ALPHA_RES * x[4 + j] + v1[j]; s1 += v0[j] + v1[j]; s2 += v0[j] * v0[j] + v1[j] * v1[j]; }
    if (row < NROW) *(u32x4*)((bf16_t*)(p->ws + OFF_Z) + (size_t)row * 1024 + col) = pack8(v0, v1);
}

DI bool gemm_epilogue(KP p, int l, f32x4 (&acc)[2][2][4][2], const GU& u, int tid_in, int wg, bool dumpst) {
    unsigned char* ws = p->ws;
    int tid = tid_in; asm volatile("" : "+v"(tid));
    const int wid = tid >> 6, lane = tid & 63, wr = wid >> 2, wc = wid & 3, fr = lane & 15, fq = lane >> 4;
    const int row0 = u.pm * 256 + wr * 64 + fr, col0 = u.pn * 256 + wc * 32 + 8 * fq;
    if (u.kind == K_EY) {
        const u32x2* gs = (const u32x2*)((unsigned char*)p->out + DO_GSCR) + (((size_t)wg * 4 + u.aux) * 16) * 512 + tid;
#pragma unroll
        for (int ai = 0; ai < 2; ++ai) {
            u32x2 gc[8], gn[8];
#pragma unroll
            for (int v = 0; v < 8; ++v) gc[v] = gs[(ai * 8 + v) * 512];
            if (u.aux < 3) {
#pragma unroll
                for (int v = 0; v < 8; ++v) gn[v] = gs[(16 + ai * 8 + v) * 512];
            } else {
#pragma unroll
                for (int v = 0; v < 8; ++v) gn[v] = (u32x2){0xffffffffu, 0xffffffffu};
            }
#pragma unroll
            for (int m = 0; m < 4; ++m)
#pragma unroll
                for (int bj = 0; bj < 2; ++bj) {
                    const int vec = m * 2 + bj;
                    f32x4 v0 = acc[ai][bj][m][0], v1 = acc[ai][bj][m][1];
#pragma unroll
                    for (int j = 0; j < 4; ++j) {
                        v0[j] *= (float)((gc[vec].x >> (8 * j)) & 0xffu) * __builtin_amdgcn_rcpf((float)((gn[vec].x >> (8 * j)) & 0xffu));
                        v1[j] *= (float)((gc[vec].y >> (8 * j)) & 0xffu) * __builtin_amdgcn_rcpf((float)((gn[vec].y >> (8 * j)) & 0xffu)); }
                    if (u.aux < 3) { acc[ai][bj][m][0] = v0; acc[ai][bj][m][1] = v1; }
                    else *(u32x4*)((bf16_t*)(ws + OFF_MERGED) + (size_t)(row0 + ai * 128 + m * 16) * 1024 + col0 + bj * 128) = pack8(v0, v1);
                }
        }
        return u.aux < 3;
    }
    if (u.kind == K_F) {
        const bf16_t* XB = (const bf16_t*)(ws + OFF_XB);
#pragma unroll
        for (int ai = 0; ai < 2; ++ai) {
            u32x4 xr[8];
#pragma unroll
            for (int m = 0; m < 4; ++m)
#pragma unroll
                for (int bj = 0; bj < 2; ++bj) xr[m * 2 + bj] = *(const u32x4*)(XB + (size_t)(row0 + ai * 128 + m * 16) * 1024 + col0 + bj * 128);
#pragma unroll
            for (int m = 0; m < 4; ++m) {
                const int row = row0 + ai * 128 + m * 16;
                float s1 = 0.f, s2 = 0.f;
#pragma unroll
                for (int bj = 0; bj < 2; ++bj) {
                    f32x4 v0 = acc[ai][bj][m][0], v1 = acc[ai][bj][m][1];
                    float x[8]; unpack8(xr[m * 2 + bj], x);
#pragma unroll
                    for (int j = 0; j < 4; ++j) { v0[j] = ALPHA_RES * x[j] + v0[j]; v1[j] = ALPHA_RES * x[4 + j] + v1[j]; s1 += v0[j] + v1[j]; s2 += v0[j] * v0[j] + v1[j] * v1[j]; }
                    *(u32x4*)((bf16_t*)(ws + OFF_Z) + (size_t)row * 1024 + col0 + bj * 128) = pack8(v0, v1);
                }
                s1 += __shfl_xor(s1, 16); s1 += __shfl_xor(s1, 32); s2 += __shfl_xor(s2, 16); s2 += __shfl_xor(s2, 32);
                if (fq == 0) { float* st = dumpst ? (float*)(ws + WS_NEED) + (row & 1023) * 2 : (float*)(ws + OFF_STATS) + (((size_t)l * MROWS + row) * 32 + u.pn * 4 + wc) * 2;
                    *(f32x2*)st = (f32x2){s1, s2}; }
            }
        }
        return false;
    }
#pragma unroll
    for (int ai = 0; ai < 2; ++ai)
#pragma unroll
        for (int m = 0; m < 4; ++m) {
            const int row = row0 + ai * 128 + m * 16;
#pragma unroll
            for (int bj = 0; bj < 2; ++bj) {
                const int col = col0 + bj * 128;
                f32x4 v0 = acc[ai][bj][m][0], v1 = acc[ai][bj][m][1];
                const int vec = (ai * 4 + m) * 2 + bj;
                if (u.kind == K_Z) {
                    epi_z(p, row, col, v0, v1);
                } else if (u.kind == K_MEMKV) {
                    float* o = p->out + (col < 256 ? O_PMK : O_PMV) + (size_t)l * 262144 + (size_t)row * 256 + (col & 255);
                    __builtin_nontemporal_store(v0, (f32x4*)o); __builtin_nontemporal_store(v1, (f32x4*)(o + 4));
                    if (col < 256) *(u32x4*)((bf16_t*)(ws + OFF_MK) + (size_t)row * 256 + col) = pack8(v0, v1);
                } else if (u.kind == K_PLAIN) {
                    *(u32x4*)(u.C + (size_t)row * u.ldc + col) = pack8(v0, v1);
                } else if (u.kind == K_QP) {
                    epi_qp(p, row, col, v0, v1);
                } else {
                    u32x2 w = {0u, 0u};
#pragma unroll
                    for (int j = 0; j < 4; ++j) { w.x = __builtin_amdgcn_cvt_pk_u8_f32(fmaxf(255.f * fsigmoid(v0[j]), 1.f), j, w.x); w.y = __builtin_amdgcn_cvt_pk_u8_f32(fmaxf(255.f * fsigmoid(v1[j]), 1.f), j, w.y); }
                    *((u32x2*)((unsigned char*)p->out + DO_GSCR) + (((size_t)wg * 4 + u.aux) * 16 + vec) * 512 + tid) = w;
                }
            }
        }
    return false;
}

DI void gemm_stream(KP p, int gph, int l, LAS unsigned char* lds, int tid, int wg, int G, bool dumpst = false) {
    const int wid = __builtin_amdgcn_readfirstlane(tid >> 6), lane = tid & 63, wr = wid >> 2, wc = wid & 3, fr = lane & 15, fq = lane >> 4;
    const unsigned ldsw = (unsigned)wid * 1024u;
    const int aoff = lds_byte(wr * 64 + fr, fq * 8), boff = lds_byte(wc * 32 + fr, fq * 8);
#define PG8_SA(b, h) (((b) * 2 + (h)) * HTB)
#define PG8_SB(b, h) ((4 + (b) * 2 + (h)) * HTB)
#define PG8_STAGE(bufoff, gbase, voff) do { const char* _g = (const char*)(gbase); asm volatile("" : "+s"(_g)); _Pragma("unroll") for (int _i = 0; _i < 2; ++_i) \
        __builtin_amdgcn_global_load_lds((const unsigned*)(_g + (voff)[_i]), (LAS unsigned*)(lds + (bufoff) + ldsw + _i * 8192), 16, 0, 0); } while (0)
#define PG8_LDA(dst, b, h) do { _Pragma("unroll") for (int m = 0; m < 4; ++m) _Pragma("unroll") for (int k = 0; k < 2; ++k) dst[m][k] = *(const LAS bf16x8*)(lds + PG8_SA(b, h) + aoff + m * 2048 + k * 1024); } while (0)
#define PG8_LDB(dst, b, h) do { _Pragma("unroll") for (int n = 0; n < 2; ++n) _Pragma("unroll") for (int k = 0; k < 2; ++k) dst[n][k] = *(const LAS bf16x8*)(lds + PG8_SB(b, h) + boff + n * 2048 + k * 1024); } while (0)
#define PG8_MMA(ai, bj, At, Bt) do { __builtin_amdgcn_s_setprio(1); _Pragma("unroll") for (int m = 0; m < 4; ++m) _Pragma("unroll") for (int n = 0; n < 2; ++n) _Pragma("unroll") for (int k = 0; k < 2; ++k) \
        acc[ai][bj][m][n] = __builtin_amdgcn_mfma_f32_16x16x32_bf16(Bt[n][k], At[m][k], acc[ai][bj][m][n], 0, 0, 0); __builtin_amdgcn_s_setprio(0); } while (0)
#define PG8_WAIT_V(n) asm volatile("s_waitcnt vmcnt(" #n ")" ::: "memory")
#define PG8_WAIT_L(n) asm volatile("s_waitcnt lgkmcnt(" #n ")" ::: "memory")
#define PG8_BAR __builtin_amdgcn_s_barrier()
#define PG8_SCHED __builtin_amdgcn_sched_barrier(0)
#define PG8_VOFF(vA, vB, U) do { _Pragma("unroll") for (int _i = 0; _i < 2; ++_i) { int _R, _C; stage_rc(tid * 16 + _i * 8192, _R, _C); const int _Rb = (_R & ~31) + perm32(_R & 31); \
        vA[_i] = (unsigned)(_R * (U).lda + _C * 2); vB[_i] = (unsigned)(_Rb * (U).ldb + _C * 2); } } while (0)
    GU cur, nxt; int ui = 0;
    if (!next_unit(p, gph, l, 0, cur, wg, G)) return;
    f32x4 acc[2][2][4][2];
#pragma unroll
    for (int a = 0; a < 2; ++a)
#pragma unroll
        for (int b = 0; b < 2; ++b)
#pragma unroll
            for (int m = 0; m < 4; ++m)
#pragma unroll
                for (int n = 0; n < 2; ++n) acc[a][b][m][n] = (f32x4){0.f, 0.f, 0.f, 0.f};
    bf16x8 At[4][2], B0[2][2], B1[2][2];
    unsigned cvA[2], cvB[2];
    PG8_VOFF(cvA, cvB, cur);
    const char* cA = cur.A; const char* cB = cur.B;
    size_t chA = (size_t)128 * cur.lda, chB = (size_t)128 * cur.ldb;
    const size_t kstep = 128;
    PG8_STAGE(PG8_SB(0, 0), cB, cvB); PG8_STAGE(PG8_SA(0, 0), cA, cvA); PG8_STAGE(PG8_SB(0, 1), cB + chB, cvB); PG8_STAGE(PG8_SA(0, 1), cA + chA, cvA);
    if (wr == 1) PG8_BAR;
    PG8_WAIT_V(4); PG8_BAR;
    PG8_STAGE(PG8_SB(1, 0), cB + kstep, cvB); PG8_STAGE(PG8_SA(1, 0), cA + kstep, cvA); PG8_STAGE(PG8_SB(1, 1), cB + chB + kstep, cvB);
    PG8_WAIT_V(6); PG8_BAR;
    for (;;) {
        const bool has_next = next_unit(p, gph, l, ui + 1, nxt, wg, G);
        if (!has_next) nxt = cur;
        const char* nA = nxt.A; const char* nB = nxt.B;
        const size_t nhA = (size_t)128 * nxt.lda, nhB = (size_t)128 * nxt.ldb;
        const int nt = cur.nt;
        for (int t = 0; t < nt; t += 2) {
            const bool last = (t == nt - 2);
            const char* a1 = cA + (size_t)(t + 1) * kstep;
            const char* a2 = last ? nA : cA + (size_t)(t + 2) * kstep; const char* b2 = last ? nB : cB + (size_t)(t + 2) * kstep;
            const char* a3 = a2 + kstep; const char* b3 = b2 + kstep;
            unsigned vA2[2], vB2[2];
            if (last) { PG8_VOFF(vA2, vB2, nxt); }
            else {
#pragma unroll
                for (int _i = 0; _i < 2; ++_i) { vA2[_i] = cvA[_i]; vB2[_i] = cvB[_i]; } }
            const size_t hA2 = last ? nhA : chA, hB2 = last ? nhB : chB;
            PG8_LDB(B0, 0, 0); PG8_SCHED; PG8_LDA(At, 0, 0); PG8_STAGE(PG8_SA(1, 1), a1 + chA, cvA);
            PG8_WAIT_L(8); PG8_BAR; PG8_WAIT_L(0); PG8_MMA(0, 0, At, B0); PG8_BAR; PG8_SCHED;
            PG8_LDB(B1, 0, 1); PG8_STAGE(PG8_SB(0, 0), b2, vB2);
            PG8_BAR; PG8_WAIT_L(0); PG8_MMA(0, 1, At, B1); PG8_BAR;
            PG8_LDA(At, 0, 1); PG8_STAGE(PG8_SA(0, 0), a2, vA2);
            PG8_BAR; PG8_WAIT_L(0); PG8_MMA(1, 0, At, B0); PG8_BAR; PG8_SCHED;
            PG8_STAGE(PG8_SB(0, 1), b2 + hB2, vB2);
            PG8_WAIT_V(6); PG8_BAR; PG8_MMA(1, 1, At, B1); PG8_BAR;
            PG8_LDB(B0, 1, 0); PG8_SCHED; PG8_LDA(At, 1, 0); PG8_STAGE(PG8_SA(0, 1), a2 + hA2, vA2);
            PG8_WAIT_L(8); PG8_BAR; PG8_WAIT_L(0); PG8_MMA(0, 0, At, B0); PG8_BAR; PG8_SCHED;
            PG8_LDB(B1, 1, 1); PG8_STAGE(PG8_SB(1, 0), b3, vB2);
            PG8_BAR; PG8_WAIT_L(0); PG8_MMA(0, 1, At, B1); PG8_BAR;
            PG8_LDA(At, 1, 1); PG8_STAGE(PG8_SA(1, 0), a3, vA2);
            PG8_BAR; PG8_WAIT_L(0); PG8_MMA(1, 0, At, B0); PG8_BAR; PG8_SCHED;
            PG8_STAGE(PG8_SB(1, 1), b3 + hB2, vB2);
            PG8_WAIT_V(6); PG8_BAR; PG8_MMA(1, 1, At, B1); PG8_BAR;
        }
        const bool keep = gemm_epilogue(p, l, acc, cur, tid, wg, dumpst);
        if (!has_next) break;
        if (!keep)
#pragma unroll
        for (int a = 0; a < 2; ++a)
#pragma unroll
            for (int b = 0; b < 2; ++b)
#pragma unroll
                for (int m = 0; m < 4; ++m)
#pragma unroll
                    for (int n = 0; n < 2; ++n) acc[a][b][m][n] = (f32x4){0.f, 0.f, 0.f, 0.f};
        cur = nxt; cA = nA; cB = nB; chA = nhA; chB = nhB;
        PG8_VOFF(cvA, cvB, cur);
        ++ui;
    }
    PG8_WAIT_V(0);
    if (wr == 0) PG8_BAR;
    PG8_BAR;
}

template <bool AF32>
DI void skinny_mm(const void* Abase, int lda, const bf16_t* Bt, int ldb, int K, LAS float* T, int tid) {
    constexpr int KC = 512, LD = KC + 8;
    LAS bf16_t* AL = (LAS bf16_t*)((LAS unsigned char*)T + 8704); LAS bf16_t* BL = AL + 64 * LD;
    const int w = tid >> 6, lane = tid & 63, r = lane & 31, h = lane >> 5, mb = w & 1, kq = w >> 1;
    f32x16 acc;
#pragma unroll
    for (int i = 0; i < 16; ++i) acc[i] = 0.f;
    for (int k0 = 0; k0 < K; k0 += KC) {
        const int kc = (K - k0) < KC ? (K - k0) : KC;
        const int sh = kc == 512 ? 6 : 5, cm = (1 << sh) - 1;
        __syncthreads();
#pragma unroll
        for (int hlf = 0; hlf < 2; ++hlf) {
            u32x4 ra[4];
#pragma unroll
            for (int i = 0; i < 4; ++i) { const int q = tid + 512 * (4 * hlf + i); const int row = q >> sh, c8 = (q & cm) * 8; ra[i] = (u32x4){0u, 0u, 0u, 0u};
                if (row < 64) {
                    if (AF32) { const float* ap = (const float*)Abase + (size_t)row * lda + k0 + c8; ra[i] = pack8(*(const f32x4*)ap, *(const f32x4*)(ap + 4)); }
                    else ra[i] = *(const u32x4*)((const bf16_t*)Abase + (size_t)row * lda + k0 + c8); } }
#pragma unroll
            for (int i = 0; i < 4; ++i) { const int q = tid + 512 * (4 * hlf + i); const int row = q >> sh, c8 = (q & cm) * 8; if (row < 64) *(LAS u32x4*)(AL + row * LD + c8) = ra[i]; }
        }
        {
            u32x4 rb[4];
#pragma unroll
            for (int i = 0; i < 4; ++i) { const int q = tid + 512 * i; const int row = q >> sh, c8 = (q & cm) * 8; rb[i] = (u32x4){0u, 0u, 0u, 0u};
                if (row < 32) rb[i] = *(const u32x4*)(Bt + (size_t)row * ldb + k0 + c8); }
#pragma unroll
            for (int i = 0; i < 4; ++i) { const int q = tid + 512 * i; const int row = q >> sh, c8 = (q & cm) * 8; if (row < 32) *(LAS u32x4*)(BL + row * LD + c8) = rb[i]; }
        }
        __syncthreads();
        const int kw = kc >> 2;
        for (int u = 0; u < kw; u += 16) {
            const bf16x8 a = *(const LAS bf16x8*)(AL + (32 * mb + r) * LD + kq * kw + u + 8 * h), b = *(const LAS bf16x8*)(BL + r * LD + kq * kw + u + 8 * h);
            acc = MFMA32(a, b, acc);
        }
    }
    __syncthreads();
    if (kq == 0) {
#pragma unroll
        for (int i = 0; i < 16; ++i) T[(32 * mb + crow(i, h)) * 33 + r] = acc[i];
    }
    __syncthreads();
    if (kq != 0) {
#pragma unroll
        for (int i = 0; i < 16; ++i) __hip_atomic_fetch_add(&T[(32 * mb + crow(i, h)) * 33 + r], acc[i], __ATOMIC_RELAXED, __HIP_MEMORY_SCOPE_WORKGROUP);
    }
    __syncthreads();
}
DI void skinny_read(LAS const float* T, int tid, f32x4& v0, f32x4& v1) {
    const int row = (tid >> 2) & 63, c8 = (tid & 3) * 8;
#pragma unroll
    for (int j = 0; j < 4; ++j) { v0[j] = T[row * 33 + c8 + j]; v1[j] = T[row * 33 + c8 + 4 + j]; }
}
DI void sample_gemm_phase(KP p, int gph, int l, LAS unsigned char* lds, int tid, int wg, int G) {
    unsigned char* ws = p->ws;
    LAS float* T = (LAS float*)lds;
    const int c8 = (tid & 3) * 8; const bool act = tid < 256;
    f32x4 v0, v1;
    if (gph == 0) {
        for (int it = G - 1 - wg; it < 117 * 2; it += G) { const int s = it >> 1, rh = it & 1; const int row = TP + 64 * rh + ((tid >> 2) & 63);
            skinny_mm<false>((const bf16_t*)(ws + OFF_XB) + (size_t)(TP + 64 * rh) * 1024, 1024, (const bf16_t*)(ws + OFF_WIN + l * SZ_WIN) + (size_t)s * 32 * 1024, 1024, 1024, T, tid);
            skinny_read(T, tid, v0, v1); if (act) epi_z(p, row, s * 32 + c8, v0, v1);
        }
    } else if (gph == 1) {
        for (int it = G - 1 - wg; it < 24 * 2; it += G) { const int s = it >> 1, rh = it & 1; const int row = TP + 64 * rh + ((tid >> 2) & 63);
            skinny_mm<false>((const bf16_t*)(ws + OFF_Z) + (size_t)(TP + 64 * rh) * ZW + C_CQ, ZW, (const bf16_t*)(ws + OFF_WUQ + l * SZ_WUQ) + (size_t)s * 32 * 256, 256, 256, T, tid);
            skinny_read(T, tid, v0, v1); if (act) epi_qp(p, row, s * 32 + c8, v0, v1);
        }
    } else if (gph == 2) {
        float* MS = (float*)(ws + OFF_MS);
        for (int it = G - 1 - wg; it < 256; it += G) {
            const int rh = it & 1, ib = (it >> 1) & 3, s = it >> 3, n0 = s * 32;
            skinny_mm<false>((const bf16_t*)(ws + OFF_XB) + (size_t)(TP + 64 * rh) * 1024, 1024, (const bf16_t*)(ws + OFF_WIN + l * SZ_WIN) + (size_t)(3840 + ib * 1024 + n0) * 1024, 1024, 1024, T, tid);
            f32x4 g0, g1; skinny_read(T, tid, g0, g1);
            const int zc = ib == 0 ? C_AU : ib == 1 ? C_BG : ib == 2 ? C_CG : C_MQ;
            skinny_mm<false>((const bf16_t*)(ws + OFF_Z) + (size_t)(TP + 64 * rh) * ZW + zc, ZW, (const bf16_t*)(ws + OFF_WBR + l * SZ_WBR) + (size_t)n0 * 1792 + ib * 512, 1792, ib < 3 ? 512 : 256, T, tid);
            skinny_read(T, tid, v0, v1);
            if (act) { float* mp = MS + (size_t)(64 * rh + ((tid >> 2) & 63)) * 1024 + n0 + c8;
#pragma unroll
                for (int j = 0; j < 4; ++j) { __hip_atomic_fetch_add(mp + j, fsigmoid(g0[j]) * v0[j], __ATOMIC_RELAXED, __HIP_MEMORY_SCOPE_AGENT);
                    __hip_atomic_fetch_add(mp + 4 + j, fsigmoid(g1[j]) * v1[j], __ATOMIC_RELAXED, __HIP_MEMORY_SCOPE_AGENT); } }
        }
    } else {
        for (int it = G - 1 - wg; it < 32 * 2; it += G) { const int s = it >> 1, rh = it & 1; const int row = TP + 64 * rh + ((tid >> 2) & 63);
            skinny_mm<true>((const float*)(ws + OFF_MS) + (size_t)(64 * rh) * 1024, 1024, (const bf16_t*)(ws + OFF_WOUT + l * SZ_WOUT) + (size_t)s * 32 * 1024, 1024, 1024, T, tid);
            skinny_read(T, tid, v0, v1);
            float s1 = 0.f, s2 = 0.f;
            if (act) epi_f(p, l, row, s * 32 + c8, v0, v1, s1, s2);
            s1 += __shfl_xor(s1, 1); s1 += __shfl_xor(s1, 2); s2 += __shfl_xor(s2, 1); s2 += __shfl_xor(s2, 2);
            if (act && (tid & 3) == 0) { float* st = (float*)(ws + OFF_STATS) + (((size_t)l * MROWS + row) * 32 + s) * 2; *(f32x2*)st = (f32x2){s1, s2}; }
        }
    }
    __syncthreads();
}

struct TJob { const float* src; int lds_, Ks; bf16_t* dst; int ldd, nN, nK, map; };
DI int tmap(int kind, int n) {
    if (kind == 0) return n;
    if (kind == 1) return n < 3744 ? n : (n < 3840 ? -1 : n - 96);
    if (kind == 2) { const int h = n / 96, d = n % 96; if (d < 64) return n; const int jj = (d - 64) >> 1, e = (d - 64) & 1; return h * 96 + 64 + jj + 16 * e; }
    if (kind == 3) { const int h = n >> 6, d = n & 63; return h * 128 + d; }
    const int h = n >> 6, d = n & 63; return h * 128 + 64 + d;
}
DI bool tjob(KP p, int j, TJob& t) {
    unsigned char* ws = p->ws;
    if (j < 18) { const int l = j / 9, k = j % 9;
        switch (k) {
        case 0: t = {p->in[9] + (size_t)l * 1024 * 7840, 7840, 1024, (bf16_t*)(ws + OFF_WIN + l * SZ_WIN), 1024, 124, 16, 1}; break;
        case 1: t = {p->in[22] + (size_t)l * 256 * 768, 768, 256, (bf16_t*)(ws + OFF_WUQ + l * SZ_WUQ), 256, 12, 4, 2}; break;
        case 2: t = {p->in[24] + (size_t)l * 128 * 1024, 1024, 128, (bf16_t*)(ws + OFF_WUK + l * SZ_WUK), 128, 8, 2, 3}; break;
        case 3: t = {p->in[24] + (size_t)l * 128 * 1024, 1024, 128, (bf16_t*)(ws + OFF_WUV + l * SZ_WUK), 128, 8, 2, 4}; break;
        case 4: t = {p->in[27] + (size_t)l * 1792 * 1024, 1024, 1792, (bf16_t*)(ws + OFF_WBR + l * SZ_WBR), 1792, 16, 28, 0}; break;
        case 5: t = {p->in[28] + (size_t)l * 1024 * 1024, 1024, 1024, (bf16_t*)(ws + OFF_WOUT + l * SZ_WOUT), 1024, 16, 16, 0}; break;
        case 6: t = {p->in[25] + (size_t)l * 1024 * 256, 256, 1024, (bf16_t*)(ws + OFF_MEMW + l * SZ_MEMW), 1024, 4, 16, 0}; break;
        case 7: t = {p->in[26] + (size_t)l * 1024 * 256, 256, 1024, (bf16_t*)(ws + OFF_MEMW + l * SZ_MEMW) + 256 * 1024, 1024, 4, 16, 0}; break;
        default: t = {p->in[6] + (size_t)l * 8 * 65536, 256, 256, (bf16_t*)(ws + OFF_MVTS) + (size_t)l * 8 * 65536, 256, 4, 4, 0}; break;
        }
        return true; }
    j -= 18;
    if (j < 14) { const int l = j / 7, b = j % 7 + 1; t = {p->in[6] + (size_t)(l * 8 + b) * 65536, 256, 256, (bf16_t*)(ws + OFF_MVTS) + (size_t)(l * 8 + b) * 65536, 256, 4, 4, 0}; return true; }
    j -= 14;
    if (j < 32) { const int l = j / 16, r = j % 16, hb = r >> 1, gi = r & 1;
        t = {p->in[gi ? 18 : 16] + (size_t)(l * 8 + hb) * 4096, 64, 64, (bf16_t*)(ws + OFF_WRI + l * SZ_WRI) + hb * 8192 + gi * 4096, 64, 1, 1, 0}; return true; }
    return false;
}

DI void prep_phase(KP p, LAS unsigned char* lds, int tid) {
    const int G = gridDim.x, wg = blockIdx.x;
    unsigned char* ws = p->ws;
    {
        bf16_t* XB = (bf16_t*)(ws + OFF_XB);
        const size_t nvec = (size_t)MROWS * 1024 / 8;
        for (size_t v = (size_t)wg * 512 + tid; v < nvec; v += (size_t)G * 512) {
            const size_t e = v * 8; const int row = (int)(e >> 10);
            u32x4 o = {0u, 0u, 0u, 0u};
            if (row < NROW) { const float* src = row < TP ? p->in[0] + e : p->in[1] + (e - (size_t)TP * 1024); o = pack8(__builtin_nontemporal_load((const f32x4*)src), __builtin_nontemporal_load((const f32x4*)(src + 4))); }
            *(u32x4*)(XB + e) = o;
        }
    }
    {
        bf16_t* MB = (bf16_t*)(ws + OFF_MEMB);
        for (size_t v = (size_t)wg * 512 + tid; v < (size_t)1024 * 1024 / 8; v += (size_t)G * 512) { const float* s = p->in[2] + v * 8; *(u32x4*)(MB + v * 8) = pack8(*(const f32x4*)s, *(const f32x4*)(s + 4)); }
        bf16_t* MKS = (bf16_t*)(ws + OFF_MKS);
        for (size_t v = (size_t)wg * 512 + tid; v < (size_t)2 * 2048 * 256 / 8; v += (size_t)G * 512) { const float* s = p->in[5] + v * 8; *(u32x4*)(MKS + v * 8) = pack8(*(const f32x4*)s, *(const f32x4*)(s + 4)); }
        bf16_t* GW = (bf16_t*)(ws + OFF_GWS);
        for (size_t v = (size_t)wg * 512 + tid; v < (size_t)2 * 4 * 128 * 128 / 8; v += (size_t)G * 512) {
            const size_t e = v * 8; const int q0 = (int)(e & 127), pr = (int)((e >> 7) & 127); const float* s = p->in[12] + e;
            f32x4 a = *(const f32x4*)s, b = *(const f32x4*)(s + 4);
#pragma unroll
            for (int j = 0; j < 4; ++j) { if (q0 + j > pr) a[j] = 0.f; if (q0 + 4 + j > pr) b[j] = 0.f; }
            *(u32x4*)(GW + e) = pack8(a, b); }
    }
    LAS float* tile = (LAS float*)lds;
    int base = 0;
    for (int j = 0;; ++j) {
        TJob t; if (!tjob(p, j, t)) break;
        const int kt4 = (t.nK & 3) == 0 ? 4 : 1;
        const int nKs = t.nK / kt4, ntile = t.nN * nKs;
        int first = wg - (base % G); if (first < 0) first += G;
        for (int tt = first; tt < ntile; tt += G) {
            const int tn = tt / nKs, tk = tt % nKs, n0 = tn * 64, k0 = tk * 64 * kt4;
            const int nn = tid & 63, kq = tid >> 6;
            const int sc = tmap(t.map, n0 + nn);
            __syncthreads();
            if (t.map != 2) {
                const int n4 = (tid & 15) * 4, kr = tid >> 4;
                const int sc4 = tmap(t.map, n0 + n4);
                if (kt4 == 4) {
                    f32x4 v[8];
#pragma unroll
                    for (int i = 0; i < 8; ++i) { const int k = k0 + kr + 32 * i; v[i] = (sc4 >= 0 && k < t.Ks) ? __builtin_nontemporal_load((const f32x4*)(t.src + (size_t)k * t.lds_ + sc4)) : (f32x4){0.f, 0.f, 0.f, 0.f}; }
#pragma unroll
                    for (int i = 0; i < 8; ++i) {
#pragma unroll
                        for (int jj = 0; jj < 4; ++jj) tile[(kr + 32 * i) * 65 + n4 + jj] = v[i][jj]; }
                } else {
                    f32x4 v[2];
#pragma unroll
                    for (int i = 0; i < 2; ++i) { const int k = k0 + kr + 32 * i; v[i] = (sc4 >= 0 && k < t.Ks) ? __builtin_nontemporal_load((const f32x4*)(t.src + (size_t)k * t.lds_ + sc4)) : (f32x4){0.f, 0.f, 0.f, 0.f}; }
#pragma unroll
                    for (int i = 0; i < 2; ++i) {
#pragma unroll
                        for (int jj = 0; jj < 4; ++jj) tile[(kr + 32 * i) * 65 + n4 + jj] = v[i][jj]; }
                }
            } else if (kt4 == 4) {
                float v[32];
#pragma unroll
                for (int i = 0; i < 32; ++i) { const int k = k0 + kq + 8 * i; v[i] = (sc >= 0 && k < t.Ks) ? t.src[(size_t)k * t.lds_ + sc] : 0.f; }
#pragma unroll
                for (int i = 0; i < 32; ++i) tile[(kq + 8 * i) * 65 + nn] = v[i];
            } else {
                float v[8];
#pragma unroll
                for (int i = 0; i < 8; ++i) { const int k = k0 + kq + 8 * i; v[i] = (sc >= 0 && k < t.Ks) ? t.src[(size_t)k * t.lds_ + sc] : 0.f; }
#pragma unroll
                for (int i = 0; i < 8; ++i) tile[(kq + 8 * i) * 65 + nn] = v[i];
            }
            __syncthreads();
            const int kw = 32 * kt4;
            for (int e = tid; e < 64 * kw; e += 512) { const int n2 = e / kw, k2 = (e % kw) * 2;
                *(unsigned*)(t.dst + (size_t)(n0 + n2) * t.ldd + k0 + k2) = cvt_pk(tile[k2 * 65 + n2], tile[(k2 + 1) * 65 + n2]); }
        }
        base += ntile;
    }
    __syncthreads();
}

struct RawRow { u32x4 av; u32x2 cq; unsigned kv; unsigned short ka, kb; };
DI RawRow rows_load(const bf16_t* Z, int row, int lane) {
    const bf16_t* zr = Z + (size_t)row * ZW; RawRow r;
    r.av = *(const u32x4*)(zr + C_AV + lane * 8); r.cq = *(const u32x2*)(zr + C_CQ + lane * 4); r.kv = *(const unsigned*)(zr + C_CKV + lane * 2);
    r.ka = zr[C_CKR + (lane & 15)]; r.kb = zr[C_CKR + 16 + (lane & 15)]; return r;
}
DI void rows_phase(KP p, int l, int tid, bool dump = false) {
    const int G = gridDim.x, lane = tid & 63, gw = blockIdx.x * 8 + (tid >> 6), nw = G * 8;
    unsigned char* ws = p->ws; unsigned char* dob = (unsigned char*)p->out;
    bf16_t* Z = (bf16_t*)(ws + OFF_Z); bf16_t* CKV = (bf16_t*)(dob + DO_CKV); bf16_t* KR = (bf16_t*)(dob + DO_KR);
    {
        const f32x4 g0 = *(const f32x4*)(p->in[10] + l * 512 + lane * 8), g1 = *(const f32x4*)(p->in[10] + l * 512 + lane * 8 + 4);
        const f32x4 b0 = *(const f32x4*)(p->in[11] + l * 512 + lane * 8), b1 = *(const f32x4*)(p->in[11] + l * 512 + lane * 8 + 4);
        const f32x4 gq = *(const f32x4*)(p->in[21] + l * 256 + lane * 4);
        const f32x2 gk = *(const f32x2*)(p->in[23] + l * 128 + lane * 2);
        RawRow cur; if (gw < NROW) cur = rows_load(Z, gw, lane);
        for (int row = gw; row < NROW; row += nw) {
            RawRow nxt = cur; if (row + nw < NROW) nxt = rows_load(Z, row + nw, lane);
            const bool smp = row >= TP; const int srow = row - TP;
            bf16_t* zr = dump ? (bf16_t*)(ws + WS_NEED) : Z + (size_t)row * ZW;
            float x[8]; unpack8(cur.av, x);
            float xq[4] = {bflo(cur.cq.x), bfhi(cur.cq.x), bflo(cur.cq.y), bfhi(cur.cq.y)};
            const float k0 = bflo(cur.kv), k1 = bfhi(cur.kv);
            float s = 0.f;
#pragma unroll
            for (int j = 0; j < 8; ++j) s += x[j];
            float ssq = xq[0] * xq[0] + xq[1] * xq[1] + xq[2] * xq[2] + xq[3] * xq[3];
            float ssk = k0 * k0 + k1 * k1;
#pragma unroll
            for (int o = 32; o >= 1; o >>= 1) { s += __shfl_xor(s, o); ssq += __shfl_xor(ssq, o); ssk += __shfl_xor(ssk, o); }
            const float mean = s * (1.f / 512.f);
            float q = 0.f;
#pragma unroll
            for (int j = 0; j < 8; ++j) { x[j] -= mean; q += x[j] * x[j]; }
            const float rstd = __builtin_amdgcn_rsqf(wave_sum(q) * (1.f / 512.f) + LN_EPS);
            {
                f32x4 y0, y1;
#pragma unroll
                for (int j = 0; j < 4; ++j) { y0[j] = x[j] * rstd * g0[j] + b0[j]; y1[j] = x[4 + j] * rstd * g1[j] + b1[j]; }
                *(u32x4*)(zr + C_AV + lane * 8) = pack8(y0, y1);
                if (smp && !dump) { float* o = p->out + O_SGV + (size_t)l * 65536 + (size_t)srow * 512 + lane * 8; *(f32x4*)o = y0; *(f32x4*)(o + 4) = y1; }
            }
            {
                const float r = __builtin_amdgcn_rsqf(ssq * (1.f / 256.f) + LN_EPS);
                u32x2 o; o.x = cvt_pk(xq[0] * r * gq[0], xq[1] * r * gq[1]); o.y = cvt_pk(xq[2] * r * gq[2], xq[3] * r * gq[3]);
                *(u32x2*)(zr + C_CQ + lane * 4) = o;
            }
            const int kvrow = smp ? TP + (srow >> 4) * SKEYS + 1024 + (srow & 15) : row;
            if (dump) { CKV = (bf16_t*)(ws + WS_NEED) + 8192 - (size_t)kvrow * 128; KR = (bf16_t*)(ws + WS_NEED) + 16384 - (size_t)kvrow * 32; }
            {
                const float r = __builtin_amdgcn_rsqf(ssk * (1.f / 128.f) + LN_EPS);
                const float y0 = k0 * r * gk[0], y1 = k1 * r * gk[1];
                float* o = smp ? p->out + O_SCKV + (size_t)l * 16384 + (size_t)srow * 128 + lane * 2 : p->out + O_PCKV + (size_t)l * 2097152 + (size_t)row * 128 + lane * 2;
                if (dump) o = (float*)(ws + WS_NEED) + 32768 + lane * 2;
                __builtin_nontemporal_store((f32x2){y0, y1}, (f32x2*)o);
                *(unsigned*)(CKV + (size_t)kvrow * 128 + lane * 2) = cvt_pk(y0, y1);
            }
            if (lane < 16) {
                float a = bf2f(cur.ka), b = bf2f(cur.kb);
                const float pos = smp ? (float)(1024 + (srow & 15)) : (float)(row & 4095);
                rope_pair(a, b, pos, lane);
                float* o = smp ? p->out + O_SKR + (size_t)l * 4096 + (size_t)srow * 32 : p->out + O_PKR + (size_t)l * 524288 + (size_t)row * 32;
                if (dump) o = (float*)(ws + WS_NEED) + 36864;
                __builtin_nontemporal_store(a, o + lane); __builtin_nontemporal_store(b, o + lane + 16);
                *(unsigned*)(KR + (size_t)kvrow * 32 + lane * 2) = cvt_pk(a, b);
            }
            cur = nxt;
        }
    }
    if (dump) return;
    for (int i0 = gw * 4; i0 < 8192; i0 += nw * 4) {
        f32x2 sv[4]; f32x2 rv[4];
#pragma unroll
        for (int k = 0; k < 4; ++k) { const int idx = i0 + k, b = idx >> 10, j = idx & 1023;
            sv[k] = __builtin_nontemporal_load((const f32x2*)(p->in[3] + ((size_t)(l * 8 + b) * 1024 + j) * 128 + lane * 2));
            const float* r = p->in[4] + ((size_t)(l * 8 + b) * 1024 + j) * 32; rv[k] = (f32x2){r[lane & 15], r[(lane & 15) + 16]}; }
#pragma unroll
        for (int k = 0; k < 4; ++k) { const int idx = i0 + k, b = idx >> 10, j = idx & 1023; const int dst = TP + b * SKEYS + j;
            *(unsigned*)(CKV + (size_t)dst * 128 + lane * 2) = cvt_pk(sv[k][0], sv[k][1]);
            if (lane < 16) *(unsigned*)(KR + (size_t)dst * 32 + lane * 2) = cvt_pk(rv[k][0], rv[k][1]); }
    }
    for (int it = gw; it < 36 + 128 + 128; it += nw) {
        if (it < 36) {
            const int idx = it; int src; float* o;
            if (idx < 12) { const int b = idx / 3, k = idx % 3; src = b * 4096 + 4093 + k; o = p->out + O_PCONV + (size_t)l * 6144 + (size_t)(b * 3 + k) * 512; }
            else { const int i2 = idx - 12, b = i2 / 3, k = i2 % 3; src = TP + b * 16 + 13 + k; o = p->out + O_SCONV + (size_t)l * 12288 + (size_t)(b * 3 + k) * 512; }
            const u32x4 raw = *(const u32x4*)(Z + (size_t)src * ZW + C_BX + lane * 8); float x[8]; unpack8(raw, x);
            *(f32x4*)(o + lane * 8) = (f32x4){x[0], x[1], x[2], x[3]}; *(f32x4*)(o + lane * 8 + 4) = (f32x4){x[4], x[5], x[6], x[7]};
        } else if (it < 36 + 128) {
            const int dst = 24704 + (it - 36);
            unsigned zz = 0u; asm volatile("" : "+v"(zz));
            *(unsigned*)(CKV + (size_t)dst * 128 + lane * 2) = zz;
        } else {
            float* ms = (float*)(ws + OFF_MS) + (size_t)(it - (36 + 128)) * 1024 + lane * 16;
#pragma unroll
            for (int j = 0; j < 4; ++j) *(f32x4*)(ms + 4 * j) = (f32x4){0.f, 0.f, 0.f, 0.f};
        }
    }
}

struct LnRow { u32x4 v[2]; f32x2 part; };
DI LnRow ln_load(const bf16_t* vb, const float* st, int row, int lane) {
    LnRow r; const bf16_t* vr = vb + (size_t)row * 1024;
#pragma unroll
    for (int c = 0; c < 2; ++c) r.v[c] = __builtin_nontemporal_load((const u32x4*)(vr + c * 512 + lane * 8));
    r.part = (f32x2){0.f, 0.f};
    if (lane < (row < TP ? 16 : 32)) r.part = *(const f32x2*)(st + (size_t)row * 64 + lane * 2);
    return r;
}
DI void ln_phase(KP p, int l, int tid) {
    const int G = gridDim.x, lane = tid & 63, gw = blockIdx.x * 8 + (tid >> 6), nw = G * 8;
    unsigned char* ws = p->ws;
    const float* st = (const float*)(ws + OFF_STATS) + (size_t)l * MROWS * 64;
    bf16_t* XB = (bf16_t*)(ws + OFF_XB);
    const float* g = p->in[29] + l * 1024; const float* b = p->in[30] + l * 1024;
    f32x4 gg[4], bb[4];
#pragma unroll
    for (int c = 0; c < 2; ++c) { gg[2 * c] = *(const f32x4*)(g + c * 512 + lane * 8); gg[2 * c + 1] = *(const f32x4*)(g + c * 512 + lane * 8 + 4);
        bb[2 * c] = *(const f32x4*)(b + c * 512 + lane * 8); bb[2 * c + 1] = *(const f32x4*)(b + c * 512 + lane * 8 + 4); }
    const bf16_t* VB = (const bf16_t*)(ws + OFF_Z);
    LnRow cur; if (gw < NROW) cur = ln_load(VB, st, gw, lane);
    for (int row = gw; row < NROW; row += nw) {
        LnRow nxt = cur; if (row + nw < NROW) nxt = ln_load(VB, st, row + nw, lane);
        float ps1 = cur.part[0], ps2 = cur.part[1];
#pragma unroll
        for (int o = 16; o >= 1; o >>= 1) { ps1 += __shfl_xor(ps1, o); ps2 += __shfl_xor(ps2, o); }
        ps1 = __shfl(ps1, 0); ps2 = __shfl(ps2, 0);
        const float mean = ps1 * (1.f / 1024.f); const float var = ps2 * (1.f / 1024.f) - mean * mean;
        const float rstd = __builtin_amdgcn_rsqf(fmaxf(var, 0.f) + LN_EPS);
        float* vr = p->out + (size_t)row * 1024;
#pragma unroll
        for (int c = 0; c < 2; ++c) {
            const int col = c * 512 + lane * 8;
            float xv[8]; unpack8(cur.v[c], xv);
            f32x4 a = {xv[0], xv[1], xv[2], xv[3]}, bq = {xv[4], xv[5], xv[6], xv[7]};
#pragma unroll
            for (int j = 0; j < 4; ++j) { a[j] = (a[j] - mean) * rstd * gg[2 * c][j] + bb[2 * c][j]; bq[j] = (bq[j] - mean) * rstd * gg[2 * c + 1][j] + bb[2 * c + 1][j]; }
            if (l == 0) *(u32x4*)(XB + (size_t)row * 1024 + col) = pack8(a, bq);
            else { __builtin_nontemporal_store(a, (f32x4*)(vr + col)); __builtin_nontemporal_store(bq, (f32x4*)(vr + col + 4)); }
        }
        cur = nxt;
    }
}

DI void gmlp_tile(KP p, int l, int b, int n, int g, LAS unsigned char* lds, int tid, bool dump = false) {
    const int w = tid >> 6, lane = tid & 63, r = lane & 31, h = lane >> 5;
    bf16_t* Z = (bf16_t*)(p->ws + OFF_Z);
    const bf16_t* GW = (const bf16_t*)(p->ws + OFF_GWS) + (size_t)(l * 4 + g) * 16384;
    LAS bf16_t* Wl = (LAS bf16_t*)lds; LAS bf16_t* Vl = (LAS bf16_t*)(lds + 34816); LAS bf16_t* Ul = (LAS bf16_t*)(lds + 69632); LAS bf16_t* Gl = (LAS bf16_t*)(lds + 102400);
    const int r0 = b * 4096 + n * 128;
    __syncthreads();
    for (int c = tid; c < 2048; c += 512) { const int rr = c >> 4, ch = c & 15; const bf16_t* zr = Z + (size_t)(r0 + rr) * ZW + g * 128 + ch * 8;
        *(LAS u32x4*)(Wl + rr * 136 + ch * 8) = *(const u32x4*)(GW + rr * 128 + ch * 8);
        *(LAS u32x4*)(Vl + rr * 136 + ch * 8) = __builtin_nontemporal_load((const u32x4*)(zr + C_AV));
        *(LAS u32x4*)(Ul + rr * 128 + ch * 8) = *(const u32x4*)(zr + C_AU);
        *(LAS u32x4*)(Gl + rr * 128 + ch * 8) = __builtin_nontemporal_load((const u32x4*)(zr + C_AG)); }
    __syncthreads();
    const int pb = w >> 1, cb0 = (w & 1) * 2;
    f32x16 acc0, acc1;
#pragma unroll
    for (int i = 0; i < 16; ++i) { acc0[i] = 0.f; acc1[i] = 0.f; }
    for (int s = 0; s < 2 * (pb + 1); ++s) {
        const bf16x8 a = *(const LAS bf16x8*)(Wl + (32 * pb + r) * 136 + 16 * s + 8 * h);
        bf16x8 b0, b1;
#pragma unroll
        for (int j = 0; j < 8; ++j) { b0[j] = (short)Vl[(16 * s + 8 * h + j) * 136 + 32 * cb0 + r]; b1[j] = (short)Vl[(16 * s + 8 * h + j) * 136 + 32 * (cb0 + 1) + r]; }
        acc0 = MFMA32(a, b0, acc0); acc1 = MFMA32(a, b1, acc1);
    }
    const float* bs = p->in[13] + (size_t)(l * 4 + g) * 128;
    float bias[16];
#pragma unroll
    for (int i = 0; i < 16; ++i) bias[i] = bs[32 * pb + crow(i, h)];
#pragma unroll
    for (int i = 0; i < 16; ++i) {
        const int pr = 32 * pb + crow(i, h);
#pragma unroll
        for (int cb = 0; cb < 2; ++cb) {
            const int c = 32 * (cb0 + cb) + r;
            const float sv = (cb ? acc1[i] : acc0[i]) + bias[i];
            Ul[pr * 128 + c] = f2bf(bf2f(Ul[pr * 128 + c]) * sv * bf2f(Gl[pr * 128 + c]));
        }
    }
    __syncthreads();
    for (int c = tid; c < 2048; c += 512) { const int rr = c >> 4, ch = c & 15;
        bf16_t* dst = dump ? (bf16_t*)(p->ws + WS_NEED) + ch * 8 : Z + (size_t)(r0 + rr) * ZW + C_AU + g * 128 + ch * 8;
        *(u32x4*)dst = *(const LAS u32x4*)(Ul + rr * 128 + ch * 8); }
}
DI void gmlp_sample(KP p, int l, int b, int g, int tid) {
    const int c = tid & 127, p0 = (tid >> 7) * 4;
    bf16_t* Z = (bf16_t*)(p->ws + OFF_Z);
    const float* wsrc = p->in[12] + (size_t)(l * 4 + g) * 16384; const float* bs = p->in[13] + (size_t)(l * 4 + g) * 128;
    const int r0 = TP + b * 16;
    float v[16];
#pragma unroll
    for (int q = 0; q < 16; ++q) v[q] = bf2f(Z[(size_t)(r0 + q) * ZW + C_AV + g * 128 + c]);
#pragma unroll
    for (int k = 0; k < 4; ++k) { const int pr = p0 + k; float s = bs[pr];
#pragma unroll
        for (int q = 0; q < 16; ++q) if (q <= pr) s += wsrc[pr * 128 + q] * v[q];
        bf16_t* zr = Z + (size_t)(r0 + pr) * ZW; const int cc = g * 128 + c;
        zr[C_AU + cc] = f2bf(bf2f(zr[C_AU + cc]) * s * bf2f(zr[C_AG + cc])); }
}

DI void lru_tile(KP p, int l, int bg, int hb, int seg, bool apply, LAS unsigned char* lds, int tid, bool dump = false) {
    const int w = tid >> 6, lane = tid & 63, r = lane & 31, h = lane >> 5;
    bf16_t* Z = (bf16_t*)(p->ws + OFF_Z);
    const bool smp = bg >= 4; const int sb = bg - 4;
    const int row0 = smp ? TP + sb * 16 : bg * 4096 + seg * 128; const int ntok = smp ? 16 : 128;
    LAS float* XC = (LAS float*)lds; LAS bf16_t* XCB = (LAS bf16_t*)(lds + 32768); LAS float* GATE = (LAS float*)(lds + 51200); LAS float* AGL = (LAS float*)(lds + 116736);
    LAS bf16_t* BXT = (LAS bf16_t*)(lds + 51200);
    LAS bf16_t* GZ = (LAS bf16_t*)(lds + 120832);
    LAS float* AGP = (LAS float*)(lds + 137216);
    const int c = tid & 63, sub = tid >> 6, ch = hb * 64 + c;
    float* AGG = (float*)(p->ws + OFF_AGG);
    const int tb = w >> 1, nb0 = (w & 1) * 2;
    const bf16_t* WT = (const bf16_t*)(p->ws + OFF_WRI + l * SZ_WRI) + hb * 8192;
    bf16x8 bw0[4], bw1[4];
#pragma unroll
    for (int s = 0; s < 4; ++s) { bw0[s] = *(const bf16x8*)(WT + (32 * nb0 + r) * 64 + 16 * s + 8 * h); bw1[s] = *(const bf16x8*)(WT + (32 * (nb0 + 1) + r) * 64 + 16 * s + 8 * h); }
    const int n0 = 32 * nb0 + r, n1 = n0 + 32;
    const float bias0 = n0 < 64 ? p->in[17][l * 512 + hb * 64 + n0] : p->in[19][l * 512 + hb * 64 + n0 - 64];
    const float bias1 = n1 < 64 ? p->in[17][l * 512 + hb * 64 + n1] : p->in[19][l * 512 + hb * 64 + n1 - 64];
    const float cb = p->in[15][l * 512 + ch];
    float cw[4];
#pragma unroll
    for (int k = 0; k < 4; ++k) cw[k] = p->in[14][(size_t)(l * 4 + k) * 512 + ch];
    const float lam = p->in[20][l * 512 + ch];
    __syncthreads();
    if (apply && !smp) {
#pragma unroll
        for (int k = 0; k < 4; ++k) { const int s2 = sub + 8 * k;
            if (s2 < seg) { const float* o = AGG + (size_t)((bg * 8 + hb) * 32 + s2) * 128; AGP[s2 * 128 + c] = o[c]; AGP[s2 * 128 + 64 + c] = o[64 + c]; } }
    }
    for (int q = tid; q < 131 * 8; q += 512) {
        const int rr = q >> 3, cc = (q & 7) * 8; const int tt = rr - 3;
        u32x4 v = {0u, 0u, 0u, 0u};
        if (!smp) { const int gt = seg * 128 + tt; if (gt >= 0) { const u32x4* sp = (const u32x4*)(Z + (size_t)(bg * 4096 + gt) * ZW + C_BX + hb * 64 + cc); v = apply ? __builtin_nontemporal_load(sp) : *sp; } }
        else if (tt >= 0) { if (tt < 16) v = *(const u32x4*)(Z + (size_t)(row0 + tt) * ZW + C_BX + hb * 64 + cc); }
        else { const float* cs = p->in[8] + ((size_t)(l * 8 + sb) * 3 + rr) * 512 + hb * 64 + cc; v = pack8(*(const f32x4*)cs, *(const f32x4*)(cs + 4)); }
        *(LAS u32x4*)(BXT + rr * 64 + cc) = v;
    }
    if (apply) for (int q = tid; q < 128 * 8; q += 512) { const int rr = q >> 3, cc = (q & 7) * 8;
        u32x4 v = {0u, 0u, 0u, 0u}; if (rr < ntok) v = __builtin_nontemporal_load((const u32x4*)(Z + (size_t)(row0 + rr) * ZW + C_BG + hb * 64 + cc));
        *(LAS u32x4*)(GZ + rr * 64 + cc) = v; }
    __syncthreads();
    {
#pragma unroll 4
        for (int t = sub; t < 128; t += 8) {
            float a = 0.f;
            if (t < ntok) { a = cb;
#pragma unroll
                for (int k = 0; k < 4; ++k) a += bf2f(BXT[(t + k) * 64 + c]) * cw[k]; }
            XC[t * 64 + c] = a; XCB[t * 72 + c] = f2bf(a);
        }
    }
    __syncthreads();
    {
        f32x16 a0, a1;
#pragma unroll
        for (int i = 0; i < 16; ++i) { a0[i] = 0.f; a1[i] = 0.f; }
#pragma unroll
        for (int s = 0; s < 4; ++s) {
            const bf16x8 a = *(const LAS bf16x8*)(XCB + (32 * tb + r) * 72 + 16 * s + 8 * h);
            a0 = MFMA32(a, bw0[s], a0); a1 = MFMA32(a, bw1[s], a1);
        }
        __syncthreads();
#pragma unroll
        for (int i = 0; i < 16; ++i) { const int t = 32 * tb + crow(i, h); GATE[t * 128 + n0] = fsigmoid(a0[i] + bias0); GATE[t * 128 + n1] = fsigmoid(a1[i] + bias1); }
    }
    __syncthreads();
    float av[16], bv[16];
    {
        const float ex = __expf(-lam);
        const float sp = ex * (1.f - ex * (0.5f - ex * 0.33333333f));
        float P = 1.f, S = 0.f;
#pragma unroll
        for (int k = 0; k < 16; ++k) { const int t = sub * 16 + k;
            float a = 1.f, bb = 0.f;
            if (t < ntok) { const float rg = GATE[t * 128 + c], ig = GATE[t * 128 + 64 + c], x = XC[t * 64 + c];
                const float la = -8.f * rg * sp; a = __expf(la); const float y2 = 2.f * la;
                const float em = y2 > -0.1f ? -y2 * (1.f + y2 * (0.5f + y2 * (0.16666667f + y2 * 0.041666668f))) : 1.f - a * a;
                bb = __builtin_amdgcn_sqrtf(fmaxf(em, 0.f)) * (ig * x); }
            av[k] = a; bv[k] = bb; S = a * S + bb; P *= a; }
        AGL[sub * 64 + c] = P; AGL[512 + sub * 64 + c] = S;
    }
    __syncthreads();
    if (!apply) {
        if (sub == 0 && !smp) { float A = 1.f, B = 0.f;
#pragma unroll
            for (int s2 = 0; s2 < 8; ++s2) { const float P = AGL[s2 * 64 + c], S = AGL[512 + s2 * 64 + c]; B = P * B + S; A *= P; }
            float* o = AGG + (size_t)((bg * 8 + hb) * 32 + seg) * 128; o[c] = A; o[64 + c] = B; }
    } else {
        float hcar;
        if (smp) hcar = p->in[7][(size_t)(l * 8 + sb) * 512 + ch];
        else { hcar = 0.f; for (int s2 = 0; s2 < seg; ++s2) hcar = AGP[s2 * 128 + c] * hcar + AGP[s2 * 128 + 64 + c]; }
        for (int s2 = 0; s2 < sub; ++s2) hcar = AGL[s2 * 64 + c] * hcar + AGL[512 + s2 * 64 + c];
#pragma unroll
        for (int k = 0; k < 16; ++k) { const int t = sub * 16 + k;
            hcar = av[k] * hcar + bv[k];
            if (t < ntok) { GZ[t * 64 + c] = f2bf(hcar * bf2f(GZ[t * 64 + c]));
                if (!dump) { if (smp) { if (t == 15) p->out[O_SH + (size_t)(l * 8 + sb) * 512 + ch] = hcar; }
                else if (seg == 31 && t == 127) p->out[O_PH + (size_t)(l * 4 + bg) * 512 + ch] = hcar; } } }
        __syncthreads();
        for (int q = tid; q < 128 * 8; q += 512) { const int rr = q >> 3, cc = (q & 7) * 8;
            if (rr < ntok) { bf16_t* dst = dump ? (bf16_t*)(p->ws + WS_NEED) + cc : Z + (size_t)(row0 + rr) * ZW + C_BG + hb * 64 + cc; *(u32x4*)dst = *(const LAS u32x4*)(GZ + rr * 64 + cc); } }
    }
}

struct AttnItem {
    const bf16_t* Q; int ldq, qcol, qrow0, nq;
    const bf16_t* Kn; int ldkn, kncol; const bf16_t* Kr; int krow0;
    const bf16_t* VT; int ldvt, vtrow0, vcol0;
    int nkeys, ntmax, tbase, causal;
    float scale;
    bf16_t* O; int ldo, ocol, gate;
};
template <bool ROPE>
DI void attn_item(const AttnItem& it, LAS unsigned char* lds, int tid) {
    constexpr int NK = ROPE ? 6 : 4;
    constexpr int KB = 64 * 104 * 2, VB = 64 * 72 * 2;
    const int w = tid >> 6, lane = tid & 63, r = lane & 31, h = lane >> 5;
    const int qi = 32 * w + r; const bool qvalid = qi < it.nq; const int qrow = it.qrow0 + (qvalid ? qi : 0);
    const int mytiles = (32 * w >= it.nq) ? 0 : (it.causal ? it.tbase + (w >> 1) + 1 : it.ntmax);
    const int T = it.ntmax;
    bf16x8 qf[NK];
#pragma unroll
    for (int ks = 0; ks < NK; ++ks) qf[ks] = *(const bf16x8*)(it.Q + (size_t)qrow * it.ldq + it.qcol + 16 * ks + 8 * h);
    f32x16 o0, o1;
#pragma unroll
    for (int i = 0; i < 16; ++i) { o0[i] = 0.f; o1[i] = 0.f; }
    float mrun = -1e30f, lsum = 0.f;
    const float sc = it.scale;
    const int lk = tid >> 3, lc = tid & 7, rk = tid >> 2, rc = tid & 3;
    const bf16_t* kp = it.Kn + (size_t)(it.krow0 + lk) * it.ldkn + it.kncol + lc * 8;
    const bf16_t* rp = ROPE ? it.Kr + (size_t)(it.krow0 + rk) * 32 + rc * 8 : nullptr;
    const bf16_t* vp = it.VT + (size_t)(it.vtrow0 + lk) * it.ldvt + it.vcol0 + lc * 8;
    const size_t kts = (size_t)64 * it.ldkn;
#define AT_KL(kt, kr_, rr_) do { kr_ = *(const u32x4*)(kp + (size_t)(kt) * kts); if (ROPE && tid < 256) rr_ = *(const u32x4*)(rp + (size_t)(kt) * 2048); } while (0)
#define AT_KS(buf, kr_, rr_) do { *(LAS u32x4*)(lds + (buf) * KB + (lk * 104 + lc * 8) * 2) = kr_; if (ROPE && tid < 256) *(LAS u32x4*)(lds + (buf) * KB + (rk * 104 + 64 + rc * 8) * 2) = rr_; } while (0)
#define AT_QK(buf, d0, d1) do { \
        _Pragma("unroll") for (int i = 0; i < 16; ++i) { d0[i] = 0.f; d1[i] = 0.f; } \
        _Pragma("unroll") for (int kb_ = 0; kb_ < NK; kb_ += 2) { bf16x8 ka_[4]; \
            _Pragma("unroll") for (int ks = 0; ks < 2; ++ks) { ka_[2 * ks] = *(const LAS bf16x8*)(lds + (buf) * KB + (r * 104 + 16 * (kb_ + ks) + 8 * h) * 2); ka_[2 * ks + 1] = *(const LAS bf16x8*)(lds + (buf) * KB + ((32 + r) * 104 + 16 * (kb_ + ks) + 8 * h) * 2); } \
            __builtin_amdgcn_sched_barrier(0); \
            _Pragma("unroll") for (int ks = 0; ks < 2; ++ks) { d0 = MFMA32(ka_[2 * ks], qf[kb_ + ks], d0); d1 = MFMA32(ka_[2 * ks + 1], qf[kb_ + ks], d1); } \
            __builtin_amdgcn_sched_barrier(0); } } while (0)
    u32x4 kreg, rreg = {0u, 0u, 0u, 0u}, vreg;
    {
        AT_KL(0, kreg, rreg); vreg = *(const u32x4*)vp;
        __syncthreads();
        AT_KS(0, kreg, rreg); *(LAS u32x4*)(lds + 2 * KB + (lk * 72 + lc * 8) * 2) = vreg;
        if (T > 1) { AT_KL(1, kreg, rreg); vreg = *(const u32x4*)(vp + 64); }
    }
    for (int kt = 0; kt < T; ++kt) {
        __syncthreads();
        if (kt + 1 < T) { AT_KS((kt + 1) & 1, kreg, rreg); *(LAS u32x4*)(lds + 2 * KB + ((kt + 1) & 1) * VB + (lk * 72 + lc * 8) * 2) = vreg; }
        if (kt + 2 < T) { AT_KL(kt + 2, kreg, rreg); vreg = *(const u32x4*)(vp + (size_t)(kt + 2) * 64); }
        if (kt < mytiles) {
            f32x16 s0, s1;
            AT_QK(kt & 1, s0, s1);
            if ((kt + 1) * 64 > it.nkeys) {
#pragma unroll
                for (int i = 0; i < 16; ++i) { const int key = kt * 64 + crow(i, h); if (key >= it.nkeys) s0[i] = -1e30f; if (key + 32 >= it.nkeys) s1[i] = -1e30f; }
            }
            float mx = max3f(s0[0], s0[1], s1[0]);
#pragma unroll
            for (int i = 2; i < 16; i += 2) mx = max3f(mx, s0[i], s0[i + 1]);
#pragma unroll
            for (int i = 1; i < 15; i += 2) mx = max3f(mx, s1[i], s1[i + 1]);
            mx = fmaxf(mx, s1[15]);
            mx = xhalf_max(mx);
            const float mnew = fmaxf(mrun, mx);
            const bool changed = __any(mnew > mrun);
            const float alpha = __builtin_amdgcn_exp2f((mrun - mnew) * sc);
            mrun = mnew;
            const f32x2 sc2 = {sc, sc}, nmc2 = {-mnew * sc, -mnew * sc};
            f32x2 ps2 = {0.f, 0.f};
#pragma unroll
            for (int i = 0; i < 16; i += 2) {
                f32x2 t0 = (f32x2){s0[i], s0[i + 1]} * sc2 + nmc2, t1 = (f32x2){s1[i], s1[i + 1]} * sc2 + nmc2;
                t0.x = __builtin_amdgcn_exp2f(t0.x); t0.y = __builtin_amdgcn_exp2f(t0.y); t1.x = __builtin_amdgcn_exp2f(t1.x); t1.y = __builtin_amdgcn_exp2f(t1.y);
                ps2 += t0; ps2 += t1;
                s0[i] = t0.x; s0[i + 1] = t0.y; s1[i] = t1.x; s1[i + 1] = t1.y;
            }
            lsum = lsum * alpha + (ps2.x + ps2.y);
            if (changed) {
#pragma unroll
                for (int i = 0; i < 16; ++i) { o0[i] *= alpha; o1[i] *= alpha; }
            }
            const LAS unsigned char* vb = lds + 2 * KB + (kt & 1) * VB;
            bf16x8 pf[4];
#pragma unroll
            for (int kk = 0; kk < 4; ++kk) {
                const int s8 = (kk & 1) * 8;
                u32x4 pw;
                if (kk < 2) { pw.x = cvt_pk(s0[s8], s0[s8 + 1]); pw.y = cvt_pk(s0[s8 + 2], s0[s8 + 3]); pw.z = cvt_pk(s0[s8 + 4], s0[s8 + 5]); pw.w = cvt_pk(s0[s8 + 6], s0[s8 + 7]); }
                else { pw.x = cvt_pk(s1[s8], s1[s8 + 1]); pw.y = cvt_pk(s1[s8 + 2], s1[s8 + 3]); pw.z = cvt_pk(s1[s8 + 4], s1[s8 + 5]); pw.w = cvt_pk(s1[s8 + 6], s1[s8 + 7]); }
                pf[kk] = __builtin_bit_cast(bf16x8, pw);
            }
#pragma unroll
            for (int k2 = 0; k2 < 4; k2 += 2) {
                s16x4 vl[8];
#pragma unroll
                for (int kq = 0; kq < 2; ++kq) { const int kk = k2 + kq;
                    vl[4 * kq] = *(const LAS s16x4*)(vb + (r * 72 + 16 * kk + 4 * h) * 2); vl[4 * kq + 1] = *(const LAS s16x4*)(vb + (r * 72 + 16 * kk + 8 + 4 * h) * 2);
                    vl[4 * kq + 2] = *(const LAS s16x4*)(vb + ((32 + r) * 72 + 16 * kk + 4 * h) * 2); vl[4 * kq + 3] = *(const LAS s16x4*)(vb + ((32 + r) * 72 + 16 * kk + 8 + 4 * h) * 2); }
                __builtin_amdgcn_sched_barrier(0);
#pragma unroll
                for (int kq = 0; kq < 2; ++kq) {
                    const bf16x8 va0 = __builtin_shufflevector(vl[4 * kq], vl[4 * kq + 1], 0, 1, 2, 3, 4, 5, 6, 7), va1 = __builtin_shufflevector(vl[4 * kq + 2], vl[4 * kq + 3], 0, 1, 2, 3, 4, 5, 6, 7);
                    o0 = MFMA32(va0, pf[k2 + kq], o0); o1 = MFMA32(va1, pf[k2 + kq], o1);
                }
                __builtin_amdgcn_sched_barrier(0);
            }
        }
    }
#undef AT_KL
#undef AT_KS
#undef AT_QK
    const float ltot = lsum + __shfl_xor(lsum, 32);
    if (qvalid && mytiles > 0) {
        const float inv = __builtin_amdgcn_rcpf(ltot);
        bf16_t* orow = it.O + (size_t)qrow * it.ldo + it.ocol;
        u32x2 gw[8];
        if (it.gate) {
#pragma unroll
            for (int db = 0; db < 2; ++db)
#pragma unroll
                for (int g4 = 0; g4 < 4; ++g4) gw[db * 4 + g4] = *(const u32x2*)(orow + 32 * db + 8 * g4 + 4 * h);
        }
#pragma unroll
        for (int db = 0; db < 2; ++db)
#pragma unroll
            for (int g4 = 0; g4 < 4; ++g4) {
                const int dv0 = 32 * db + 8 * g4 + 4 * h;
                float v[4];
#pragma unroll
                for (int j = 0; j < 4; ++j) v[j] = (db ? o1[4 * g4 + j] : o0[4 * g4 + j]) * inv;
                if (it.gate) { const u32x2 g = gw[db * 4 + g4]; v[0] *= bflo(g.x); v[1] *= bfhi(g.x); v[2] *= bflo(g.y); v[3] *= bfhi(g.y); }
                u32x2 ow; ow.x = cvt_pk(v[0], v[1]); ow.y = cvt_pk(v[2], v[3]);
                *(u32x2*)(orow + dv0) = ow;
            }
    }
}

#define XB_TMO      128
#define XB_XCNT(j)  (256  + 64 * (j))
#define XB_XSUB(j)  (1280 + 64 * (j))
#define XB_XGEN(j)  (2304 + 64 * (j))
#define XB_TOP      3328
#define XB_TOPGEN   3392
#define XCD_BAR_WORDS 3456
#define XB_SPIN_CAP (1u << 18)
DI unsigned xb_ld(unsigned* p)              { return __hip_atomic_load(p, __ATOMIC_RELAXED, __HIP_MEMORY_SCOPE_AGENT); }
DI unsigned xb_add(unsigned* p, unsigned v) { return __hip_atomic_fetch_add(p, v, __ATOMIC_RELAXED, __HIP_MEMORY_SCOPE_AGENT); }
DI unsigned xb_xcc_id() { return (unsigned)__builtin_amdgcn_s_getreg((3 << 11) | 20) & 0xFu; }
#define XB_SPIN(cond, bar) do { unsigned _sp = 0; while (cond) { __builtin_amdgcn_s_sleep(1); \
    if ((++_sp & 255u) == 0u) { if (xb_ld(&(bar)[XB_TMO])) break; if (_sp > XB_SPIN_CAP) { atomicAdd(&(bar)[XB_TMO], 1u); break; } } } } while (0)
struct XcdBarrier { unsigned* bar; unsigned x; volatile LAS unsigned* st; };
DI XcdBarrier xcd_barrier_post(unsigned* bar, volatile LAS unsigned* st) {
    XcdBarrier b; b.bar = bar; b.x = xb_xcc_id(); b.st = st;
    if (threadIdx.x == 0) (void)xb_add(&bar[XB_XCNT(b.x)], 1u);
    return b;
}
DI void xcd_barrier_complete(unsigned* bar, unsigned x, unsigned& nloc, unsigned& nx) {
    const unsigned G = gridDim.x * gridDim.y * gridDim.z;
    unsigned sum, cnt, mine, sp = 0u;
    for (;;) {
        sum = 0u; cnt = 0u; mine = 0u;
#pragma unroll
        for (unsigned j = 0; j < 16; ++j) { const unsigned c = xb_ld(&bar[XB_XCNT(j)]); sum += c; cnt += (c > 0u) ? 1u : 0u; mine = (j == x) ? c : mine; }
        if (sum == G) break;
        __builtin_amdgcn_s_sleep(1);
        if ((++sp & 255u) == 0u) { if (xb_ld(&bar[XB_TMO])) break; if (sp > XB_SPIN_CAP) { atomicAdd(&bar[XB_TMO], 1u); break; } }
    }
    nloc = mine > 0u ? mine : 1u; nx = cnt > 0u ? cnt : 1u;
}
DI void xcd_barrier(const XcdBarrier& b) {
    asm volatile("s_waitcnt vmcnt(0)" ::: "memory");
    __syncthreads();
    if (threadIdx.x == 0) {
        unsigned* bar = b.bar;
        __builtin_amdgcn_s_waitcnt(0);
        unsigned nloc = b.st[0], nx = b.st[1];
        if (nloc == 0u) { xcd_barrier_complete(bar, b.x, nloc, nx); b.st[0] = nloc; b.st[1] = nx; }
        const unsigned old = xb_add(&bar[XB_XSUB(b.x)], 1u);
        const unsigned gen = old / nloc;
        if (old + 1u == (gen + 1u) * nloc) {
            __builtin_amdgcn_fence(__ATOMIC_RELEASE, "agent");
            asm volatile("s_waitcnt vmcnt(0)" ::: "memory");
            const unsigned og = xb_add(&bar[XB_TOP], 1u);
            const unsigned tg = og / nx;
            if (og + 1u == (tg + 1u) * nx) xb_add(&bar[XB_TOPGEN], 1u);
            else XB_SPIN(xb_ld(&bar[XB_TOPGEN]) == tg, bar);
            __builtin_amdgcn_fence(__ATOMIC_ACQUIRE, "agent");
            xb_add(&bar[XB_XGEN(b.x)], 1u);
            asm volatile("s_waitcnt vmcnt(0)" ::: "memory");
        } else {
            XB_SPIN(xb_ld(&bar[XB_XGEN(b.x)]) == gen, bar);
            __builtin_amdgcn_fence(__ATOMIC_ACQUIRE, "agent");
            asm volatile("s_waitcnt vmcnt(0)" ::: "memory");
        }
    }
    __syncthreads();
}

__global__ void __launch_bounds__(512, 2) mega(Params pk) {
    extern __shared__ __attribute__((aligned(16))) unsigned char shm[];
    LAS unsigned char* lds = (LAS unsigned char*)shm;
    cg::grid_group grid = cg::this_grid();
    __shared__ uint4 xb_words;
    if (threadIdx.x == 0) xb_words = make_uint4(0u, 0u, 0u, 0u);
    __syncthreads();
    XcdBarrier xb = xcd_barrier_post((unsigned*)(((KP)__builtin_amdgcn_kernarg_segment_ptr())->ws + OFF_BAR), (volatile LAS unsigned*)&xb_words);
#define STAMP(k) do { if (TSA != -1 && blockIdx.x == 0 && threadIdx.x == 0) ((unsigned long long*)(((KP)__builtin_amdgcn_kernarg_segment_ptr())->ws + OFF_TS))[k] = __builtin_amdgcn_s_memrealtime(); } while (0)
    STAMP(18);
    { KP p = (KP)__builtin_amdgcn_kernarg_segment_ptr(); int tid0 = threadIdx.x; asm volatile("" : "+v"(tid0)); prep_phase(p, lds, tid0); if (PROBE & 64) { grid.sync(); prep_phase(p, lds, tid0); } }
    grid.sync();
    if (PROBE & 256) { for (int k = 0; k < 20; ++k) xcd_barrier(xb); }
    STAMP(0);
    for (int step = 0; step < 14; ++step) {
        const int l = step / 7, ph = step % 7;
        KP p = (KP)__builtin_amdgcn_kernarg_segment_ptr(); asm volatile("" : "+s"(p));
        int tid = threadIdx.x; asm volatile("" : "+v"(tid));
        int wg = blockIdx.x, G = gridDim.x; asm volatile("" : "+s"(wg), "+s"(G));
        unsigned char* ws = p->ws; unsigned char* dob = (unsigned char*)p->out;
        const int gph = ph == 0 ? 0 : ph == 2 ? 1 : ph == 4 ? 2 : ph == 5 ? 3 : -1;
        if (gph >= 0) {
            const int ndup = ((PROBE & 1) && gph == 0) || ((PROBE & 2) && gph == 1) || ((PROBE & 4) && gph == 2) || ((PROBE & 128) && gph == 3) ? 2 : 1;
#pragma unroll 1
            for (int rep = 0; rep < ndup; ++rep) { gemm_stream(p, gph, l, lds, tid, wg, G, rep + 1 < ndup); if (rep + 1 < ndup) xcd_barrier(xb); }
            if (l == 0) STAMP(20 + gph * 2);
            sample_gemm_phase(p, gph, l, lds, tid, wg, G);
            if (l == 0) STAMP(21 + gph * 2);
        }
        if (ph == 1) { if (PROBE & 512) { rows_phase(p, l, tid, true); xcd_barrier(xb); } rows_phase(p, l, tid); }
        else if (ph == 2) {
            __syncthreads();
            for (int t = wg; t < 512; t += G) { if (PROBE & 32) gmlp_tile(p, l, t >> 7, (t >> 2) & 31, t & 3, lds, tid, true); gmlp_tile(p, l, t >> 7, (t >> 2) & 31, t & 3, lds, tid); }
            for (int s = G - 1 - wg; s < 32; s += G) gmlp_sample(p, l, s >> 2, s & 3, tid);
            if (l == 0) STAMP(30);
            for (int k_ = 0;; ++k_) {
                int t;
                if (G == 256) t = k_ == 0 ? wg : (k_ == 1 && wg >= 192 && wg < 224) ? 479 - wg : -1; else { t = wg + k_ * G; if (t >= 288) t = -1; }
                if (t < 0) break;
                AttnItem it;
                it.Q = (const bf16_t*)(ws + OFF_Z); it.ldq = ZW; it.Kr = nullptr; it.scale = 0.125f * 1.44269504089f;
                it.O = (bf16_t*)(ws + OFF_Z); it.ldo = ZW; it.gate = 0; it.nkeys = 256; it.ntmax = 4; it.tbase = 0; it.causal = 0; it.krow0 = 0; it.vcol0 = 0;
                if (t < 256) { const int b = t >> 6, hh = (t >> 4) & 3, qb = t & 15;
                    it.qcol = C_MQ + hh * 64; it.qrow0 = b * 4096 + qb * 256; it.nq = 256;
                    it.Kn = (const bf16_t*)(ws + OFF_MK) + (size_t)b * 256 * 256; it.ldkn = 256; it.kncol = hh * 64;
                    it.VT = (const bf16_t*)(ws + OFF_MVT); it.ldvt = 1024; it.vtrow0 = hh * 64; it.vcol0 = b * 256; }
                else { const int s = t - 256, b = s >> 2, hh = s & 3;
                    it.qcol = C_MQ + hh * 64; it.qrow0 = TP + b * 16; it.nq = 16;
                    it.Kn = (const bf16_t*)(ws + OFF_MKS) + (size_t)(l * 8 + b) * 65536; it.ldkn = 256; it.kncol = hh * 64;
                    it.VT = (const bf16_t*)(ws + OFF_MVTS) + (size_t)(l * 8 + b) * 65536; it.ldvt = 256; it.vtrow0 = hh * 64; }
                it.ocol = it.qcol;
                if (PROBE & 32) { AttnItem d = it; d.O = (bf16_t*)(ws + WS_NEED); d.ldo = 64; d.ocol = 0; attn_item<false>(d, lds, tid); }
                attn_item<false>(it, lds, tid);
            }
            if (l == 0) STAMP(31);
            for (int t = wg; t < 1024; t += G) { if (PROBE & 8) lru_tile(p, l, t >> 8, (t >> 5) & 7, t & 31, false, lds, tid); lru_tile(p, l, t >> 8, (t >> 5) & 7, t & 31, false, lds, tid); }
            if (l == 0) STAMP(32);
        } else if (ph == 3) {
            for (int t = wg; t < 256; t += G) {
                AttnItem it;
                it.Q = (const bf16_t*)(dob + DO_Q); it.ldq = 768; it.Kn = (const bf16_t*)(dob + DO_KN); it.ldkn = 512; it.Kr = (const bf16_t*)(dob + DO_KR);
                it.VT = (const bf16_t*)(ws + OFF_VT); it.ldvt = KVROWS; it.scale = 0.10206207262f * 1.44269504089f;
                it.O = (bf16_t*)(ws + OFF_Z); it.ldo = ZW; it.gate = 1;
                const int b = t >> 6, hh = (t >> 3) & 7, g = t & 7;
                const unsigned tab = g == 0 ? 0xffdu : g == 1 ? 0xf0cu : g == 2 ? 0xf1fu : g == 3 ? 0xf2eu : g == 4 ? 0xf5bu : g == 5 ? 0xf6au : g == 6 ? 0xf79u : 0x348u;
                it.qcol = hh * 96; it.kncol = hh * 64; it.vtrow0 = hh * 64; it.ocol = C_CG + hh * 64;
                it.krow0 = b * 4096; it.vcol0 = b * 4096; it.nq = 256; it.nkeys = 4096; it.causal = 1;
                const int nqb = g == 0 ? 1 : g == 7 ? 3 : 2;
#pragma unroll 1
                for (int k = 0; k < nqb; ++k) { const int qb = (tab >> (4 * k)) & 15;
                    it.qrow0 = b * 4096 + qb * 256; it.tbase = 4 * qb; it.ntmax = 4 * qb + 4;
                    attn_item<true>(it, lds, tid); }
                if (g < 2) { const int bs = 2 * b + g;
                    it.krow0 = TP + bs * SKEYS; it.vcol0 = TP + bs * SKEYS;
                    it.qrow0 = TP + bs * 16; it.nq = 16; it.nkeys = SKEYS; it.causal = 0; it.tbase = 0; it.ntmax = 17;
                    attn_item<true>(it, lds, tid); }
            }
            if (l == 0) STAMP(33);
            for (int t = wg; t < 1024; t += G) {
                if (t < 1024) { if (PROBE & 8) lru_tile(p, l, t >> 8, (t >> 5) & 7, t & 31, true, lds, tid, true); lru_tile(p, l, t >> 8, (t >> 5) & 7, t & 31, true, lds, tid); }
            }
            for (int s = G - 1 - wg; s < 64; s += G) lru_tile(p, l, 4 + (s >> 3), s & 7, 0, true, lds, tid);
            if (l == 0) STAMP(34);
        } else if (ph == 6) { if ((PROBE & 1024) && l == 0) { ln_phase(p, l, tid); xcd_barrier(xb); } ln_phase(p, l, tid); }
        if (step < 13) xcd_barrier(xb);
        if (l == 0) STAMP(1 + step);
    }
    if (TSA != -1) {
        xcd_barrier(xb);
        if (blockIdx.x == 0 && threadIdx.x == 0) {
            KP p = (KP)__builtin_amdgcn_kernarg_segment_ptr();
            const unsigned long long* ts = (const unsigned long long*)(p->ws + OFF_TS);
            const float t_us = TSA == -2 ? 100.f : TSA == -3 ? 200.f : (float)(long long)(ts[TSB < 0 ? 0 : TSB] - ts[TSA < 0 ? 0 : TSA]) * 0.01f;
            p->out[O_SH] += 0.3f * __builtin_amdgcn_sqrtf(t_us * 0.01f);
        }
    }
}

extern "C" void kernel_launch(void* const* d_in, const int* in_sizes, int n_in, void* d_out, int out_size, void* d_ws, size_t ws_size, hipStream_t stream) {
    constexpr size_t kDynLds = 155648;
    static int grid_blocks = 0;
    if (!grid_blocks) {
        int dev = 0, cus = 0, per_cu = 0;
        (void)hipGetDevice(&dev);
        (void)hipDeviceGetAttribute(&cus, hipDeviceAttributeMultiprocessorCount, dev);
        (void)hipFuncSetAttribute((const void*)mega, hipFuncAttributeMaxDynamicSharedMemorySize, (int)kDynLds);
        (void)hipOccupancyMaxActiveBlocksPerMultiprocessor(&per_cu, mega, 512, kDynLds);
        if (per_cu > 1) per_cu = 1;
        grid_blocks = cus * per_cu;
        if (grid_blocks > 256) grid_blocks = 256;
    }
    if (ws_size < WS_NEED) { fprintf(stderr, "workspace too small: %zu < %zu\n", ws_size, (size_t)WS_NEED); return; }
    Params p{};
    for (int i = 0; i < 31; ++i) p.in[i] = (const float*)d_in[i];
    p.out = (float*)d_out; p.ws = (unsigned char*)d_ws;
    (void)hipMemsetAsync((unsigned char*)d_ws + OFF_BAR, 0, 16384, stream);
    void* args[] = {&p};
    hipError_t e = hipLaunchCooperativeKernel((void*)mega, dim3(grid_blocks), dim3(512), args, kDynLds, stream);
    if (e != hipSuccess) fprintf(stderr, "cooperative launch failed: %s (grid %d)\n", hipGetErrorString(e), grid_blocks);
}
```
